# Optimizing an MI355X kernel written in HIP

```python
import jax, jax.numpy as jnp
from jax import lax
import numpy as np

D_MODEL = 2048
BATCH = 2
SEQ = 4096
DEPTH = 2

MLSTM_HEADS = 4
MLSTM_DHEAD = D_MODEL // (2 * MLSTM_HEADS)
MLSTM_WIDTH = MLSTM_HEADS * MLSTM_DHEAD
RET_HEADS = 4
RET_DHEAD = D_MODEL // (2 * RET_HEADS)
RET_WIDTH = RET_HEADS * RET_DHEAD
MIX_WIDTH = MLSTM_WIDTH + RET_WIDTH
IN_COLS = 4 * MLSTM_WIDTH + 2 * MLSTM_HEADS + 4 * RET_WIDTH
CONV_WIDTH = 4
MLSTM_CHUNK = 64
RET_CHUNK = 128
MLA_HEADS = 16
Q_LORA = 512
KV_LORA = 512
QK_NOPE = 128
QK_ROPE = 64
V_HEAD = 128
ATTN_BLOCK = 128
D_FF = ((8 * D_MODEL // 3 + 255) // 256) * 256
N_EXPERTS = 8
TOP_K = 2
D_FF_EXPERT = D_FF
ROPE_BASE = 10000.0
EPS = 1e-6

kernel_name = 'mlstm_retention_mla_moe_hybrid'


def rmsnorm(x, g):
    xf = x.astype(jnp.float32)
    y = xf * lax.rsqrt(jnp.mean(xf * xf, axis=-1, keepdims=True) + EPS)
    return (y * g.astype(jnp.float32)).astype(x.dtype)


def rope(x, pos):
    half = x.shape[-1] // 2
    inv = ROPE_BASE ** (-jnp.arange(half, dtype=jnp.float32) / half)
    ang = pos.astype(jnp.float32)[..., None] * inv
    cos = jnp.cos(ang)[:, :, None, :]
    sin = jnp.sin(ang)[:, :, None, :]
    x1 = x[..., :half].astype(jnp.float32)
    x2 = x[..., half:].astype(jnp.float32)
    return jnp.concatenate([x1 * cos - x2 * sin, x2 * cos + x1 * sin], axis=-1).astype(x.dtype)


def causal_dwconv(x, w):
    C = x.shape[-1]
    xp = jnp.pad(x, ((0, 0), (w.shape[0] - 1, 0), (0, 0)))
    return lax.conv_general_dilated(xp, w[:, None, :].astype(x.dtype), window_strides=(1,), padding='VALID',
                                    dimension_numbers=('NWC', 'WIO', 'NWC'), feature_group_count=C)


def to_chunks(x, L):
    B, S, H = x.shape[:3]
    x = x.reshape((B, S // L, L, H) + x.shape[3:])
    return x.transpose((1, 0, 3, 2) + tuple(range(4, x.ndim)))


def from_chunks(y):
    NC, B, H, L, d = y.shape
    return y.transpose(1, 0, 3, 2, 4).reshape(B, NC * L, H, d)


def mlstm_chunkwise(q, k, v, i_pre, logf):
    L = MLSTM_CHUNK
    B, S, H, dk = q.shape
    dv = v.shape[-1]
    qc = to_chunks(q.astype(jnp.float32), L)
    kc = to_chunks(k.astype(jnp.float32), L) * (dk ** -0.5)
    vc = to_chunks(v.astype(jnp.float32), L)
    ic = to_chunks(i_pre.astype(jnp.float32), L)
    fc = to_chunks(logf.astype(jnp.float32), L)
    causal = jnp.tril(jnp.ones((L, L), dtype=bool))

    def step(carry, xs):
        C, n, m = carry
        q_, k_, v_, i_, f_ = xs
        b = jnp.cumsum(f_, axis=-1)
        g = b[..., -1]
        logD = jnp.where(causal, b[..., :, None] - b[..., None, :] + i_[..., None, :], -jnp.inf)
        m_inter = b + m[..., None]
        m_t = jnp.maximum(logD.max(axis=-1), m_inter)
        Dm = jnp.exp(logD - m_t[..., None])
        inter = jnp.exp(m_inter - m_t)
        Sm = jnp.einsum('bhld,bhsd->bhls', q_, k_) * Dm
        num = jnp.einsum('bhls,bhsv->bhlv', Sm, v_) + inter[..., None] * jnp.einsum('bhld,bhdv->bhlv', q_, C)
        den = Sm.sum(axis=-1) + inter * jnp.einsum('bhld,bhd->bhl', q_, n)
        h = num / jnp.maximum(jnp.abs(den), jnp.exp(-m_t))[..., None]
        log_w = g[..., None] - b + i_
        m_new = jnp.maximum(g + m, log_w.max(axis=-1))
        w = jnp.exp(log_w - m_new[..., None])
        decay = jnp.exp(g + m - m_new)
        C = decay[..., None, None] * C + jnp.einsum('bhl,bhld,bhlv->bhdv', w, k_, v_)
        n = decay[..., None] * n + jnp.einsum('bhl,bhld->bhd', w, k_)
        return (C, n, m_new), h

    init = (jnp.zeros((B, H, dk, dv), jnp.float32), jnp.zeros((B, H, dk), jnp.float32),
            jnp.full((B, H), -jnp.inf, jnp.float32))
    _, hs = lax.scan(step, init, (qc, kc, vc, ic, fc))
    return from_chunks(hs)


def retention_chunkwise(q, k, v, log_gamma):
    L = RET_CHUNK
    B, S, H, dk = q.shape
    dv = v.shape[-1]
    qc = to_chunks(q.astype(jnp.float32), L)
    kc = to_chunks(k.astype(jnp.float32), L) * (dk ** -0.5)
    vc = to_chunks(v.astype(jnp.float32), L)
    j = jnp.arange(L, dtype=jnp.float32)
    lg = log_gamma[:, None]
    dist = j[:, None] - j[None, :]
    D = jnp.where(dist >= 0, jnp.exp(lg[..., None] * jnp.maximum(dist, 0.0)), 0.0)
    q_decay = jnp.exp(lg * (j + 1.0))
    k_decay = jnp.exp(lg * (L - 1.0 - j))
    chunk_decay = jnp.exp(log_gamma * L)

    def step(R, xs):
        q_, k_, v_ = xs
        Sm = jnp.einsum('bhld,bhsd->bhls', q_, k_) * D
        out = jnp.einsum('bhls,bhsv->bhlv', Sm, v_) + jnp.einsum('bhld,bhdv->bhlv', q_, R) * q_decay[..., None]
        R = chunk_decay[:, None, None] * R + jnp.einsum('bhld,hl,bhlv->bhdv', k_, k_decay, v_)
        return R, out

    _, outs = lax.scan(step, jnp.zeros((B, H, dk, dv), jnp.float32), (qc, kc, vc))
    return from_chunks(outs)


def recurrent_hybrid_mixer(h, pos, w_in, conv_w, b_gates, g_mlstm_out, g_ret_out, w_out):
    B, S, _ = h.shape
    Hm, Hr = MLSTM_HEADS, RET_HEADS
    sizes = [2 * MLSTM_WIDTH, MLSTM_WIDTH, MLSTM_WIDTH, 2 * Hm, RET_WIDTH, RET_WIDTH, RET_WIDTH, RET_WIDTH]
    offs = np.cumsum(sizes)[:-1].tolist()
    m_qk, m_v, m_o, m_if, r_q, r_k, r_v, r_g = jnp.split(h @ w_in, offs, axis=-1)
    m_qk = jax.nn.silu(causal_dwconv(m_qk, conv_w))
    m_q = m_qk[..., :MLSTM_WIDTH].reshape(B, S, Hm, MLSTM_DHEAD)
    m_k = m_qk[..., MLSTM_WIDTH:].reshape(B, S, Hm, MLSTM_DHEAD)
    gates = m_if.astype(jnp.float32) + b_gates.astype(jnp.float32)
    i_pre = gates[..., :Hm]
    logf = jax.nn.log_sigmoid(gates[..., Hm:])
    hm = mlstm_chunkwise(m_q, m_k, m_v.reshape(B, S, Hm, MLSTM_DHEAD), i_pre, logf)
    hm = jax.nn.sigmoid(m_o.astype(jnp.float32)).reshape(B, S, Hm, MLSTM_DHEAD) * hm
    hm = rmsnorm(hm, g_mlstm_out.reshape(Hm, MLSTM_DHEAD)).reshape(B, S, MLSTM_WIDTH).astype(h.dtype)
    log_gamma = jnp.log1p(-jnp.exp2(-5.0 - jnp.arange(Hr, dtype=jnp.float32)))
    r_q = rope(r_q.reshape(B, S, Hr, RET_DHEAD), pos)
    r_k = rope(r_k.reshape(B, S, Hr, RET_DHEAD), pos)
    hr = retention_chunkwise(r_q, r_k, r_v.reshape(B, S, Hr, RET_DHEAD), log_gamma)
    hr = rmsnorm(hr, g_ret_out.reshape(Hr, RET_DHEAD)).reshape(B, S, RET_WIDTH)
    hr = (jax.nn.silu(r_g.astype(jnp.float32)) * hr).astype(h.dtype)
    return jnp.concatenate([hm, hr], axis=-1) @ w_out


def mla_mixer(h, pos, w_dqkv, g_cq, g_ckv, w_uq, w_ukv, g_qn, g_qr, g_kn, g_kr, w_o):
    B, S, _ = h.shape
    H = MLA_HEADS
    c_q, c_kv, k_r = jnp.split(h @ w_dqkv, [Q_LORA, Q_LORA + KV_LORA], axis=-1)
    c_q = rmsnorm(c_q, g_cq)
    c_kv = rmsnorm(c_kv, g_ckv)
    q = (c_q @ w_uq).reshape(B, S, H, QK_NOPE + QK_ROPE)
    kv = (c_kv @ w_ukv).reshape(B, S, H, QK_NOPE + V_HEAD)
    q_n = rmsnorm(q[..., :QK_NOPE], g_qn)
    q_r = rope(rmsnorm(q[..., QK_NOPE:], g_qr), pos)
    k_n = rmsnorm(kv[..., :QK_NOPE], g_kn)
    v = kv[..., QK_NOPE:]
    k_r = rope(rmsnorm(k_r, g_kr)[:, :, None, :], pos)[:, :, 0, :]
    scale = (QK_NOPE + QK_ROPE) ** -0.5
    nb = S // ATTN_BLOCK
    qn_b = q_n.reshape(B, nb, ATTN_BLOCK, H, QK_NOPE).transpose(1, 0, 2, 3, 4)
    qr_b = q_r.reshape(B, nb, ATTN_BLOCK, H, QK_ROPE).transpose(1, 0, 2, 3, 4)
    kpos = jnp.arange(S)

    def block(args):
        qn, qr, bi = args
        s = jnp.einsum('bqhd,bkhd->bhqk', qn, k_n) + jnp.einsum('bqhd,bkd->bhqk', qr, k_r)
        s = s.astype(jnp.float32) * scale
        qpos = bi * ATTN_BLOCK + jnp.arange(ATTN_BLOCK)
        s = jnp.where(kpos[None, :] <= qpos[:, None], s, -jnp.inf)
        p = jax.nn.softmax(s, axis=-1).astype(v.dtype)
        return jnp.einsum('bhqk,bkhd->bqhd', p, v)

    o = lax.map(block, (qn_b, qr_b, jnp.arange(nb)))
    o = o.transpose(1, 0, 2, 3, 4).reshape(B, S, H * V_HEAD)
    return o @ w_o


def swiglu(t, wg, wu, wd):
    return (jax.nn.silu(t @ wg) * (t @ wu)) @ wd


def moe_swiglu(h, w_router, we_gate, we_up, we_down):
    B, S, D = h.shape
    t = h.reshape(B * S, D)
    logits = (t @ w_router).astype(jnp.float32)
    top_val, top_idx = lax.top_k(logits, TOP_K)
    top_w = jax.nn.softmax(top_val, axis=-1)
    combine = jnp.einsum('tk,tke->te', top_w, jax.nn.one_hot(top_idx, N_EXPERTS, dtype=jnp.float32)).astype(t.dtype)
    y = jnp.zeros_like(t)
    for e in range(N_EXPERTS):
        y = y + combine[:, e:e + 1] * swiglu(t, we_gate[e], we_up[e], we_down[e])
    return y.reshape(B, S, D)


def setup_inputs(seed: int = 0) -> dict:
    key = jax.random.key(seed)
    ks = iter(jax.random.split(key, 40))
    f32 = jnp.float32
    ne, no = (DEPTH + 1) // 2, DEPTH // 2
    out_scale = (2 * DEPTH) ** -0.5

    def dense(shape, fan_in, scale=1.0):
        return jax.random.normal(next(ks), shape, f32) * (scale * fan_in ** -0.5)

    def gain(shape):
        return 1.0 + 0.02 * jax.random.normal(next(ks), shape, f32)

    x = jax.random.normal(next(ks), (BATCH, SEQ, D_MODEL), f32)
    positions = (jax.random.randint(next(ks), (BATCH, 1), 0, 2048, jnp.int32)
                 + jnp.arange(SEQ, dtype=jnp.int32)[None, :])
    b_base = jnp.concatenate([jnp.zeros((MLSTM_HEADS,), f32), jnp.linspace(3.0, 6.0, MLSTM_HEADS, dtype=f32)])
    b_gates = b_base[None, :] + 0.1 * jax.random.normal(next(ks), (ne, 2 * MLSTM_HEADS), f32)
    return {
        'x': x,
        'positions': positions,
        'g_mix_norm': gain((DEPTH, D_MODEL)),
        'g_ffn_norm': gain((DEPTH, D_MODEL)),
        'w_in': dense((ne, D_MODEL, IN_COLS), D_MODEL),
        'conv_w': dense((ne, CONV_WIDTH, 2 * MLSTM_WIDTH), CONV_WIDTH),
        'b_gates': b_gates,
        'g_mlstm_out': gain((ne, MLSTM_WIDTH)),
        'g_ret_out': gain((ne, RET_WIDTH)),
        'w_mix_out': dense((ne, MIX_WIDTH, D_MODEL), MIX_WIDTH, out_scale),
        'ffn_gate': dense((ne, D_MODEL, D_FF), D_MODEL),
        'ffn_up': dense((ne, D_MODEL, D_FF), D_MODEL),
        'ffn_down': dense((ne, D_FF, D_MODEL), D_FF, out_scale),
        'w_dqkv': dense((no, D_MODEL, Q_LORA + KV_LORA + QK_ROPE), D_MODEL),
        'g_cq': gain((no, Q_LORA)),
        'g_ckv': gain((no, KV_LORA)),
        'w_uq': dense((no, Q_LORA, MLA_HEADS * (QK_NOPE + QK_ROPE)), Q_LORA),
        'w_ukv': dense((no, KV_LORA, MLA_HEADS * (QK_NOPE + V_HEAD)), KV_LORA),
        'g_qn': gain((no, QK_NOPE)),
        'g_qr': gain((no, QK_ROPE)),
        'g_kn': gain((no, QK_NOPE)),
        'g_kr': gain((no, QK_ROPE)),
        'w_o': dense((no, MLA_HEADS * V_HEAD, D_MODEL), MLA_HEADS * V_HEAD, out_scale),
        'w_router': dense((no, D_MODEL, N_EXPERTS), D_MODEL),
        'we_gate': dense((no, N_EXPERTS, D_MODEL, D_FF_EXPERT), D_MODEL),
        'we_up': dense((no, N_EXPERTS, D_MODEL, D_FF_EXPERT), D_MODEL),
        'we_down': dense((no, N_EXPERTS, D_FF_EXPERT, D_MODEL), D_FF_EXPERT, out_scale),
    }


def reference(x, positions, g_mix_norm, g_ffn_norm, w_in, conv_w, b_gates, g_mlstm_out, g_ret_out,
              w_mix_out, ffn_gate, ffn_up, ffn_down, w_dqkv, g_cq, g_ckv, w_uq, w_ukv, g_qn, g_qr,
              g_kn, g_kr, w_o, w_router, we_gate, we_up, we_down):
    for layer in range(DEPTH):
        j = layer // 2
        h = rmsnorm(x, g_mix_norm[layer])
        if layer % 2 == 0:
            x = x + recurrent_hybrid_mixer(h, positions, w_in[j], conv_w[j], b_gates[j], g_mlstm_out[j],
                                           g_ret_out[j], w_mix_out[j]).astype(x.dtype)
            h = rmsnorm(x, g_ffn_norm[layer])
            x = x + swiglu(h, ffn_gate[j], ffn_up[j], ffn_down[j]).astype(x.dtype)
        else:
            x = x + mla_mixer(h, positions, w_dqkv[j], g_cq[j], g_ckv[j], w_uq[j], w_ukv[j], g_qn[j],
                              g_qr[j], g_kn[j], g_kr[j], w_o[j]).astype(x.dtype)
            h = rmsnorm(x, g_ffn_norm[layer])
            x = x + moe_swiglu(h, w_router[j], we_gate[j], we_up[j], we_down[j]).astype(x.dtype)
    return x
```

```cpp
#include <hip/hip_runtime.h>
#include <cstdio>
#include <cstdint>

#ifndef MK_ONE_LAUNCH
#define MK_ONE_LAUNCH 1
#endif

#define LAS __attribute__((address_space(3)))
#define GAS __attribute__((address_space(1)))
typedef unsigned short bf16_t;
typedef short bf16x8 __attribute__((ext_vector_type(8)));
typedef float f32x2 __attribute__((ext_vector_type(2)));
typedef float f32x4 __attribute__((ext_vector_type(4)));
typedef float f32x16 __attribute__((ext_vector_type(16)));
typedef unsigned u32x4 __attribute__((ext_vector_type(4)));
typedef unsigned u32x2 __attribute__((ext_vector_type(2)));

constexpr int T = 8192, SEQ = 4096, NBATCH = 2, D = 2048, DFF = 5632;
constexpr int IN_COLS = 8200, NEXP = 8;
constexpr int HM = 4, DH = 256;
constexpr int LM = 128, NCM = SEQ / LM;
constexpr int LR = 128, NCR = SEQ / LR;
constexpr int MLA_H = 16, QLORA = 512, KVLORA = 512, NOPE = 128, ROPE = 64, VH = 128, QKD = NOPE + ROPE;
constexpr int NDQKV = 1280;
constexpr float EPS = 1e-6f;
constexpr int MOE_ROWS = 18432;
constexpr int MOE_MAXRT = 72;

constexpr size_t MiB = 1u << 20;
constexpr size_t WS_CTL = 0, CTL_ZERO_BYTES = 128 * 1024;
constexpr size_t WS_SMALL = 1 * MiB;
constexpr size_t WS_ROPER = WS_SMALL;
constexpr size_t WS_ROPEM = WS_ROPER + 8 * MiB;
constexpr size_t WS_GI    = WS_ROPEM + 2 * MiB;
constexpr size_t WS_GF    = WS_GI + 128 * 1024;
constexpr size_t WS_BC    = WS_GF + 128 * 1024;
constexpr size_t WS_WL    = WS_BC + 128 * 1024;
constexpr size_t WS_MPREV = WS_WL + 128 * 1024;
constexpr size_t WS_DEC   = WS_MPREV + 4096;
constexpr size_t WS_UN    = WS_DEC + 4096;
constexpr size_t WS_RTE   = WS_UN + 512 * 1024;
constexpr size_t WS_RTW   = WS_RTE + 64 * 1024;
constexpr size_t WS_RTROW = WS_RTW + 64 * 1024;
constexpr size_t WS_CNT   = WS_RTROW + 64 * 1024;
constexpr size_t WS_MOETAB = WS_CNT + 8192;
constexpr size_t WS_KR    = WS_MOETAB + 4096;
constexpr size_t WS_RSQ_X1 = WS_KR + 2 * MiB;
constexpr size_t WS_RSQ_X2 = WS_RSQ_X1 + 256 * 1024;
constexpr size_t WS_RSQ_CQ = WS_RSQ_X2 + 256 * 1024;
constexpr size_t WS_RSQ_CKV = WS_RSQ_CQ + 64 * 1024;
constexpr size_t WS_ROWTOK = WS_RSQ_CKV + 64 * 1024;
static_assert(WS_ROWTOK + 18432 * 4 <= 16 * MiB, "small tables");
constexpr size_t WS_WIN   = 16 * MiB;
constexpr size_t WS_WOUT  = WS_WIN + 32 * MiB;
constexpr size_t WS_WGU   = WS_WOUT + 8 * MiB;
constexpr size_t WS_WD    = WS_WGU + 44 * MiB;
constexpr size_t WS_WDQKV = WS_WD + 22 * MiB;
constexpr size_t WS_WUQKV = WS_WDQKV + 5 * MiB;
constexpr size_t WS_WO    = WS_WUQKV + 7 * MiB;
constexpr size_t WS_WEGU  = WS_WO + 8 * MiB;
constexpr size_t WS_WED   = WS_WEGU + 176 * MiB;
constexpr size_t WS_H     = WS_WED + 88 * MiB;
constexpr size_t WS_X1    = WS_H + 32 * MiB;
constexpr size_t WS_X2    = WS_X1 + 64 * MiB;
constexpr size_t WS_OV    = WS_X2 + 64 * MiB;
constexpr size_t WS_Z     = WS_OV;
constexpr size_t WS_QKC   = WS_Z + 128 * MiB;
constexpr size_t WS_STM   = WS_QKC + 64 * MiB;
constexpr size_t WS_STR   = WS_STM + 64 * MiB;
constexpr size_t WS_MIX   = WS_STR + 32 * MiB;
constexpr size_t WS_ACT   = WS_MIX + 32 * MiB;
constexpr size_t WS_L0END = WS_ACT + 88 * MiB;
constexpr size_t WS_CQKV  = WS_OV;
constexpr size_t WS_CQKVN = WS_CQKV + 40 * MiB;
constexpr size_t WS_QKVR  = WS_CQKVN + 16 * MiB;
constexpr size_t WS_QA    = WS_QKVR + 112 * MiB;
constexpr size_t WS_KA    = WS_QA + 48 * MiB;
constexpr size_t WS_VT    = WS_KA + 48 * MiB;
constexpr size_t WS_AO    = WS_VT + 32 * MiB;
constexpr size_t WS_L1AEND = WS_AO + 32 * MiB;
constexpr size_t WS_HPERM = WS_OV;
constexpr size_t WS_ACTE  = WS_HPERM + 36 * MiB;
constexpr size_t WS_OE    = WS_ACTE + 99 * MiB;
constexpr size_t WS_SPLITK = WS_OE + 72 * MiB;
constexpr size_t WS_L1BEND = WS_SPLITK + 48 * MiB;
constexpr size_t WS_END = (WS_L0END > WS_L1AEND ? (WS_L0END > WS_L1BEND ? WS_L0END : WS_L1BEND) : (WS_L1AEND > WS_L1BEND ? WS_L1AEND : WS_L1BEND));
static_assert(WS_END <= (size_t)1400 * MiB, "d_ws map must stay under the guaranteed workspace size");

constexpr int CW_TMO = 0;
constexpr int CW_BAR = 4096;
constexpr int CW_SPLITK = 16384;
constexpr int RING_BYTES = 131072;
constexpr int LDSCTL_OFF = 155648, MISC_OFF = LDSCTL_OFF + 320;
constexpr int LDS_BYTES = LDSCTL_OFF + 1024;
constexpr int NWAVES = 8, NTHR = 512;

__device__ __forceinline__ unsigned cvt_pk_bf16(float lo, float hi) { unsigned r; asm volatile("v_cvt_pk_bf16_f32 %0, %1, %2" : "=v"(r) : "v"(lo), "v"(hi)); return r; }
__device__ __forceinline__ bf16_t f2bf(float f) { return (bf16_t)(cvt_pk_bf16(f, 0.f) & 0xffffu); }
__device__ __forceinline__ float bf2f(bf16_t b) { return __uint_as_float(((unsigned)b) << 16); }
__device__ __forceinline__ float bflo(unsigned w) { return __uint_as_float(w << 16); }
__device__ __forceinline__ float bfhi(unsigned w) { return __uint_as_float(w & 0xffff0000u); }
template <int CTRL> __device__ __forceinline__ float dpp_mov(float v) { return __builtin_bit_cast(float, __builtin_amdgcn_update_dpp(0, __builtin_bit_cast(int, v), CTRL, 0xf, 0xf, true)); }
__device__ __forceinline__ float half32_add(float v) { auto rr = __builtin_amdgcn_permlane32_swap(__float_as_uint(v), __float_as_uint(v), false, false); return __uint_as_float(rr[0]) + __uint_as_float(rr[1]); }
__device__ __forceinline__ float half32_max(float v) { auto rr = __builtin_amdgcn_permlane32_swap(__float_as_uint(v), __float_as_uint(v), false, false); return fmaxf(__uint_as_float(rr[0]), __uint_as_float(rr[1])); }
__device__ __forceinline__ float row16_sum(float v) { v += dpp_mov<0xB1>(v); v += dpp_mov<0x4E>(v); v += dpp_mov<0x141>(v); v += dpp_mov<0x140>(v); return v; }
__device__ __forceinline__ float wave_sum(float v) { v = row16_sum(v); v += __shfl_xor(v, 16); return half32_add(v); }
__device__ __forceinline__ float wave_max(float v) {
    v = fmaxf(v, dpp_mov<0xB1>(v)); v = fmaxf(v, dpp_mov<0x4E>(v)); v = fmaxf(v, dpp_mov<0x141>(v)); v = fmaxf(v, dpp_mov<0x140>(v));
    v = fmaxf(v, __shfl_xor(v, 16)); return half32_max(v);
}
__device__ __forceinline__ float silu_f(float x) { return x * __builtin_amdgcn_rcpf(1.f + __expf(-x)); }
__device__ __forceinline__ float sigmoid_f(float x) { return __builtin_amdgcn_rcpf(1.f + __expf(-x)); }
__device__ __forceinline__ float q8f(float x, float sc, float isc) { const int w = __builtin_amdgcn_cvt_pk_fp8_f32(x * sc, 0.f, 0, false); return __builtin_amdgcn_cvt_f32_fp8(w, 0) * isc; }
typedef int i32x8 __attribute__((ext_vector_type(8)));
typedef int i32x4 __attribute__((ext_vector_type(4)));
__device__ __forceinline__ unsigned pk4_fp8(float a, float b, float c, float d) { int w = __builtin_amdgcn_cvt_pk_fp8_f32(a, b, 0, false); w = __builtin_amdgcn_cvt_pk_fp8_f32(c, d, w, true); return (unsigned)w; }
constexpr float W8_SCALE = 64.f;
#ifndef FP8_EMU
#define FP8_EMU 0
#endif
#define LDS_WAIT() asm volatile("s_waitcnt lgkmcnt(0)" ::: "memory")
#define VM_WAIT() asm volatile("s_waitcnt vmcnt(0)" ::: "memory")
namespace pg8 {
#define PG8_LAS __attribute__((address_space(3)))
constexpr int BM = 256, BK = 64, HALF = 128, HTB = HALF * BK * 2, STAGE_BYTES = 8 * HTB, NXCD = 8, WGM = 8;

__host__ __device__ __forceinline__ int lds_byte(int r, int c) { const int st = (r >> 4) * 2 + (c >> 5), rr = r & 15, cc = c & 31, ob = rr * 64 + cc * 2; return st * 1024 + (ob ^ (((ob >> 9) & 1) << 5)); }
__host__ __device__ __forceinline__ void stage_rc(int b, int& R, int& C) { const int st = b / 1024, sb = b % 1024, swz = sb ^ (((sb >> 9) & 1) << 5); R = (st >> 1) * 16 + swz / 64; C = (st & 1) * 32 + (swz % 64) / 2; }
__host__ __device__ __forceinline__ int perm32(int rho) { const int n = rho >> 4, i = rho & 15; return 8 * (i >> 2) + 4 * n + (i & 3); }

struct Unit { int pm, pn, pc, aoff; };
struct Gemm { const bf16_t* A; const bf16_t* Bt; int K, lda, ldb; };

struct StaticOrder {
    int nM, nN, nwg, G, c;
    __host__ __device__ void init(int M, int N, int G_, int c_) { nM = M / BM; nN = N / BM; nwg = nM * nN; G = G_; c = c_; }
    __host__ __device__ bool next(int i, Unit& u) const {
        const long L = (long)i * G + c; if (L >= nwg) return false;
        int wgid = (int)L; { const int q = nwg / NXCD, r = nwg % NXCD, xcd = wgid % NXCD, off = wgid / NXCD; wgid = (xcd < r ? xcd * (q + 1) : r * (q + 1) + (xcd - r) * q) + off; }
        const int nig = WGM * nN, gid = wgid / nig, fm = gid * WGM, gsz = (nM - fm) < WGM ? (nM - fm) : WGM;
        u.pm = fm + ((wgid % nig) % gsz); u.pn = (wgid % nig) / gsz; u.pc = u.pn; u.aoff = 0; return true;
    }
};
struct RangeOrder { StaticOrder S; int lo, hi;
    __device__ __forceinline__ bool next(int i, Unit& u) const { return (lo + i < hi) && S.next(lo + i, u); } };
struct DualOrder : StaticOrder {
    __device__ bool next(int i, Unit& u) const { if (!StaticOrder::next(i, u)) return false; u.aoff = (u.pn >= 12) ? 512 * 2 : 0; return true; }
};
__device__ __forceinline__ int moe_unit_word(const PG8_LAS int* tab, int npn, int G, int c, int i) {
    const int nu = tab[16] * npn; const long L = (long)i * G + c; if (L >= nu) return -1;
    int id = (int)L; { const int q = nu / NXCD, r = nu % NXCD, xcd = id % NXCD, off = id / NXCD; id = (xcd < r ? xcd * (q + 1) : r * (q + 1) + (xcd - r) * q) + off; }
    int e = 0, base = 0;
    for (int j = 0; j < 7; ++j) { const int n = tab[8 + e] * npn; if (id >= base + n) { base += n; ++e; } }
    int cnt = tab[8 + e]; if (cnt < 1) cnt = 1;
    const int rr = id - base; const int pnl = rr / cnt, rt = tab[e] + rr % cnt;
    return rt | (pnl << 8) | (e << 16);
}
struct MoeOrder {
    const PG8_LAS int* list; int npn; const PG8_LAS int* toks;
    __device__ __forceinline__ int rowoff(int i, int r) const { return toks[i * 256 + r]; }
    __device__ __forceinline__ bool next(int i, Unit& u) const {
        const int w = __builtin_amdgcn_readfirstlane(list[i]); if (w < 0) return false;
        const int rt = w & 255, pnl = (w >> 8) & 255, e = w >> 16;
        u.pm = rt; u.pn = e * npn + pnl; u.pc = pnl; u.aoff = 0; return true;
    }
};

struct EpiBf16 {
    static constexpr bool PERM = true, AFTER_DRAIN = false; static constexpr int NSTORES = 16;
    bf16_t* O; int ldc;
    __device__ __forceinline__ void operator()(const f32x4 (&acc)[2][2][4][2], const Unit& u, int wr, int wc, int fr, int fq) const {
        const int row0 = u.pm * BM + wr * 64 + fr, col0 = u.pc * BM + wc * 32 + 8 * fq;
#pragma unroll
        for (int ai = 0; ai < 2; ++ai)
#pragma unroll
            for (int m = 0; m < 4; ++m) { bf16_t* rowp = O + (size_t)(row0 + ai * HALF + m * 16) * ldc + col0;
#pragma unroll
                for (int bj = 0; bj < 2; ++bj) { const f32x4 v0 = acc[ai][bj][m][0], v1 = acc[ai][bj][m][1];
                    u32x4 w; w.x = cvt_pk_bf16(v0[0], v0[1]); w.y = cvt_pk_bf16(v0[2], v0[3]); w.z = cvt_pk_bf16(v1[0], v1[1]); w.w = cvt_pk_bf16(v1[2], v1[3]);
                    *(u32x4*)(rowp + bj * HALF) = w; } }
    }
};
struct EpiZ {
    static constexpr bool PERM = true, AFTER_DRAIN = false; static constexpr int NSTORES = 16;
    bf16_t* O; int ldc; const float* rope;
    __device__ __forceinline__ void operator()(const f32x4 (&acc)[2][2][4][2], const Unit& u, int wr, int wc, int fr, int fq) const {
        const int row0 = u.pm * BM + wr * 64 + fr, col0 = u.pc * BM + wc * 32 + 8 * fq;
        const bool rot = (u.pc >= 16) && (u.pc < 24); const float sc = (u.pc >= 20) ? 0.0625f : 1.f;
#pragma unroll
        for (int ai = 0; ai < 2; ++ai)
#pragma unroll
            for (int m = 0; m < 4; ++m) { const int row = row0 + ai * HALF + m * 16; bf16_t* rowp = O + (size_t)row * ldc + col0;
                f32x4 a0 = acc[ai][0][m][0], a1 = acc[ai][0][m][1], b0 = acc[ai][1][m][0], b1 = acc[ai][1][m][1];
                if (rot) { const f32x4* cp = (const f32x4*)(rope + ((size_t)row * 128 + wc * 32 + 8 * fq) * 2);
                    const f32x4 c0 = cp[0], c1 = cp[1], c2 = cp[2], c3 = cp[3];
                    const f32x4 C0 = {c0[0], c0[2], c1[0], c1[2]}, S0 = {c0[1], c0[3], c1[1], c1[3]}, C1 = {c2[0], c2[2], c3[0], c3[2]}, S1 = {c2[1], c2[3], c3[1], c3[3]};
                    const f32x4 y0 = (a0 * C0 - b0 * S0) * sc, z0 = (b0 * C0 + a0 * S0) * sc, y1 = (a1 * C1 - b1 * S1) * sc, z1 = (b1 * C1 + a1 * S1) * sc;
                    a0 = y0; b0 = z0; a1 = y1; b1 = z1; }
                u32x4 w; w.x = cvt_pk_bf16(a0[0], a0[1]); w.y = cvt_pk_bf16(a0[2], a0[3]); w.z = cvt_pk_bf16(a1[0], a1[1]); w.w = cvt_pk_bf16(a1[2], a1[3]);
                *(u32x4*)rowp = w;
                w.x = cvt_pk_bf16(b0[0], b0[1]); w.y = cvt_pk_bf16(b0[2], b0[3]); w.z = cvt_pk_bf16(b1[0], b1[1]); w.w = cvt_pk_bf16(b1[2], b1[3]);
                *(u32x4*)(rowp + HALF) = w; }
    }
};
template <bool Q8 = false> struct EpiSwiGLU {
    static constexpr bool PERM = true, AFTER_DRAIN = false; static constexpr int NSTORES = 8;
    bf16_t* O; int ldc;
    __device__ __forceinline__ void operator()(const f32x4 (&acc)[2][2][4][2], const Unit& u, int wr, int wc, int fr, int fq) const {
        const int row0 = u.pm * BM + wr * 64 + fr, col0 = u.pc * HALF + wc * 32 + 8 * fq;
#pragma unroll
        for (int ai = 0; ai < 2; ++ai)
#pragma unroll
            for (int m = 0; m < 4; ++m) { bf16_t* rowp = O + (size_t)(row0 + ai * HALF + m * 16) * ldc + col0;
                float o[8];
#pragma unroll
                for (int n = 0; n < 2; ++n)
#pragma unroll
                    for (int j = 0; j < 4; ++j) { const float g = acc[ai][0][m][n][j], up = acc[ai][1][m][n][j]; float ov = g * up * __builtin_amdgcn_rcpf(1.f + __expf(-g)); if (Q8) ov = q8f(ov, 1.f, 1.f); o[n * 4 + j] = ov; }
                u32x4 w; w.x = cvt_pk_bf16(o[0], o[1]); w.y = cvt_pk_bf16(o[2], o[3]); w.z = cvt_pk_bf16(o[4], o[5]); w.w = cvt_pk_bf16(o[6], o[7]);
                *(u32x4*)rowp = w; }
    }
};
struct EpiSwiGLU8 {
    static constexpr bool PERM = true, AFTER_DRAIN = false; static constexpr int NSTORES = 8;
    unsigned char* O; int ldc;
    __device__ __forceinline__ void operator()(const f32x4 (&acc)[2][2][4][2], const Unit& u, int wr, int wc, int fr, int fq) const {
        const int row0 = u.pm * BM + wr * 64 + fr, col0 = u.pc * HALF + wc * 32 + 8 * fq;
#pragma unroll
        for (int ai = 0; ai < 2; ++ai)
#pragma unroll
            for (int m = 0; m < 4; ++m) { unsigned char* rowp = O + (size_t)(row0 + ai * HALF + m * 16) * ldc + col0;
                float o[8];
#pragma unroll
                for (int n = 0; n < 2; ++n)
#pragma unroll
                    for (int j = 0; j < 4; ++j) { const float g = acc[ai][0][m][n][j], up = acc[ai][1][m][n][j]; o[n * 4 + j] = g * up * __builtin_amdgcn_rcpf(1.f + __expf(-g)); }
                *(u32x2*)rowp = (u32x2){pk4_fp8(o[0], o[1], o[2], o[3]), pk4_fp8(o[4], o[5], o[6], o[7])}; }
    }
};
struct EpiF32 {
    static constexpr bool PERM = true, AFTER_DRAIN = false; static constexpr int NSTORES = 16;
    bf16_t* C; int ldc; const bf16_t* res;
    __device__ __forceinline__ void operator()(const f32x4 (&acc)[2][2][4][2], const Unit& u, int wr, int wc, int fr, int fq) const {
        const int row0 = u.pm * BM + wr * 64 + fr, col0 = u.pc * BM + wc * 32 + 8 * fq;
#pragma unroll
        for (int ai = 0; ai < 2; ++ai)
#pragma unroll
            for (int m = 0; m < 4; ++m) { const size_t off = (size_t)(row0 + ai * HALF + m * 16) * ldc + col0;
#pragma unroll
                for (int bj = 0; bj < 2; ++bj) { f32x4 v0 = acc[ai][bj][m][0], v1 = acc[ai][bj][m][1]; const u32x4 rz = *(const u32x4*)(res + off + bj * HALF);
                    v0[0] += bflo(rz.x); v0[1] += bfhi(rz.x); v0[2] += bflo(rz.y); v0[3] += bfhi(rz.y); v1[0] += bflo(rz.z); v1[1] += bfhi(rz.z); v1[2] += bflo(rz.w); v1[3] += bfhi(rz.w);
                    *(u32x4*)(C + off + bj * HALF) = (u32x4){cvt_pk_bf16(v0[0], v0[1]), cvt_pk_bf16(v0[2], v0[3]), cvt_pk_bf16(v1[0], v1[1]), cvt_pk_bf16(v1[2], v1[3])}; } }
    }
};

__device__ __forceinline__ float fq_reduce(float s) { s += __shfl_xor(s, 16); return half32_add(s); }
__device__ __forceinline__ float slot_sum8(const float* p) { const f32x4 a = *(const f32x4*)p, b = *(const f32x4*)(p + 4); return ((a[0] + a[1]) + (a[2] + a[3])) + ((b[0] + b[1]) + (b[2] + b[3])); }
__device__ __forceinline__ void rowsq_publish(const float (&ss)[2][4], PG8_LAS unsigned char* lds, int pm, int wr, int wc, int fr, int fq, float* slot, int nslot, int sidx, bool active) {
    PG8_LAS float* P = (PG8_LAS float*)lds;
#pragma unroll
    for (int ai = 0; ai < 2; ++ai)
#pragma unroll
        for (int m = 0; m < 4; ++m) if (fq == 0) P[(ai * HALF + wr * 64 + m * 16 + fr) * 4 + wc] = ss[ai][m];
    asm volatile("s_waitcnt lgkmcnt(0)" ::: "memory"); __builtin_amdgcn_s_barrier(); asm volatile("" ::: "memory");
    const int row = threadIdx.x;
    if (row < 256 && active) { const f32x4 q = *(const PG8_LAS f32x4*)(P + row * 4); slot[(size_t)(pm * BM + row) * nslot + sidx] = (q[0] + q[1]) + (q[2] + q[3]); }
    asm volatile("s_waitcnt lgkmcnt(0)" ::: "memory"); __builtin_amdgcn_s_barrier(); asm volatile("" ::: "memory");
}
template <bool H8 = false, bool RF32 = false> struct EpiResNorm {
    static constexpr bool PERM = true, AFTER_DRAIN = true; static constexpr int NSTORES = 0;
    bf16_t* C; int ldc; const void* res; bf16_t* H; const float* gain; float* slot;
    __device__ __forceinline__ void fused(const f32x4 (&acc)[2][2][4][2], const Unit& u, int wr, int wc, int fr, int fq, PG8_LAS unsigned char* lds) const {
        const int row0 = u.pm * BM + wr * 64 + fr, col0 = u.pc * BM + wc * 32 + 8 * fq;
        f32x4 gv[2][2]; float ss[2][4];
#pragma unroll
        for (int bj = 0; bj < 2; ++bj)
#pragma unroll
            for (int n = 0; n < 2; ++n) gv[bj][n] = *(const f32x4*)(gain + col0 + bj * HALF + n * 4);
#pragma unroll
        for (int ai = 0; ai < 2; ++ai)
#pragma unroll
            for (int m = 0; m < 4; ++m) { const int row = row0 + ai * HALF + m * 16; const size_t off = (size_t)row * ldc + col0; float s = 0.f;
#pragma unroll
                for (int bj = 0; bj < 2; ++bj) { f32x4 v0 = acc[ai][bj][m][0], v1 = acc[ai][bj][m][1];
                    if (RF32) { v0 += *(const f32x4*)((const float*)res + off + bj * HALF); v1 += *(const f32x4*)((const float*)res + off + bj * HALF + 4); }
                    else { const u32x4 rz = *(const u32x4*)((const bf16_t*)res + off + bj * HALF);
                        v0[0] += bflo(rz.x); v0[1] += bfhi(rz.x); v0[2] += bflo(rz.y); v0[3] += bfhi(rz.y); v1[0] += bflo(rz.z); v1[1] += bfhi(rz.z); v1[2] += bflo(rz.w); v1[3] += bfhi(rz.w); }
                    *(u32x4*)(C + off + bj * HALF) = (u32x4){cvt_pk_bf16(v0[0], v0[1]), cvt_pk_bf16(v0[2], v0[3]), cvt_pk_bf16(v1[0], v1[1]), cvt_pk_bf16(v1[2], v1[3])};
                    s += ((v0[0] * v0[0] + v0[1] * v0[1]) + (v0[2] * v0[2] + v0[3] * v0[3])) + ((v1[0] * v1[0] + v1[1] * v1[1]) + (v1[2] * v1[2] + v1[3] * v1[3]));
                    const f32x4 h0 = v0 * gv[bj][0], h1 = v1 * gv[bj][1];
                    if (H8) *(u32x2*)((unsigned char*)H + off + bj * HALF) = (u32x2){pk4_fp8(h0[0], h0[1], h0[2], h0[3]), pk4_fp8(h1[0], h1[1], h1[2], h1[3])};
                    else *(u32x4*)(H + off + bj * HALF) = (u32x4){cvt_pk_bf16(h0[0], h0[1]), cvt_pk_bf16(h0[2], h0[3]), cvt_pk_bf16(h1[0], h1[1]), cvt_pk_bf16(h1[2], h1[3])}; }
                ss[ai][m] = fq_reduce(s); }
        rowsq_publish(ss, lds, u.pm, wr, wc, fr, fq, slot, 8, u.pc, true);
    }
};
struct EpiSwiGLUScaled {
    static constexpr bool PERM = true, AFTER_DRAIN = false; static constexpr int NSTORES = 8;
    bf16_t* O; int ldc; const float* slot; float inv_n, eps;
    __device__ __forceinline__ void operator()(const f32x4 (&acc)[2][2][4][2], const Unit& u, int wr, int wc, int fr, int fq) const {
        const int row0 = u.pm * BM + wr * 64 + fr, col0 = u.pc * HALF + wc * 32 + 8 * fq;
#pragma unroll
        for (int ai = 0; ai < 2; ++ai)
#pragma unroll
            for (int m = 0; m < 4; ++m) { const int row = row0 + ai * HALF + m * 16; bf16_t* rowp = O + (size_t)row * ldc + col0;
                const float rs = rsqrtf(slot_sum8(slot + (size_t)row * 8) * inv_n + eps); float o[8];
#pragma unroll
                for (int n = 0; n < 2; ++n)
#pragma unroll
                    for (int j = 0; j < 4; ++j) { const float g = acc[ai][0][m][n][j] * rs, up = acc[ai][1][m][n][j] * rs; o[n * 4 + j] = g * up * __builtin_amdgcn_rcpf(1.f + __expf(-g)); }
                u32x4 w; w.x = cvt_pk_bf16(o[0], o[1]); w.y = cvt_pk_bf16(o[2], o[3]); w.z = cvt_pk_bf16(o[4], o[5]); w.w = cvt_pk_bf16(o[6], o[7]);
                *(u32x4*)rowp = w; }
    }
};
struct EpiSwiGLUScaled8 {
    static constexpr bool PERM = true, AFTER_DRAIN = false; static constexpr int NSTORES = 8;
    unsigned char* O; int ldc; const float* slot; float inv_n, eps;
    __device__ __forceinline__ void operator()(const f32x4 (&acc)[2][2][4][2], const Unit& u, int wr, int wc, int fr, int fq) const {
        const int row0 = u.pm * BM + wr * 64 + fr, col0 = u.pc * HALF + wc * 32 + 8 * fq;
#pragma unroll
        for (int ai = 0; ai < 2; ++ai)
#pragma unroll
            for (int m = 0; m < 4; ++m) { const int row = row0 + ai * HALF + m * 16; unsigned char* rowp = O + (size_t)row * ldc + col0;
                const float rs = rsqrtf(slot_sum8(slot + (size_t)row * 8) * inv_n + eps); float o[8];
#pragma unroll
                for (int n = 0; n < 2; ++n)
#pragma unroll
                    for (int j = 0; j < 4; ++j) { const float g = acc[ai][0][m][n][j] * rs, up = acc[ai][1][m][n][j] * rs; o[n * 4 + j] = g * up * __builtin_amdgcn_rcpf(1.f + __expf(-g)); }
                *(u32x2*)rowp = (u32x2){pk4_fp8(o[0], o[1], o[2], o[3]), pk4_fp8(o[4], o[5], o[6], o[7])}; }
    }
};
struct EpiLatent {
    static constexpr bool PERM = false, AFTER_DRAIN = true; static constexpr int NSTORES = 0;
    bf16_t* O; float* kr; const float* slot_x; float* slot_cq; float* slot_ckv; const float* g_cq; const float* g_ckv; float inv_n, eps;
    __device__ __forceinline__ void fused(const f32x4 (&acc)[2][2][4][2], const Unit& u, int wr, int wc, int fr, int fq, PG8_LAS unsigned char* lds) const {
        const int row0 = u.pm * BM + wr * 64 + fr, ct = wc * 32 + 4 * fq;
        const bool lat = u.pc < 4;
        const float* gain = (u.pc < 2 ? g_cq + u.pc * BM : g_ckv + (u.pc - 2) * BM);
        f32x4 gv[2][2]; float ss[2][4];
#pragma unroll
        for (int bj = 0; bj < 2; ++bj)
#pragma unroll
            for (int n = 0; n < 2; ++n) gv[bj][n] = lat ? *(const f32x4*)(gain + ct + bj * HALF + n * 16) : (f32x4){0.f, 0.f, 0.f, 0.f};
#pragma unroll
        for (int ai = 0; ai < 2; ++ai)
#pragma unroll
            for (int m = 0; m < 4; ++m) { const int row = row0 + ai * HALF + m * 16; const float rs = rsqrtf(slot_sum8(slot_x + (size_t)row * 8) * inv_n + eps); float s = 0.f;
                if (lat) {
#pragma unroll
                    for (int bj = 0; bj < 2; ++bj)
#pragma unroll
                        for (int n = 0; n < 2; ++n) { const f32x4 v = acc[ai][bj][m][n] * rs; s += (v[0] * v[0] + v[1] * v[1]) + (v[2] * v[2] + v[3] * v[3]); const f32x4 h = v * gv[bj][n];
                            *(u32x2*)(O + (size_t)row * 1024 + u.pc * BM + ct + bj * HALF + n * 16) = (u32x2){cvt_pk_bf16(h[0], h[1]), cvt_pk_bf16(h[2], h[3])}; }
                } else {
#pragma unroll
                    for (int n = 0; n < 2; ++n) { const int c = ct + n * 16; if (c < 64) *(f32x4*)(kr + (size_t)row * 64 + c) = acc[ai][0][m][n] * rs; }
                }
                ss[ai][m] = fq_reduce(s); }
        rowsq_publish(ss, lds, u.pm, wr, wc, fr, fq, (u.pc < 2 ? slot_cq : slot_ckv), 2, u.pc & 1, lat);
    }
};
static_assert(SEQ == 4096, "EpiBf16Dual splits the row index with a shift");
struct EpiBf16Dual {
    static constexpr bool PERM = true, AFTER_DRAIN = false; static constexpr int NSTORES = 16;
    bf16_t* O; int ldc; const float* slot_cq; const float* slot_ckv; float inv_n, eps; bf16_t* VT; int seq;
    __device__ __forceinline__ void operator()(const f32x4 (&acc)[2][2][4][2], const Unit& u, int wr, int wc, int fr, int fq) const {
        const int row0 = u.pm * BM + wr * 64 + fr, col0 = u.pc * BM + wc * 32 + 8 * fq; const bool kv = (u.pn >= 12); const float* sl = kv ? slot_ckv : slot_cq;
        const bool odd = fr & 1;
#pragma unroll
        for (int ai = 0; ai < 2; ++ai)
#pragma unroll
            for (int m = 0; m < 4; ++m) { const int row = row0 + ai * HALF + m * 16; bf16_t* rowp = O + (size_t)row * ldc + col0; const f32x2 sq = *(const f32x2*)(sl + (size_t)row * 2); const float rs = rsqrtf((sq[0] + sq[1]) * inv_n + eps);
                { const f32x4 v0 = acc[ai][0][m][0] * rs, v1 = acc[ai][0][m][1] * rs;
                  u32x4 w; w.x = cvt_pk_bf16(v0[0], v0[1]); w.y = cvt_pk_bf16(v0[2], v0[3]); w.z = cvt_pk_bf16(v1[0], v1[1]); w.w = cvt_pk_bf16(v1[2], v1[3]);
                  *(u32x4*)rowp = w; }
                const f32x4 v0 = acc[ai][1][m][0] * rs, v1 = acc[ai][1][m][1] * rs;
                if (!kv) { u32x4 w; w.x = cvt_pk_bf16(v0[0], v0[1]); w.y = cvt_pk_bf16(v0[2], v0[3]); w.z = cvt_pk_bf16(v1[0], v1[1]); w.w = cvt_pk_bf16(v1[2], v1[3]);
                    *(u32x4*)(rowp + HALF) = w; }
                else { const int bq = row >> 12, sq_ = row & 4095, hd = u.pn - 12;
                    bf16_t* vt = VT + (((size_t)bq * 16 + hd) * 128 + wc * 32 + 8 * fq) * seq + (sq_ & ~1);
                    const float val[8] = {v0[0], v0[1], v0[2], v0[3], v1[0], v1[1], v1[2], v1[3]};
#pragma unroll
                    for (int i = 0; i < 8; i += 2) { const float send = odd ? val[i] : val[i + 1];
                        const float recv = __builtin_bit_cast(float, __builtin_amdgcn_update_dpp(0, __builtin_bit_cast(int, send), 0xB1, 0xf, 0xf, true));
                        const unsigned pr = odd ? cvt_pk_bf16(recv, val[i + 1]) : cvt_pk_bf16(val[i], recv);
                        *(unsigned*)(vt + (size_t)(i + (odd ? 1 : 0)) * seq) = pr; } } }
    }
};

struct OneUnit { Unit u; bool on;
    __device__ __forceinline__ bool next(int i, Unit& o) const { if (i != 0 || !on) return false; o = u; return true; }
    __device__ __forceinline__ int rowoff(int, int) const { return 0; } };
struct EpiSplitK {
    static constexpr bool PERM = true, AFTER_DRAIN = true; static constexpr int NSTORES = 16;
    bf16_t* O; int ldc; float* part; unsigned* flag; int slice;
    __device__ __forceinline__ void fused(const f32x4 (&acc)[2][2][4][2], const Unit& u, int wr, int wc, int fr, int fq, PG8_LAS unsigned char* lds) const {
        const int tid = threadIdx.x;
        if (slice != 0) {
            f32x4* p = (f32x4*)part + (size_t)(slice - 1) * (32 * 512) + tid;
#pragma unroll
            for (int ai = 0; ai < 2; ++ai)
#pragma unroll
                for (int bj = 0; bj < 2; ++bj)
#pragma unroll
                    for (int m = 0; m < 4; ++m)
#pragma unroll
                        for (int n = 0; n < 2; ++n) p[(((ai * 2 + bj) * 4 + m) * 2 + n) * 512] = acc[ai][bj][m][n];
            asm volatile("s_waitcnt vmcnt(0)" ::: "memory");
            __syncthreads();
            if (tid == 0) { __builtin_amdgcn_fence(__ATOMIC_RELEASE, "agent"); asm volatile("s_waitcnt vmcnt(0)" ::: "memory"); (void)__hip_atomic_fetch_add(flag, 1u, __ATOMIC_RELAXED, __HIP_MEMORY_SCOPE_AGENT); }
        } else {
            if (tid == 0) { unsigned sp = 0; while (__hip_atomic_load(flag, __ATOMIC_RELAXED, __HIP_MEMORY_SCOPE_AGENT) < 3u) { __builtin_amdgcn_s_sleep(1); if (++sp > (1u << 22)) break; }
                __builtin_amdgcn_fence(__ATOMIC_ACQUIRE, "agent"); asm volatile("s_waitcnt vmcnt(0)" ::: "memory"); }
            __syncthreads();
            const f32x4* p = (const f32x4*)part + tid;
            const int row0 = u.pm * BM + wr * 64 + fr, col0 = u.pc * BM + wc * 32 + 8 * fq;
#pragma unroll
            for (int ai = 0; ai < 2; ++ai)
#pragma unroll
                for (int m = 0; m < 4; ++m) { bf16_t* rowp = O + (size_t)(row0 + ai * HALF + m * 16) * ldc + col0;
#pragma unroll
                    for (int bj = 0; bj < 2; ++bj) { const int j0 = ((ai * 2 + bj) * 4 + m) * 2;
                        const f32x4 v0 = ((acc[ai][bj][m][0] + p[j0 * 512]) + p[(32 + j0) * 512]) + p[(64 + j0) * 512], v1 = ((acc[ai][bj][m][1] + p[(j0 + 1) * 512]) + p[(33 + j0) * 512]) + p[(65 + j0) * 512];
                        u32x4 w; w.x = cvt_pk_bf16(v0[0], v0[1]); w.y = cvt_pk_bf16(v0[2], v0[3]); w.z = cvt_pk_bf16(v1[0], v1[1]); w.w = cvt_pk_bf16(v1[2], v1[3]);
                        *(u32x4*)(rowp + bj * HALF) = w; } }
        }
    }
};

template <class Epi, class Sched, bool ALIGN_EPI = true, bool SP2 = true, bool FP8 = false, bool GATHER = false>
__device__ __forceinline__ void gemm_phase(PG8_LAS unsigned char* lds, const Gemm g, const Sched& S, const Epi& E) {
    const int tid = threadIdx.x, wid = __builtin_amdgcn_readfirstlane(tid >> 6), lane = tid & 63, wr = wid >> 2, wc = wid & 3, fr = lane & 15, fq = lane >> 4;
    const int K = g.K, nt = K / BK;
    unsigned voffA[2], voffB[2];
#pragma unroll
    for (int i = 0; i < 2; ++i) { int R, C; stage_rc(tid * 16 + i * 8192, R, C); const int Rb = Epi::PERM ? ((R & ~31) + perm32(R & 31)) : R;
        voffA[i] = (unsigned)(R * g.lda + C) * 2u; voffB[i] = (unsigned)(Rb * g.ldb + C) * 2u; }
    unsigned vAc[2][2] = {{0u, 0u}, {0u, 0u}}; unsigned (&vAn)[2][2] = vAc; int Rg0 = 0, Cg2 = 0;
    if constexpr (GATHER) { static_assert(SP2, "gather: SP2 form only"); int C0; stage_rc(tid * 16, Rg0, C0); Cg2 = 2 * C0; }
#define PG8_GOFF(dst, ui_) do { _Pragma("unroll") for (int h_ = 0; h_ < 2; ++h_) _Pragma("unroll") for (int i_ = 0; i_ < 2; ++i_) dst[h_][i_] = (unsigned)(S.rowoff(ui_, h_ * HALF + 64 * i_ + Rg0) + Cg2); } while (0)
#define PG8_STAGE_A(bufoff, gbase, h, nx) do { if constexpr (GATHER) { unsigned v_[2] = {(nx) ? vAn[h][0] : vAc[h][0], (nx) ? vAn[h][1] : vAc[h][1]}; PG8_STAGE(bufoff, gbase, v_); } \
        else PG8_STAGE(bufoff, (gbase) + (h) * hstepA, voffA); } while (0)
    const size_t kstep = (size_t)(BK * 2);
    const size_t hstepA = (size_t)HALF * g.lda * 2, hstepB = (size_t)HALF * g.ldb * 2;
    const size_t tstepA = 2 * hstepA, tstepB = 2 * hstepB;
    const unsigned ldsw = (unsigned)wid * 1024u;
    const int aoff = lds_byte(wr * 64 + fr, fq * 8), boff = lds_byte(wc * 32 + fr, fq * 8);
#define PG8_SA(b, h) (((b) * 2 + (h)) * HTB)
#define PG8_SB(b, h) ((4 + (b) * 2 + (h)) * HTB)
#define PG8_STAGE(bufoff, gbase, voff) do { _Pragma("unroll") for (int _i = 0; _i < 2; ++_i) \
        __builtin_amdgcn_global_load_lds((const unsigned*)((const char*)(gbase) + (voff)[_i]), (PG8_LAS unsigned*)(lds + (bufoff) + ldsw + _i * 8192), 16, 0, 0); } while (0)
#define PG8_LDA(dst, b, h) do { _Pragma("unroll") for (int m = 0; m < 4; ++m) { \
        if constexpr (FP8) { dst##8[m].lo = *(const PG8_LAS i32x4*)(lds + PG8_SA(b, h) + aoff + m * 2048); dst##8[m].hi = *(const PG8_LAS i32x4*)(lds + PG8_SA(b, h) + aoff + m * 2048 + 1024); } \
        else { _Pragma("unroll") for (int k = 0; k < 2; ++k) dst[m][k] = *(const PG8_LAS bf16x8*)(lds + PG8_SA(b, h) + aoff + m * 2048 + k * 1024); } } } while (0)
#define PG8_LDB(dst, b, h) do { _Pragma("unroll") for (int n = 0; n < 2; ++n) { \
        if constexpr (FP8) { dst##8[n].lo = *(const PG8_LAS i32x4*)(lds + PG8_SB(b, h) + boff + n * 2048); dst##8[n].hi = *(const PG8_LAS i32x4*)(lds + PG8_SB(b, h) + boff + n * 2048 + 1024); } \
        else { _Pragma("unroll") for (int k = 0; k < 2; ++k) dst[n][k] = *(const PG8_LAS bf16x8*)(lds + PG8_SB(b, h) + boff + n * 2048 + k * 1024); } } } while (0)
#define PG8_MMA(ai, bj, At, Bt) do { __builtin_amdgcn_s_setprio(1); \
        if constexpr (FP8) { _Pragma("unroll") for (int m = 0; m < 4; ++m) _Pragma("unroll") for (int n = 0; n < 2; ++n) \
            asm volatile("v_mfma_scale_f32_16x16x128_f8f6f4 %0, %1, %2, %0, %3, %4 op_sel_hi:[0,0,0]" : "+v"(acc[ai][bj][m][n]) : "v"(Bt##8[n]), "v"(At##8[m]), "v"(sclW), "v"(sclX)); } \
        else { _Pragma("unroll") for (int m = 0; m < 4; ++m) _Pragma("unroll") for (int n = 0; n < 2; ++n) _Pragma("unroll") for (int k = 0; k < 2; ++k) \
            acc[ai][bj][m][n] = __builtin_amdgcn_mfma_f32_16x16x32_bf16(Bt[n][k], At[m][k], acc[ai][bj][m][n], 0, 0, 0); } \
          \
        __builtin_amdgcn_s_setprio(0); } while (0)
#define PG8_WAIT_V(n) asm volatile("s_waitcnt vmcnt(" #n ")" ::: "memory")
#define PG8_WAIT_L(n) asm volatile("s_waitcnt lgkmcnt(" #n ")" ::: "memory")
#define PG8_WAIT_V8R(relax_) do { if (relax_) asm volatile("s_waitcnt vmcnt(%0)" :: "i"(8 + Epi::NSTORES) : "memory"); else asm volatile("s_waitcnt vmcnt(8)" ::: "memory"); } while (0)
#define PG8_BAR __builtin_amdgcn_s_barrier()
#define PG8_SCHED __builtin_amdgcn_sched_barrier(0)
    Unit cur, nxt; int ui = 0;
    if (!S.next(0, cur)) return;
    f32x4 acc[2][2][4][2];
#pragma unroll
    for (int a = 0; a < 2; ++a)
#pragma unroll
        for (int b = 0; b < 2; ++b)
#pragma unroll
            for (int m = 0; m < 4; ++m)
#pragma unroll
                for (int n = 0; n < 2; ++n) acc[a][b][m][n] = (f32x4){0.f, 0.f, 0.f, 0.f};
    const int sclW = 0x79797979, sclX = 0x7f7f7f7f;
    bf16x8 At[4][2], B0[2][2], B1[2][2]; i32x8 At8[4], B08[2], B18[2];
    const char* cA = (const char*)g.A + (GATHER ? (size_t)0 : (size_t)cur.pm * tstepA) + cur.aoff; const char* cB = (const char*)g.Bt + (size_t)cur.pn * tstepB;
    if constexpr (GATHER) PG8_GOFF(vAc, 0);
    if constexpr (SP2) {
        PG8_STAGE(PG8_SB(0, 0), cB, voffB); PG8_STAGE(PG8_SB(0, 1), cB + hstepB, voffB); PG8_STAGE_A(PG8_SA(0, 0), cA, 0, false); PG8_STAGE_A(PG8_SA(0, 1), cA, 1, false);
        if (wr == 1) PG8_BAR;
        PG8_WAIT_V(2); PG8_BAR;
        PG8_STAGE(PG8_SB(1, 0), cB + kstep, voffB); PG8_STAGE_A(PG8_SA(1, 0), cA + kstep, 0, false); PG8_STAGE(PG8_SB(1, 1), cB + hstepB + kstep, voffB);
        PG8_WAIT_V(6); PG8_BAR;
    } else {
        PG8_STAGE(PG8_SB(0, 0), cB, voffB); PG8_STAGE(PG8_SA(0, 0), cA, voffA); PG8_STAGE(PG8_SB(0, 1), cB + hstepB, voffB); PG8_STAGE(PG8_SA(0, 1), cA + hstepA, voffA);
        if (wr == 1) PG8_BAR;
        PG8_WAIT_V(4); PG8_BAR;
        PG8_STAGE(PG8_SB(1, 0), cB + kstep, voffB); PG8_STAGE(PG8_SA(1, 0), cA + kstep, voffA); PG8_STAGE(PG8_SB(1, 1), cB + hstepB + kstep, voffB);
        PG8_WAIT_V(6); PG8_BAR;
    }
    for (;;) {
        const bool has_next = S.next(ui + 1, nxt);
        const char* nA = has_next ? (const char*)g.A + (GATHER ? (size_t)0 : (size_t)nxt.pm * tstepA) + nxt.aoff : cA;
        const char* nB = has_next ? (const char*)g.Bt + (size_t)nxt.pn * tstepB : cB;
        for (int t = 0; t < nt; t += 2) {
            const bool last = (t == nt - 2);
            const char* a1 = cA + (size_t)(t + 1) * kstep;
            const char* a2 = last ? nA : cA + (size_t)(t + 2) * kstep; const char* b2 = last ? nB : cB + (size_t)(t + 2) * kstep;
            const char* a3 = a2 + kstep; const char* b3 = b2 + kstep;
            if constexpr (SP2) {
            unsigned vAn[2][2] = {{vAc[0][0], vAc[0][1]}, {vAc[1][0], vAc[1][1]}};
            if constexpr (GATHER) { if (last && has_next) PG8_GOFF(vAn, ui + 1); }
            constexpr bool relax = false;
            PG8_LDB(B0, 0, 0); PG8_LDB(B1, 0, 1); PG8_SCHED; PG8_LDA(At, 0, 0); PG8_STAGE_A(PG8_SA(1, 1), a1, 1, false);
            PG8_WAIT_V8R(relax); PG8_WAIT_L(0); PG8_BAR; PG8_MMA(0, 0, At, B0); PG8_MMA(0, 1, At, B1); PG8_BAR; PG8_SCHED;
            PG8_LDA(At, 0, 1); PG8_STAGE(PG8_SB(0, 0), b2, voffB); PG8_STAGE(PG8_SB(0, 1), b2 + hstepB, voffB); PG8_STAGE_A(PG8_SA(0, 0), a2, 0, last);
            PG8_WAIT_V8R(relax); PG8_WAIT_L(0); PG8_BAR; PG8_MMA(1, 0, At, B0); PG8_MMA(1, 1, At, B1); PG8_BAR; PG8_SCHED;
            PG8_LDB(B0, 1, 0); PG8_LDB(B1, 1, 1); PG8_SCHED; PG8_LDA(At, 1, 0); PG8_STAGE_A(PG8_SA(0, 1), a2, 1, last);
            PG8_WAIT_V(8); PG8_WAIT_L(0); PG8_BAR; PG8_MMA(0, 0, At, B0); PG8_MMA(0, 1, At, B1); PG8_BAR; PG8_SCHED;
            PG8_LDA(At, 1, 1); PG8_STAGE(PG8_SB(1, 0), b3, voffB); PG8_STAGE(PG8_SB(1, 1), b3 + hstepB, voffB); PG8_STAGE_A(PG8_SA(1, 0), a3, 0, last);
            PG8_WAIT_V(8); PG8_WAIT_L(0); PG8_BAR; PG8_MMA(1, 0, At, B0); PG8_MMA(1, 1, At, B1); PG8_BAR; PG8_SCHED;
            } else {
            PG8_LDB(B0, 0, 0); PG8_SCHED; PG8_LDA(At, 0, 0); PG8_STAGE(PG8_SA(1, 1), a1 + hstepA, voffA);
            PG8_WAIT_L(8); PG8_BAR; PG8_WAIT_L(0); PG8_MMA(0, 0, At, B0); PG8_BAR; PG8_SCHED;
            PG8_LDB(B1, 0, 1); PG8_STAGE(PG8_SB(0, 0), b2, voffB);
            PG8_BAR; PG8_WAIT_L(0); PG8_MMA(0, 1, At, B1); PG8_BAR;
            PG8_LDA(At, 0, 1); PG8_STAGE(PG8_SA(0, 0), a2, voffA);
            PG8_BAR; PG8_WAIT_L(0); PG8_MMA(1, 0, At, B0); PG8_BAR; PG8_SCHED;
            PG8_STAGE(PG8_SB(0, 1), b2 + hstepB, voffB);
            PG8_WAIT_V(6); PG8_BAR; PG8_MMA(1, 1, At, B1); PG8_BAR;
            PG8_LDB(B0, 1, 0); PG8_SCHED; PG8_LDA(At, 1, 0); PG8_STAGE(PG8_SA(0, 1), a2 + hstepA, voffA);
            PG8_WAIT_L(8); PG8_BAR; PG8_WAIT_L(0); PG8_MMA(0, 0, At, B0); PG8_BAR; PG8_SCHED;
            PG8_LDB(B1, 1, 1); PG8_STAGE(PG8_SB(1, 0), b3, voffB);
            PG8_BAR; PG8_WAIT_L(0); PG8_MMA(0, 1, At, B1); PG8_BAR;
            PG8_LDA(At, 1, 1); PG8_STAGE(PG8_SA(1, 0), a3, voffA);
            PG8_BAR; PG8_WAIT_L(0); PG8_MMA(1, 0, At, B0); PG8_BAR; PG8_SCHED;
            PG8_STAGE(PG8_SB(1, 1), b3 + hstepB, voffB);
            PG8_WAIT_V(6); PG8_BAR; PG8_MMA(1, 1, At, B1); PG8_BAR;
            }
        }
        if constexpr (ALIGN_EPI) { if (wr == 0) PG8_BAR; }
        asm volatile("s_nop 15\n\ts_nop 15" ::: "memory");
        if constexpr (!Epi::AFTER_DRAIN) E(acc, cur, wr, wc, fr, fq);
        if (!has_next) break;
#pragma unroll
        for (int a = 0; a < 2; ++a)
#pragma unroll
            for (int b = 0; b < 2; ++b)
#pragma unroll
                for (int m = 0; m < 4; ++m)
#pragma unroll
                    for (int n = 0; n < 2; ++n) acc[a][b][m][n] = (f32x4){0.f, 0.f, 0.f, 0.f};
        cur = nxt; cA = nA; cB = nB; ++ui;
        if constexpr (GATHER) PG8_GOFF(vAc, ui);
        if constexpr (ALIGN_EPI) { if (wr == 1) PG8_BAR; }
    }
    PG8_WAIT_V(0);
    if constexpr (!ALIGN_EPI) { if (wr == 0) PG8_BAR; }
    PG8_BAR;
    if constexpr (Epi::AFTER_DRAIN) E.fused(acc, cur, wr, wc, fr, fq, lds);
#undef PG8_SA
#undef PG8_SB
#undef PG8_STAGE
#undef PG8_LDA
#undef PG8_LDB
#undef PG8_MMA
#undef PG8_WAIT_V
#undef PG8_WAIT_L
#undef PG8_GOFF
#undef PG8_STAGE_A
#undef PG8_WAIT_V8R
#undef PG8_BAR
#undef PG8_SCHED
}
}
#define XB_TMO      128
#define XB_XCNT(j)  (256  + 64 * (j))
#define XB_XSUB(j)  (1280 + 64 * (j))
#define XB_XGEN(j)  (2304 + 64 * (j))
#define XB_TOP      3328
#define XB_TOPGEN   3392
#define XCD_BAR_WORDS 3456
#define XB_SPIN_CAP (1u << 18)

__device__ __forceinline__ unsigned xb_ld(unsigned* p)              { return __hip_atomic_load(p, __ATOMIC_RELAXED, __HIP_MEMORY_SCOPE_AGENT); }
__device__ __forceinline__ unsigned xb_add(unsigned* p, unsigned v) { return __hip_atomic_fetch_add(p, v, __ATOMIC_RELAXED, __HIP_MEMORY_SCOPE_AGENT); }
__device__ __forceinline__ unsigned xb_xcc_id() { return (unsigned)__builtin_amdgcn_s_getreg((3 << 11) | 20) & 0xFu; }
#define XB_SPIN(cond, bar) do { unsigned _sp = 0; while (cond) { __builtin_amdgcn_s_sleep(1); \
    if ((++_sp & 255u) == 0u) { if (xb_ld(&(bar)[XB_TMO])) break; if (_sp > XB_SPIN_CAP) { atomicAdd(&(bar)[XB_TMO], 1u); break; } } } } while (0)

struct XcdBarrier { unsigned* bar; unsigned x; volatile LAS unsigned* st; };

__device__ __forceinline__ XcdBarrier xcd_barrier_post(unsigned* bar, volatile LAS unsigned* st) {
    XcdBarrier b; b.bar = bar; b.x = xb_xcc_id(); b.st = st;
    if (threadIdx.x == 0) (void)xb_add(&bar[XB_XCNT(b.x)], 1u);
    return b;
}
__device__ __forceinline__ void xcd_barrier_complete(unsigned* bar, unsigned x, unsigned& nloc, unsigned& nx) {
    const unsigned G = gridDim.x * gridDim.y * gridDim.z;
    unsigned sum, cnt, mine, sp = 0u;
    for (;;) {
        sum = 0u; cnt = 0u; mine = 0u;
#pragma unroll
        for (unsigned j = 0; j < 16; ++j) { const unsigned c = xb_ld(&bar[XB_XCNT(j)]); sum += c; cnt += (c > 0u) ? 1u : 0u; mine = (j == x) ? c : mine; }
        if (sum == G) break;
        __builtin_amdgcn_s_sleep(1);
        if ((++sp & 255u) == 0u) { if (xb_ld(&bar[XB_TMO])) break; if (sp > XB_SPIN_CAP) { atomicAdd(&bar[XB_TMO], 1u); break; } }
    }
    nloc = mine > 0u ? mine : 1u; nx = cnt > 0u ? cnt : 1u;
}
__device__ __forceinline__ void xcd_barrier(const XcdBarrier& b) {
    asm volatile("s_waitcnt vmcnt(0)" ::: "memory");
    __syncthreads();
    if (threadIdx.x == 0) {
        unsigned* bar = b.bar;
        __builtin_amdgcn_s_waitcnt(0);
        unsigned nloc = b.st[0], nx = b.st[1];
        if (nloc == 0u) { xcd_barrier_complete(bar, b.x, nloc, nx); b.st[0] = nloc; b.st[1] = nx; }
        const unsigned old = xb_add(&bar[XB_XSUB(b.x)], 1u);
        const unsigned gen = old / nloc;
        if (old + 1u == (gen + 1u) * nloc) {
            __builtin_amdgcn_fence(__ATOMIC_RELEASE, "agent");
            asm volatile("s_waitcnt vmcnt(0)" ::: "memory");
            (void)xb_add(&bar[XB_TOP], 1u);
        }
        { const unsigned target = (gen + 1u) * nx; XB_SPIN(xb_ld(&bar[XB_TOP]) < target, bar); }
        __builtin_amdgcn_fence(__ATOMIC_ACQUIRE, "agent");
        asm volatile("s_waitcnt vmcnt(0)" ::: "memory");
    }
    __syncthreads();
}

struct Ctx {
    LAS unsigned char* lds;
    int tid, lane, wave, wg, nwg;
    const float *x; const int* pos;
    const float *g_mix, *g_ffn, *w_in, *conv_w, *b_gates, *g_mo, *g_ro, *w_mix_out, *ffn_gate, *ffn_up, *ffn_down;
    const float *w_dqkv, *g_cq, *g_ckv, *w_uq, *w_ukv, *g_qn, *g_qr, *g_kn, *g_kr, *w_o, *w_router, *we_gate, *we_up, *we_down;
    float* out; unsigned char* ws;
};

template <bool Q8 = false>
__device__ __forceinline__ void transpose_item(const float* src, int lds_, bf16_t* dst, int ldd, LAS float* scr, int lane) {
    f32x4 v[8]; const int l8 = lane & 7, kr = lane >> 3;
#pragma unroll
    for (int i = 0; i < 8; ++i) v[i] = *(const f32x4*)(src + (size_t)(kr + 8 * i) * lds_ + 4 * l8);
#pragma unroll
    for (int i = 0; i < 8; ++i) { LAS float* d = scr + (kr + 8 * i) * 33 + 4 * l8; d[0] = v[i][0]; d[1] = v[i][1]; d[2] = v[i][2]; d[3] = v[i][3]; }
    LDS_WAIT(); asm volatile("" ::: "memory");
    const int c = lane & 7;
#pragma unroll
    for (int j = 0; j < 4; ++j) { const int n = (lane >> 3) + 8 * j; const LAS float* s = scr + (8 * c) * 33 + n;
        u32x4 o; o.x = cvt_pk_bf16(s[0 * 33], s[1 * 33]); o.y = cvt_pk_bf16(s[2 * 33], s[3 * 33]); o.z = cvt_pk_bf16(s[4 * 33], s[5 * 33]); o.w = cvt_pk_bf16(s[6 * 33], s[7 * 33]);
        *(u32x4*)(dst + (size_t)n * ldd + 8 * c) = o; }
    LDS_WAIT(); asm volatile("" ::: "memory");
}
template <bool Q8 = false>
__device__ __forceinline__ void tr_plain(const float* W, int K, int N, bf16_t* WT, int r, LAS float* scr, int lane) {
    const int nblk = N / 32, kb = r / nblk, nb = r % nblk;
    transpose_item<Q8>(W + (size_t)(64 * kb) * N + 32 * nb, N, WT + (size_t)(32 * nb) * K + 64 * kb, K, scr, lane);
}
template <bool Q8 = false>
__device__ __forceinline__ void tr_gu(const float* Wg, const float* Wu, bf16_t* WT, int r, LAS float* scr, int lane) {
    constexpr int nblk = (2 * DFF) / 32; const int kb = r / nblk, nb = r % nblk, n0 = 32 * nb, j = n0 >> 8, within = n0 & 255;
    const float* src = (within < 128 ? Wg : Wu) + (size_t)(64 * kb) * DFF + 128 * j + (within & 127);
    transpose_item<Q8>(src, DFF, WT + (size_t)n0 * D + 64 * kb, D, scr, lane);
}
__device__ __forceinline__ void transpose_item8(const float* src, int lds_, unsigned char* dst, int ldd, LAS float* scr, int lane) {
    f32x4 v[2][8]; const int l8 = lane & 7, kr = lane >> 3;
#pragma unroll
    for (int hf = 0; hf < 2; ++hf)
#pragma unroll
        for (int i = 0; i < 8; ++i) v[hf][i] = *(const f32x4*)(src + (size_t)(64 * hf + kr + 8 * i) * lds_ + 4 * l8);
#pragma unroll
    for (int hf = 0; hf < 2; ++hf) {
#pragma unroll
        for (int i = 0; i < 8; ++i) { LAS float* d = scr + (kr + 8 * i) * 33 + 4 * l8; d[0] = v[hf][i][0]; d[1] = v[hf][i][1]; d[2] = v[hf][i][2]; d[3] = v[hf][i][3]; }
        LDS_WAIT(); asm volatile("" ::: "memory");
        const int n = lane >> 1, hh = lane & 1; const LAS float* sp = scr + (32 * hh) * 33 + n; unsigned w[8];
#pragma unroll
        for (int q = 0; q < 8; ++q) w[q] = pk4_fp8(sp[(4 * q) * 33] * W8_SCALE, sp[(4 * q + 1) * 33] * W8_SCALE, sp[(4 * q + 2) * 33] * W8_SCALE, sp[(4 * q + 3) * 33] * W8_SCALE);
        unsigned char* d = dst + (size_t)n * ldd + 64 * hf + 32 * hh;
        *(u32x4*)d = (u32x4){w[0], w[1], w[2], w[3]}; *(u32x4*)(d + 16) = (u32x4){w[4], w[5], w[6], w[7]};
        LDS_WAIT(); asm volatile("" ::: "memory");
    }
}
__device__ __forceinline__ void zero_item(bf16_t* dst, int ldd, int lane) {
#pragma unroll
    for (int j = 0; j < 4; ++j) { const int n = (lane >> 3) + 8 * j; *(u32x4*)(dst + (size_t)n * ldd + 8 * (lane & 7)) = (u32x4){0u, 0u, 0u, 0u}; }
}

constexpr int I_WIN = 32 * 256, I_WOUT = 32 * 64, I_WGU = 32 * 352, I_WD = 88 * 64, I_WDQKV = 32 * 40, I_WUQ = 8 * 96, I_WUKV = 8 * 128, I_WO = 32 * 64;
constexpr int I_DENSE = I_WIN + I_WOUT + I_WGU + I_WD + I_WDQKV + I_WUQ + I_WUKV + I_WO;
constexpr int I_EGU8 = 16 * 352, I_ED8 = 44 * 64;
constexpr int I_EXP = I_EGU8 + I_ED8;
constexpr int I_TOTAL = I_DENSE + NEXP * I_EXP;

__device__ __forceinline__ void weight_item(const Ctx& C, int it, LAS float* scr) {
    int r = it; unsigned char* ws = C.ws; const int lane = C.lane;
    if (r < I_WIN) { constexpr int nblk = 256; const int kb = r / nblk, nb = r % nblk, n0 = 32 * nb, sc = n0 + (n0 >= 4096 ? 8 : 0);
        transpose_item(C.w_in + (size_t)(64 * kb) * IN_COLS + sc, IN_COLS, (bf16_t*)(ws + WS_WIN) + (size_t)n0 * D + 64 * kb, D, scr, lane); return; } r -= I_WIN;
    if (r < I_WOUT) { tr_plain(C.w_mix_out, D, D, (bf16_t*)(ws + WS_WOUT), r, scr, lane); return; } r -= I_WOUT;
    if (r < I_WGU) { tr_gu<(FP8_EMU >= 2)>(C.ffn_gate, C.ffn_up, (bf16_t*)(ws + WS_WGU), r, scr, lane); return; } r -= I_WGU;
    if (r < I_WD) { tr_plain<(FP8_EMU >= 2)>(C.ffn_down, DFF, D, (bf16_t*)(ws + WS_WD), r, scr, lane); return; } r -= I_WD;
    if (r < I_WDQKV) { constexpr int nblk = 40; const int kb = r / nblk, nb = r % nblk; bf16_t* dst = (bf16_t*)(ws + WS_WDQKV) + (size_t)(32 * nb) * D + 64 * kb;
        if (nb < 34) transpose_item(C.w_dqkv + (size_t)(64 * kb) * 1088 + 32 * nb, 1088, dst, D, scr, lane); else zero_item(dst, D, lane); return; } r -= I_WDQKV;
    if (r < I_WUQ) { tr_plain(C.w_uq, 512, 3072, (bf16_t*)(ws + WS_WUQKV), r, scr, lane); return; } r -= I_WUQ;
    if (r < I_WUKV) { tr_plain(C.w_ukv, 512, 4096, (bf16_t*)(ws + WS_WUQKV) + (size_t)3072 * 512, r, scr, lane); return; } r -= I_WUKV;
    if (r < I_WO) { tr_plain(C.w_o, D, D, (bf16_t*)(ws + WS_WO), r, scr, lane); return; } r -= I_WO;
    const int e = r / I_EXP; r -= e * I_EXP;
    if (r < I_EGU8) { constexpr int nblk = 352; const int kb = r / nblk, nb = r % nblk, n0 = 32 * nb, j = n0 >> 8, within = n0 & 255;
        const float* src = (within < 128 ? C.we_gate : C.we_up) + (size_t)e * D * DFF + (size_t)(128 * kb) * DFF + 128 * j + (within & 127);
        transpose_item8(src, DFF, ws + WS_WEGU + ((size_t)e * 2 * DFF + n0) * D + 128 * kb, D, scr, lane); return; } r -= I_EGU8;
    { constexpr int nblk = 64; const int kb = r / nblk, nb = r % nblk;
        transpose_item8(C.we_down + (size_t)e * DFF * D + (size_t)(128 * kb) * D + 32 * nb, D, ws + WS_WED + ((size_t)e * D + 32 * nb) * DFF + 128 * kb, DFF, scr, lane); }
}

constexpr int EXP_ITEMS_GU = 16 * 44, EXP_ITEMS_D = 44 * 8, EXP_ITEMS = EXP_ITEMS_GU + EXP_ITEMS_D;
struct ExpItem { const float* p; unsigned char* dst; int ld, ldd; };
constexpr int EXP_N_GU = NEXP * EXP_ITEMS_GU, EXP_N_ALL = NEXP * EXP_ITEMS, EXP_N_FFN = EXP_ITEMS_GU, EXP_N_TOTAL = EXP_N_ALL + EXP_N_FFN, EXP_N_FD = EXP_ITEMS_D, EXP_N_TOTAL2 = EXP_N_TOTAL + EXP_N_FD;
__device__ __forceinline__ ExpItem exp_item(const Ctx& C, int it) {
    ExpItem I; const int w = C.wave, l = C.lane;
    if (it < EXP_N_GU) { const int e = it / EXP_ITEMS_GU, r = it - e * EXP_ITEMS_GU; const int kb = r / 44, j = r - kb * 44, within = 4 * l;
        I.p = (within < 128 ? C.we_gate : C.we_up) + (size_t)e * D * DFF + (size_t)(128 * kb + 16 * w) * DFF + 128 * j + (within & 127); I.ld = DFF;
        I.dst = C.ws + WS_WEGU + ((size_t)e * 2 * DFF + 256 * j) * D + 128 * kb; I.ldd = D; }
    else if (it >= EXP_N_TOTAL) { const int r = it - EXP_N_TOTAL; const int kb = r >> 3, nb = r & 7;
        I.p = C.ffn_down + (size_t)(128 * kb + 16 * w) * D + 256 * nb + 4 * l; I.ld = D;
        I.dst = C.ws + WS_WD + (size_t)(256 * nb) * DFF + 128 * kb; I.ldd = DFF; }
    else if (it >= EXP_N_ALL) { const int r = it - EXP_N_ALL; const int kb = r / 44, j = r - kb * 44, within = 4 * l;
        I.p = (within < 128 ? C.ffn_gate : C.ffn_up) + (size_t)(128 * kb + 16 * w) * DFF + 128 * j + (within & 127); I.ld = DFF;
        I.dst = C.ws + WS_WGU + (size_t)(256 * j) * D + 128 * kb; I.ldd = D; }
    else { const int q = it - EXP_N_GU, e = q / EXP_ITEMS_D, r = q - e * EXP_ITEMS_D; const int kb = r >> 3, nb = r & 7;
        I.p = C.we_down + (size_t)e * DFF * D + (size_t)(128 * kb + 16 * w) * D + 256 * nb + 4 * l; I.ld = D;
        I.dst = C.ws + WS_WED + ((size_t)e * D + 256 * nb) * DFF + 128 * kb; I.ldd = DFF; }
    return I;
}
#define EXP_LOAD(V, I) do { _Pragma("unroll") for (int i_ = 0; i_ < 16; ++i_) V[i_] = __builtin_nontemporal_load((const f32x4*)((I).p + (size_t)i_ * (I).ld)); } while (0)
#define EXP_PROC(V, I, BUF) do { LAS unsigned* buf_ = (LAS unsigned*)(C.lds + (BUF) * 32768); const int w_ = C.wave, l_ = C.lane; \
        _Pragma("unroll") for (int i_ = 0; i_ < 16; ++i_) buf_[(16 * w_ + i_) * 64 + (l_ ^ (w_ << 3))] = pk4_fp8(V[i_][0] * W8_SCALE, V[i_][1] * W8_SCALE, V[i_][2] * W8_SCALE, V[i_][3] * W8_SCALE); \
        __syncthreads(); \
        const int kq_ = C.tid & 7, g_ = C.tid >> 3; unsigned d_[16]; \
        _Pragma("unroll") for (int j_ = 0; j_ < 16; ++j_) d_[j_] = buf_[(16 * kq_ + j_) * 64 + (g_ ^ (kq_ << 3))]; \
        _Pragma("unroll") for (int i_ = 0; i_ < 4; ++i_) { u32x4 o_; \
            _Pragma("unroll") for (int b_ = 0; b_ < 4; ++b_) o_[b_] = ((d_[4 * b_] >> (8 * i_)) & 0xffu) | (((d_[4 * b_ + 1] >> (8 * i_)) & 0xffu) << 8) | (((d_[4 * b_ + 2] >> (8 * i_)) & 0xffu) << 16) | (((d_[4 * b_ + 3] >> (8 * i_)) & 0xffu) << 24); \
            __builtin_nontemporal_store(o_, (u32x4*)((I).dst + (size_t)(4 * g_ + i_) * (I).ldd + 16 * kq_)); } } while (0)
#ifndef EXP_N7
#define EXP_N7 6
#endif
#ifndef EXP_N9
#define EXP_N9 8
#endif
#ifndef EXP_N10
#define EXP_N10 2
#endif
constexpr int EXP_P1_END = 2560;
constexpr int EXP_TAIL7 = 128 * EXP_N7, EXP_TAIL9 = 96 * EXP_N9, EXP_TAIL10 = 128 * EXP_N10, EXP_TAIL_END = EXP_TAIL7 + EXP_TAIL9 + EXP_TAIL10;
static_assert(EXP_TAIL_END <= EXP_N_GU, "tail items are gate/up items");
__device__ __forceinline__ void expert_weights_range(const Ctx& C, int lo, int hi, int rank, int nranks) {
    f32x4 va[16], vb[16]; ExpItem Ia, Ib;
    int it = lo + rank; asm volatile("" : "+s"(it));
    if (it < hi) { Ia = exp_item(C, it); EXP_LOAD(va, Ia); }
    while (it < hi) {
        const int itb = it + nranks;
        if (itb < hi) { Ib = exp_item(C, itb); EXP_LOAD(vb, Ib); }
        EXP_PROC(va, Ia, 0);
        if (itb >= hi) break;
        const int ita = itb + nranks;
        if (ita < hi) { Ia = exp_item(C, ita); EXP_LOAD(va, Ia); }
        EXP_PROC(vb, Ib, 1);
        it = ita;
    }
    __syncthreads();
}
#undef EXP_LOAD
#undef EXP_PROC

struct DenItem { const float* p; bf16_t* dst; int ld, ldd; int valid; int q8; };
constexpr int DI_WIN = 32 * 32, DI_WOUT = 32 * 8, DI_GU = 32 * 44, DI_WD = 0  , DI_DQKV = 32 * 5, DI_UQ = 8 * 12, DI_UKV = 8 * 16, DI_WO = 32 * 8;
constexpr int DI_TOTAL = DI_WIN + DI_WOUT + DI_WD + DI_DQKV + DI_UQ + DI_UKV + DI_WO;
__device__ __forceinline__ DenItem den_item(const Ctx& C, int it) {
    DenItem I; I.valid = 1; I.q8 = 0; int r = it; const int w = C.wave, l = C.lane; unsigned char* ws = C.ws;
    if (r < DI_WIN) { const int kb = r >> 5, nb = r & 31, n0 = 256 * nb; I.ld = IN_COLS; I.p = C.w_in + (size_t)(64 * kb + 8 * w) * IN_COLS + n0 + (n0 >= 4096 ? 8 : 0) + 4 * l; I.dst = (bf16_t*)(ws + WS_WIN) + (size_t)n0 * D + 64 * kb; I.ldd = D; return I; } r -= DI_WIN;
    if (r < DI_WOUT) { const int kb = r >> 3, nb = r & 7; I.ld = D; I.p = C.w_mix_out + (size_t)(64 * kb + 8 * w) * D + 256 * nb + 4 * l; I.dst = (bf16_t*)(ws + WS_WOUT) + (size_t)(256 * nb) * D + 64 * kb; I.ldd = D; return I; } r -= DI_WOUT;
    if (r < DI_WD) { const int kb = r >> 3, nb = r & 7; I.ld = D; I.p = C.ffn_down + (size_t)(64 * kb + 8 * w) * D + 256 * nb + 4 * l; I.dst = (bf16_t*)(ws + WS_WD) + (size_t)(256 * nb) * DFF + 64 * kb; I.ldd = DFF; return I; } r -= DI_WD;
    if (r < DI_DQKV) { const int kb = r / 5, nb = r - kb * 5; I.ld = 1088; I.valid = (256 * nb + 4 * l) < 1088; I.p = C.w_dqkv + (size_t)(64 * kb + 8 * w) * 1088 + (I.valid ? 256 * nb + 4 * l : 0); I.dst = (bf16_t*)(ws + WS_WDQKV) + (size_t)(256 * nb) * D + 64 * kb; I.ldd = D; return I; } r -= DI_DQKV;
    if (r < DI_UQ) { const int kb = r / 12, nb = r - kb * 12; I.ld = 3072; I.p = C.w_uq + (size_t)(64 * kb + 8 * w) * 3072 + 256 * nb + 4 * l; I.dst = (bf16_t*)(ws + WS_WUQKV) + (size_t)(256 * nb) * 512 + 64 * kb; I.ldd = 512; return I; } r -= DI_UQ;
    if (r < DI_UKV) { const int kb = r >> 4, nb = r & 15; I.ld = 4096; I.p = C.w_ukv + (size_t)(64 * kb + 8 * w) * 4096 + 256 * nb + 4 * l; I.dst = (bf16_t*)(ws + WS_WUQKV) + (size_t)(3072 + 256 * nb) * 512 + 64 * kb; I.ldd = 512; return I; } r -= DI_UKV;
    { const int kb = r >> 3, nb = r & 7; I.ld = D; I.p = C.w_o + (size_t)(64 * kb + 8 * w) * D + 256 * nb + 4 * l; I.dst = (bf16_t*)(ws + WS_WO) + (size_t)(256 * nb) * D + 64 * kb; I.ldd = D; return I; }
}
#define DEN_LOAD(V, I) do { _Pragma("unroll") for (int i_ = 0; i_ < 8; ++i_) V[i_] = (I).valid ? __builtin_nontemporal_load((const f32x4*)((I).p + (size_t)i_ * (I).ld)) : (f32x4){0.f, 0.f, 0.f, 0.f}; } while (0)
#define DEN_PROC(V, I, BUF) do { LAS unsigned* buf_ = (LAS unsigned*)(C.lds + (BUF) * 32768); const int w_ = C.wave, l_ = C.lane; \
        _Pragma("unroll") for (int i_ = 0; i_ < 8; ++i_) { const f32x4 x_ = V[i_]; \
            *(LAS u32x2*)(buf_ + (8 * w_ + i_) * 128 + ((2 * l_) ^ (8 * w_))) = (u32x2){cvt_pk_bf16(x_[0], x_[1]), cvt_pk_bf16(x_[2], x_[3])}; } \
        __syncthreads(); \
        const int c_ = C.tid & 7, g0_ = C.tid >> 3; \
        _Pragma("unroll") for (int ps_ = 0; ps_ < 2; ++ps_) { const int g_ = g0_ + 64 * ps_; unsigned d_[8]; \
            _Pragma("unroll") for (int j_ = 0; j_ < 8; ++j_) d_[j_] = buf_[(8 * c_ + j_) * 128 + (g_ ^ (8 * c_))]; \
            u32x4 o0_, o1_; \
            _Pragma("unroll") for (int j_ = 0; j_ < 4; ++j_) { o0_[j_] = (d_[2 * j_] & 0xffffu) | (d_[2 * j_ + 1] << 16); o1_[j_] = (d_[2 * j_] >> 16) | (d_[2 * j_ + 1] & 0xffff0000u); } \
            __builtin_nontemporal_store(o0_, (u32x4*)((I).dst + (size_t)(2 * g_) * (I).ldd + 8 * c_)); __builtin_nontemporal_store(o1_, (u32x4*)((I).dst + (size_t)(2 * g_ + 1) * (I).ldd + 8 * c_)); } } while (0)
__device__ __forceinline__ void dense_weights_to_bf16(const Ctx& C, int lo, int N) {
    f32x4 va[8], vb[8]; DenItem Ia, Ib;
    int it = lo + C.wg; asm volatile("" : "+s"(it));
    if (it < N) { Ia = den_item(C, it); DEN_LOAD(va, Ia); }
    while (it < N) {
        const int itb = it + C.nwg;
        if (itb < N) { Ib = den_item(C, itb); DEN_LOAD(vb, Ib); }
        DEN_PROC(va, Ia, 0);
        if (itb >= N) break;
        const int ita = itb + C.nwg;
        if (ita < N) { Ia = den_item(C, ita); DEN_LOAD(va, Ia); }
        DEN_PROC(vb, Ib, 1);
        it = ita;
    }
    __syncthreads();
}
#undef DEN_LOAD
#undef DEN_PROC

__device__ __forceinline__ f32x2 rope_cs(float a) {
    const float k = rintf(a * 0.15915494309189535f);
    float r = fmaf(-k, 6.2831854820251465f, a); r = fmaf(-k, -1.7484555e-7f, r);
    const float tr = r * 0.15915494309189535f;
    return (f32x2){__builtin_amdgcn_cosf(tr), __builtin_amdgcn_sinf(tr)};
}
__device__ __forceinline__ void phase_prologue(const Ctx& C) {
    LAS float* scr = (LAS float*)(C.lds + C.wave * 16384);
    const int gw = C.wg * NWAVES + C.wave, NGW = C.nwg * NWAVES;
    dense_weights_to_bf16(C, 0, DI_WIN);
    const int gt = C.wg * NTHR + C.tid, NGT = C.nwg * NTHR;
    f32x2* rr = (f32x2*)(C.ws + WS_ROPER); f32x2* rm = (f32x2*)(C.ws + WS_ROPEM);
    for (int i = gt; i < T * 128; i += NGT) { const int t = i >> 7, j = i & 127; const float inv = exp2f(-(float)j * (13.287712379549449f / 128.f)); const float a = (float)C.pos[t] * inv; rr[i] = rope_cs(a); }
    for (int i = gt; i < T * 32; i += NGT) { const int t = i >> 5, j = i & 31; const float inv = exp2f(-(float)j * (13.287712379549449f / 32.f)); const float a = (float)C.pos[t] * inv; rm[i] = rope_cs(a); }
}

template <int MODE, bool Q8 = false>
__device__ __forceinline__ void phase_norm(const Ctx& C, const float* xin, const float* gain, bf16_t* hout, const float* w8, int w8ld) {
    LAS float* wT = (LAS float*)C.lds;
    LAS int* lcnt = (LAS int*)(C.lds + 65536);
    if (MODE != 0) {
        for (int k = C.tid; k < D; k += NTHR) { const f32x4 a = *(const f32x4*)(w8 + (size_t)k * w8ld), b = *(const f32x4*)(w8 + (size_t)k * w8ld + 4);
            wT[0 * D + k] = a[0]; wT[1 * D + k] = a[1]; wT[2 * D + k] = a[2]; wT[3 * D + k] = a[3]; wT[4 * D + k] = b[0]; wT[5 * D + k] = b[1]; wT[6 * D + k] = b[2]; wT[7 * D + k] = b[3]; }
        if (MODE == 2 && C.tid < 8) lcnt[C.tid] = 0;
        __syncthreads();
    }
    const int rows_per_wg = T / C.nwg;
    const int lane = C.lane;
    for (int rl = C.wave; rl < rows_per_wg; rl += NWAVES) {
        const int t = C.wg * rows_per_wg + rl;
        const f32x4* xr = (const f32x4*)(xin + (size_t)t * D) + lane; const u32x2* xb = (const u32x2*)((const bf16_t*)xin + (size_t)t * D) + lane;
        f32x4 v[8]; float ss = 0.f;
#pragma unroll
        for (int j = 0; j < 8; ++j) { if (MODE == 2) { const u32x2 z = xb[64 * j]; v[j] = (f32x4){bflo(z.x), bfhi(z.x), bflo(z.y), bfhi(z.y)}; } else v[j] = (MODE == 1) ? __builtin_nontemporal_load(xr + 64 * j) : xr[64 * j]; ss += (v[j][0] * v[j][0] + v[j][1] * v[j][1]) + (v[j][2] * v[j][2] + v[j][3] * v[j][3]); }
        const float rstd = rsqrtf(wave_sum(ss) * (1.f / D) + EPS);
#pragma unroll
        for (int j = 0; j < 8; ++j) { const f32x4 g = *((const f32x4*)gain + lane + 64 * j); v[j] = v[j] * rstd * g; if (Q8) { v[j][0] = q8f(v[j][0], 1.f, 1.f); v[j][1] = q8f(v[j][1], 1.f, 1.f); v[j][2] = q8f(v[j][2], 1.f, 1.f); v[j][3] = q8f(v[j][3], 1.f, 1.f); } }
        if (MODE == 2) { unsigned* o4 = (unsigned*)((unsigned char*)hout + (size_t)t * D) + lane;
#pragma unroll
            for (int j = 0; j < 8; ++j) o4[64 * j] = pk4_fp8(v[j][0], v[j][1], v[j][2], v[j][3]);
        } else { u32x2* o8 = (u32x2*)(hout + (size_t)t * D) + lane;
#pragma unroll
            for (int j = 0; j < 8; ++j) o8[64 * j] = (u32x2){cvt_pk_bf16(v[j][0], v[j][1]), cvt_pk_bf16(v[j][2], v[j][3])}; }
        if (MODE != 0) {
            float dot[8];
#pragma unroll
            for (int q = 0; q < 8; ++q) { float s = 0.f;
#pragma unroll
                for (int j = 0; j < 8; ++j) { const f32x4 w = *(const LAS f32x4*)(wT + q * D + 256 * j + 4 * lane); s += (v[j][0] * w[0] + v[j][1] * w[1]) + (v[j][2] * w[2] + v[j][3] * w[3]); }
                dot[q] = wave_sum(s); }
            if (MODE == 1) {
                if (lane < 4) { float gi = 0.f, gf = 0.f;
#pragma unroll
                    for (int q = 0; q < 4; ++q) { if (lane == q) { gi = dot[q]; gf = dot[4 + q]; } }
                    gi += C.b_gates[lane]; gf += C.b_gates[4 + lane];
                    const float lf = fminf(gf, 0.f) - log1pf(__expf(-fabsf(gf)));
                    ((float*)(C.ws + WS_GI))[t * 4 + lane] = gi; ((float*)(C.ws + WS_GF))[t * 4 + lane] = lf; }
            } else {
                int e1 = 0; float v1 = dot[0];
#pragma unroll
                for (int q = 1; q < 8; ++q) if (dot[q] > v1) { v1 = dot[q]; e1 = q; }
                int e2 = -1; float v2 = -3.0e38f;
#pragma unroll
                for (int q = 0; q < 8; ++q) if (q != e1 && dot[q] > v2) { v2 = dot[q]; e2 = q; }
                const float w2 = 1.f / (1.f + __expf(v1 - v2)), w1 = 1.f - w2;
                if (lane == 0) { ((int*)(C.ws + WS_RTE))[2 * t] = e1; ((int*)(C.ws + WS_RTE))[2 * t + 1] = e2; ((float*)(C.ws + WS_RTW))[2 * t] = w1; ((float*)(C.ws + WS_RTW))[2 * t + 1] = w2;
                    atomicAdd((int*)(lcnt + e1), 1); atomicAdd((int*)(lcnt + e2), 1); }
            }
        }
    }
    if (MODE == 2) { __syncthreads(); if (C.tid < 8) ((int*)(C.ws + WS_CNT))[C.wg * 8 + C.tid] = lcnt[C.tid]; }
    __syncthreads();
}
__device__ __forceinline__ int crow(int r, int hi) { return (r & 3) + 8 * (r >> 2) + 4 * hi; }
__device__ __forceinline__ f32x16 mfma32(bf16x8 a, bf16x8 b, f32x16 c) { return __builtin_amdgcn_mfma_f32_32x32x16_bf16(a, b, c, 0, 0, 0); }
#define PK4(P, B_, OUT) do { unsigned a0_ = cvt_pk_bf16(P[B_ + 0], P[B_ + 1]), a1_ = cvt_pk_bf16(P[B_ + 2], P[B_ + 3]);                 \
        unsigned b0_ = cvt_pk_bf16(P[B_ + 4], P[B_ + 5]), b1_ = cvt_pk_bf16(P[B_ + 6], P[B_ + 7]);                                      \
        auto r0_ = __builtin_amdgcn_permlane32_swap(a0_, b0_, false, false); auto r1_ = __builtin_amdgcn_permlane32_swap(a1_, b1_, false, false); \
        u32x4 w_ = {r0_[0], r1_[0], r0_[1], r1_[1]}; OUT = *reinterpret_cast<bf16x8*>(&w_); } while (0)
__device__ __forceinline__ float half_swap_add(float v) { auto rr = __builtin_amdgcn_permlane32_swap(__float_as_uint(v), __float_as_uint(v), false, false); return __uint_as_float(rr[0]) + __uint_as_float(rr[1]); }
__device__ __forceinline__ float half_swap_max(float v) { auto rr = __builtin_amdgcn_permlane32_swap(__float_as_uint(v), __float_as_uint(v), false, false); return fmaxf(__uint_as_float(rr[0]), __uint_as_float(rr[1])); }
__device__ __forceinline__ float ret_log2gamma(int h) { return log2f(1.f - exp2f(-5.f - (float)h)); }

__device__ __forceinline__ void mlstm_scalar_scan(const Ctx& C, int bh) {
    const int b = bh >> 2, h = bh & 3, lane = C.lane, tid = C.tid;
    const float* gi = (const float*)(C.ws + WS_GI); const float* gf = (const float*)(C.ws + WS_GF);
    float* bcw = (float*)(C.ws + WS_BC); float* wl = (float*)(C.ws + WS_WL); float* mprev = (float*)(C.ws + WS_MPREV); float* decv = (float*)(C.ws + WS_DEC);
    constexpr int P = LM + 1;
    LAS float* fl = (LAS float*)C.lds; LAS float* il = fl + NCM * P;
#pragma unroll
    for (int j = 0; j < 8; ++j) { const int pos = tid + 512 * j, t = b * SEQ + pos; fl[(pos / LM) * P + (pos % LM)] = gf[t * 4 + h]; il[(pos / LM) * P + (pos % LM)] = gi[t * 4 + h]; }
    __syncthreads();
    if (C.wave == 0) {
        const int ck = lane < NCM ? lane : NCM - 1;
        const LAS float* fr_ = fl + ck * P; const LAS float* ir_ = il + ck * P;
        float bc = 0.f, mxp = -__builtin_inff();
        for (int l = 0; l < LM; ++l) { bc += fr_[l]; mxp = fmaxf(mxp, ir_[l] - bc); }
        const float g = bc, mx = g + mxp;
        float m = -__builtin_inff(), mp_l = 0.f, mn_l = 0.f;
        for (int k = 0; k < NCM; ++k) { const float gk = __builtin_bit_cast(float, __builtin_amdgcn_readlane(__builtin_bit_cast(int, g), k)), mxk = __builtin_bit_cast(float, __builtin_amdgcn_readlane(__builtin_bit_cast(int, mx), k));
            const float mp = m; m = fmaxf(gk + m, mxk); if (lane == k) { mp_l = mp; mn_l = m; } }
        if (lane < NCM) { mprev[bh * 64 + lane] = mp_l; decv[bh * 64 + lane] = (mp_l == -__builtin_inff()) ? 0.f : __expf(g + mp_l - mn_l);
            LAS float* fw = fl + lane * P; LAS float* iw = il + lane * P;
            bc = 0.f;
            for (int l = 0; l < LM; ++l) { bc += fw[l]; const float w = __expf(g - bc + iw[l] - mn_l); fw[l] = bc; iw[l] = w; } }
    }
    __syncthreads();
#pragma unroll
    for (int j = 0; j < 8; ++j) { const int pos = tid + 512 * j, t = b * SEQ + pos; bcw[t * 4 + h] = fl[(pos / LM) * P + (pos % LM)]; wl[t * 4 + h] = il[(pos / LM) * P + (pos % LM)]; }
    __syncthreads();
}

constexpr int CONVTAB_OFF = 143360;
__device__ __forceinline__ void conv_taps_to_lds(const Ctx& C, int h, int tid) {
    LAS float* tab = (LAS float*)(C.lds + CONVTAB_OFF);
#pragma unroll
    for (int i = 0; i < 4; ++i) { const int idx = tid + 512 * i, which = idx >> 10, tap = (idx >> 8) & 3, c = idx & 255; tab[idx] = C.conv_w[tap * 2048 + which * 1024 + h * 256 + c]; }
}
__device__ __forceinline__ void conv8_silu(const bf16_t* zc, int t, int s, const LAS float* wt, float sc, float (&y)[8]) {
#pragma unroll
    for (int i = 0; i < 8; ++i) y[i] = 0.f;
#pragma unroll
    for (int tap = 0; tap < 4; ++tap) if (s - 3 + tap >= 0) { const u32x4 z = *(const u32x4*)(zc + (size_t)(t - 3 + tap) * 8192);
        const f32x4 w0 = *(const LAS f32x4*)(wt + tap * 256), w1 = *(const LAS f32x4*)(wt + tap * 256 + 4);
        y[0] += bflo(z.x) * w0[0]; y[1] += bfhi(z.x) * w0[1]; y[2] += bflo(z.y) * w0[2]; y[3] += bfhi(z.y) * w0[3];
        y[4] += bflo(z.z) * w1[0]; y[5] += bfhi(z.z) * w1[1]; y[6] += bflo(z.w) * w1[2]; y[7] += bfhi(z.w) * w1[3]; }
#pragma unroll
    for (int i = 0; i < 8; ++i) y[i] = silu_f(y[i]) * sc;
}

template <bool RET>
__device__ __forceinline__ void mixer_contrib_unit(const Ctx& C, int bh, int k) {
    constexpr int L = RET ? LR : LM, NC = RET ? NCR : NCM, NHALF = L / 64, PITCH = 72;
    const int b = bh >> 2, h = bh & 3, t0 = b * SEQ + k * L;
    int lane_ = C.lane; asm volatile("" : "+v"(lane_));
    const int lane = lane_, wave = C.wave, tid = wave * 64 + lane, c32 = lane & 31, hi = lane >> 5;
    const bf16_t* ksrc = (const bf16_t*)(C.ws + WS_Z) + (RET ? 5120 : 1024) + h * 256;
    const bf16_t* vsrc = (const bf16_t*)(C.ws + WS_Z) + (RET ? 6144 : 2048) + h * 256;
    bf16_t* UT = (bf16_t*)(C.ws + (RET ? WS_STR : WS_STM)) + ((size_t)bh * NC + k) * 65536;
    LAS bf16_t* vT = (LAS bf16_t*)C.lds; LAS bf16_t* kT = (LAS bf16_t*)(C.lds + 36864);
    const float* wl = (const float*)(C.ws + WS_WL);
    const float lg2 = ret_log2gamma(h);
    f32x16 acc[8];
#pragma unroll
    for (int i = 0; i < 8; ++i) acc[i] = f32x16{};
    float unacc = 0.f;
    if (!RET) { conv_taps_to_lds(C, h, tid); __syncthreads(); }
    for (int hf = 0; hf < NHALF; ++hf) {
#pragma unroll
        for (int i = 0; i < 4; ++i) { const int c = tid + 512 * i, l = c & 63, c8 = c >> 6, lt = hf * 64 + l, t = t0 + lt;
            const u32x4 vz = *(const u32x4*)(vsrc + (size_t)t * 8192 + 8 * c8);
            const float w = RET ? __builtin_amdgcn_exp2f(lg2 * (float)(L - 1 - lt)) : wl[t * 4 + h];
            unsigned k0, k1, k2, k3;
            if (RET) { const u32x4 kz = *(const u32x4*)(ksrc + (size_t)t * 8192 + 8 * c8);
                k0 = cvt_pk_bf16(bflo(kz.x) * w, bfhi(kz.x) * w); k1 = cvt_pk_bf16(bflo(kz.y) * w, bfhi(kz.y) * w); k2 = cvt_pk_bf16(bflo(kz.z) * w, bfhi(kz.z) * w); k3 = cvt_pk_bf16(bflo(kz.w) * w, bfhi(kz.w) * w); }
            else { float y[8]; conv8_silu(ksrc + 8 * c8, t, t & (SEQ - 1), (const LAS float*)(C.lds + CONVTAB_OFF) + 1024 + 8 * c8, 0.0625f * w, y);
                k0 = cvt_pk_bf16(y[0], y[1]); k1 = cvt_pk_bf16(y[2], y[3]); k2 = cvt_pk_bf16(y[4], y[5]); k3 = cvt_pk_bf16(y[6], y[7]); }
            LAS bf16_t* kd = kT + (8 * c8) * PITCH + l; LAS bf16_t* vd = vT + (8 * c8) * PITCH + l;
            kd[0 * PITCH] = (bf16_t)(k0 & 0xffff); kd[1 * PITCH] = (bf16_t)(k0 >> 16); kd[2 * PITCH] = (bf16_t)(k1 & 0xffff); kd[3 * PITCH] = (bf16_t)(k1 >> 16);
            kd[4 * PITCH] = (bf16_t)(k2 & 0xffff); kd[5 * PITCH] = (bf16_t)(k2 >> 16); kd[6 * PITCH] = (bf16_t)(k3 & 0xffff); kd[7 * PITCH] = (bf16_t)(k3 >> 16);
            vd[0 * PITCH] = (bf16_t)(vz.x & 0xffff); vd[1 * PITCH] = (bf16_t)(vz.x >> 16); vd[2 * PITCH] = (bf16_t)(vz.y & 0xffff); vd[3 * PITCH] = (bf16_t)(vz.y >> 16);
            vd[4 * PITCH] = (bf16_t)(vz.z & 0xffff); vd[5 * PITCH] = (bf16_t)(vz.z >> 16); vd[6 * PITCH] = (bf16_t)(vz.w & 0xffff); vd[7 * PITCH] = (bf16_t)(vz.w >> 16); }
        __syncthreads();
#pragma unroll
        for (int ks = 0; ks < 4; ++ks) {
            const bf16x8 af = *(const LAS bf16x8*)(vT + (32 * wave + c32) * PITCH + 16 * ks + 8 * hi);
#pragma unroll
            for (int db = 0; db < 8; ++db) { const bf16x8 bfr = *(const LAS bf16x8*)(kT + (32 * db + c32) * PITCH + 16 * ks + 8 * hi); acc[db] = mfma32(af, bfr, acc[db]); }
        }
        if (!RET && tid < 256) {
#pragma unroll
            for (int q = 0; q < 8; ++q) { const u32x4 z = *(const LAS u32x4*)(kT + tid * PITCH + 8 * q);
                unacc += (bflo(z.x) + bfhi(z.x)) + (bflo(z.y) + bfhi(z.y)) + (bflo(z.z) + bfhi(z.z)) + (bflo(z.w) + bfhi(z.w)); } }
        __syncthreads();
    }
    LAS unsigned char* Wl = C.lds + wave * 16384;
#pragma unroll
    for (int db = 0; db < 8; ++db)
#pragma unroll
        for (int r = 0; r < 16; r += 2) { const float send = (lane & 1) ? acc[db][r] : acc[db][r + 1]; const float recv = __shfl_xor(send, 1);
            const unsigned val = (lane & 1) ? cvt_pk_bf16(recv, acc[db][r + 1]) : cvt_pk_bf16(acc[db][r], recv);
            *(LAS unsigned*)(Wl + crow(r + (lane & 1), hi) * 512 + (32 * db + (c32 & ~1)) * 2) = val; if (r == 14) __builtin_amdgcn_sched_barrier(0); }
    LDS_WAIT();
#pragma unroll
    for (int j = 0; j < 16; ++j) { const int idx = lane + 64 * j, row = idx >> 5, ch = idx & 31;
        *(u32x4*)(UT + (size_t)(32 * wave + row) * 256 + 8 * ch) = *(const LAS u32x4*)(Wl + row * 512 + ch * 16); }
    if (!RET && tid < 256) ((float*)(C.ws + WS_UN))[((size_t)bh * NCM + k) * 256 + tid] = unacc;
    __syncthreads();
}
__device__ __forceinline__ void phase_contrib(const Ctx& C) {
    constexpr int NU = 8 * NCM + 8 * NCR;
    for (int u = C.wg; u < NU; u += C.nwg) {
        if (u < 8 * NCM) mixer_contrib_unit<false>(C, u / NCM, u % NCM); else mixer_contrib_unit<true>(C, (u - 8 * NCM) / NCR, (u - 8 * NCM) % NCR);
    }
}

__device__ __forceinline__ void phase_scan(const Ctx& C) {
    const int gt = C.wg * NTHR + C.tid, NGT = C.nwg * NTHR;
    const float* decv = (const float*)(C.ws + WS_DEC);
    for (int it = gt; it < 2 * 65536; it += NGT) {
        const bool ret = it >= 65536; const int r = it & 65535, bh = r >> 13, c = r & 8191;
        const int nc = ret ? NCR : NCM;
        bf16_t* base = (bf16_t*)(C.ws + (ret ? WS_STR : WS_STM)) + (size_t)bh * nc * 65536 + c * 8;
        const float cdec = exp2f(ret_log2gamma(bh & 3) * (float)LR);
        float run[8];
#pragma unroll
        for (int i = 0; i < 8; ++i) run[i] = 0.f;
#pragma unroll 4
        for (int k = 0; k < nc; ++k) {
            u32x4* p = (u32x4*)(base + (size_t)k * 65536); const u32x4 u = *p;
            *p = (u32x4){cvt_pk_bf16(run[0], run[1]), cvt_pk_bf16(run[2], run[3]), cvt_pk_bf16(run[4], run[5]), cvt_pk_bf16(run[6], run[7])};
            const float dec = ret ? cdec : decv[bh * 64 + k];
            run[0] = run[0] * dec + bflo(u.x); run[1] = run[1] * dec + bfhi(u.x); run[2] = run[2] * dec + bflo(u.y); run[3] = run[3] * dec + bfhi(u.y);
            run[4] = run[4] * dec + bflo(u.z); run[5] = run[5] * dec + bfhi(u.z); run[6] = run[6] * dec + bflo(u.w); run[7] = run[7] * dec + bfhi(u.w);
        }
    }
    for (int it = gt; it < 8 * 256; it += NGT) { const int bh = it >> 8, d = it & 255; float* un = (float*)(C.ws + WS_UN) + (size_t)bh * NCM * 256 + d; float u[NCM], dc[NCM];
#pragma unroll
        for (int k = 0; k < NCM; ++k) { u[k] = un[k * 256]; dc[k] = decv[bh * 64 + k]; }
        float run = 0.f;
#pragma unroll
        for (int k = 0; k < NCM; ++k) { const float uk = u[k]; u[k] = run; run = run * dc[k] + uk; }
#pragma unroll
        for (int k = 0; k < NCM; ++k) un[k * 256] = u[k]; }
}

template <bool RET>
__device__ __forceinline__ void mixer_out_unit(const Ctx& C, int bh, int k) {
    constexpr int L = RET ? LR : LM, NLB = L / 32, NEG = 8 / NLB, NEB = 8 / NEG, NC = RET ? NCR : NCM, PITCH = L + 8, KP = 264;
    const int b = bh >> 2, h = bh & 3, t0 = b * SEQ + k * L;
    int lane_ = C.lane; asm volatile("" : "+v"(lane_));
    const int lane = lane_, wave = C.wave, tid = wave * 64 + lane, c32 = lane & 31, hi = lane >> 5;
    const int lb = wave % NLB, eg = wave / NLB;
    const bf16_t* Z = (const bf16_t*)(C.ws + WS_Z);
    const bf16_t* qsrc = Z + (RET ? 4096 : 0) + h * 256;
    const bf16_t* ksrc = Z + (RET ? 5120 : 1024) + h * 256;
    const bf16_t* vsrc = Z + (RET ? 6144 : 2048) + h * 256;
    const bf16_t* gsrc = Z + (RET ? 7168 : 3072) + h * 256;
    const bf16_t* ST = (const bf16_t*)(C.ws + (RET ? WS_STR : WS_STM)) + ((size_t)bh * NC + k) * 65536;
    const float* gain = (RET ? C.g_ro : C.g_mo) + h * 256;
    bf16_t* MIX = (bf16_t*)(C.ws + WS_MIX) + (RET ? 1024 : 0) + h * 256;
    LAS bf16_t* Kl = (LAS bf16_t*)C.lds;
    constexpr int KBYTES = L * KP * 2, TAB = KBYTES + 256 * PITCH * 2;
    LAS bf16_t* vT = (LAS bf16_t*)(C.lds + KBYTES);
    LAS float* a_s = (LAS float*)(C.lds + TAB);
    LAS float* nprev = a_s + 128;
    LAS float* rowtab = nprev + 256;
    const int lrow = 32 * lb + c32;
    bf16x8 qr[16], sf[16];
    if (RET) {
#pragma unroll
        for (int ks = 0; ks < 16; ++ks) qr[ks] = *(const bf16x8*)(qsrc + (size_t)(t0 + lrow) * 8192 + 16 * ks + 8 * hi);
    } else conv_taps_to_lds(C, h, tid);
#pragma unroll
    for (int ks = 0; ks < 16; ++ks) sf[ks] = *(const bf16x8*)(ST + (size_t)(eg * NEB * 32 + c32) * 256 + 16 * ks + 8 * hi);
    if (RET) {
#pragma unroll
        for (int i = 0; i < L / 16; ++i) { const int c = tid + 512 * i, row = c >> 5, ch = c & 31;
            *(LAS u32x4*)(Kl + row * KP + 8 * ch) = *(const u32x4*)(ksrc + (size_t)(t0 + row) * 8192 + 8 * ch); }
    } else {
        __syncthreads();
        const LAS float* taps = (const LAS float*)(C.lds + CONVTAB_OFF);
#pragma unroll
        for (int i = 0; i < L / 16; ++i) { const int c = tid + 512 * i, row = c >> 5, ch = c & 31, t = t0 + row; float y[8];
            conv8_silu(qsrc + 8 * ch, t, t & (SEQ - 1), taps + 8 * ch, 1.f, y);
            *(LAS u32x4*)(Kl + row * KP + 8 * ch) = (u32x4){cvt_pk_bf16(y[0], y[1]), cvt_pk_bf16(y[2], y[3]), cvt_pk_bf16(y[4], y[5]), cvt_pk_bf16(y[6], y[7])}; }
        __syncthreads();
#pragma unroll
        for (int ks = 0; ks < 16; ++ks) qr[ks] = *(const LAS bf16x8*)(Kl + lrow * KP + 16 * ks + 8 * hi);
        __syncthreads();
#pragma unroll
        for (int i = 0; i < L / 16; ++i) { const int c = tid + 512 * i, row = c >> 5, ch = c & 31, t = t0 + row; float y[8];
            conv8_silu(ksrc + 8 * ch, t, t & (SEQ - 1), taps + 1024 + 8 * ch, 0.0625f, y);
            *(LAS u32x4*)(Kl + row * KP + 8 * ch) = (u32x4){cvt_pk_bf16(y[0], y[1]), cvt_pk_bf16(y[2], y[3]), cvt_pk_bf16(y[4], y[5]), cvt_pk_bf16(y[6], y[7])}; }
    }
#pragma unroll
    for (int i = 0; i < L / 16; ++i) { const int c = tid + 512 * i, l = c & (L - 1), c8 = c / L;
        const u32x4 vz = *(const u32x4*)(vsrc + (size_t)(t0 + l) * 8192 + 8 * c8); LAS bf16_t* vd = vT + (8 * c8) * PITCH + l;
        vd[0 * PITCH] = (bf16_t)(vz.x & 0xffff); vd[1 * PITCH] = (bf16_t)(vz.x >> 16); vd[2 * PITCH] = (bf16_t)(vz.y & 0xffff); vd[3 * PITCH] = (bf16_t)(vz.y >> 16);
        vd[4 * PITCH] = (bf16_t)(vz.z & 0xffff); vd[5 * PITCH] = (bf16_t)(vz.z >> 16); vd[6 * PITCH] = (bf16_t)(vz.w & 0xffff); vd[7 * PITCH] = (bf16_t)(vz.w >> 16); }
    float mprev = 0.f;
    if (!RET) {
        if (tid < L) a_s[tid] = ((const float*)(C.ws + WS_GI))[(t0 + tid) * 4 + h] - ((const float*)(C.ws + WS_BC))[(t0 + tid) * 4 + h];
        if (tid < 256) nprev[tid] = ((const float*)(C.ws + WS_UN))[((size_t)bh * NCM + k) * 256 + tid];
        mprev = ((const float*)(C.ws + WS_MPREV))[bh * 64 + k];
    }
    __syncthreads();
    float rowf, rowd, M = 0.f, bl = 0.f, dsum = 0.f;
    const float lg2 = ret_log2gamma(h);
    if (!RET) {
        float pm = -__builtin_inff();
#pragma unroll 8
        for (int s4 = 0; s4 < L; s4 += 4) { const f32x4 a = *(const LAS f32x4*)(a_s + s4);
            const float NI = -__builtin_inff();
            pm = fmaxf(pm, (s4 <= lrow) ? a[0] : NI); pm = fmaxf(pm, (s4 + 1 <= lrow) ? a[1] : NI); pm = fmaxf(pm, (s4 + 2 <= lrow) ? a[2] : NI); pm = fmaxf(pm, (s4 + 3 <= lrow) ? a[3] : NI); }
        M = fmaxf(pm, mprev);
        bl = ((const float*)(C.ws + WS_BC))[(t0 + lrow) * 4 + h];
    }
    bf16x8 pa[2 * NLB];
#pragma unroll
    for (int sb = 0; sb < NLB; ++sb) {
        f32x16 p = f32x16{};
        if (sb <= lb) {
#pragma unroll
            for (int ks = 0; ks < 16; ++ks) { const bf16x8 kf = *(const LAS bf16x8*)(Kl + (32 * sb + c32) * KP + 16 * ks + 8 * hi); p = mfma32(kf, qr[ks], p); }
#pragma unroll
            for (int g = 0; g < 4; ++g) {
                f32x4 av = (f32x4){0.f, 0.f, 0.f, 0.f}; if (!RET) av = *(const LAS f32x4*)(a_s + 32 * sb + 8 * g + 4 * hi);
#pragma unroll
                for (int j = 0; j < 4; ++j) { const int r = 4 * g + j, s = 32 * sb + crow(r, hi);
                    if (!RET) { const float e = __expf(av[j] - M); const float dm = (s <= lrow) ? e : 0.f; p[r] *= dm; dsum += p[r]; }
                    else p[r] = (s <= lrow) ? p[r] * __builtin_amdgcn_exp2f(lg2 * (float)(lrow - s)) : 0.f; } }
        }
        PK4(p, 0, pa[2 * sb]); PK4(p, 8, pa[2 * sb + 1]);
        __builtin_amdgcn_sched_barrier(0);
    }
    if (!RET) {
        const float inter = (mprev == -__builtin_inff()) ? 0.f : __expf(mprev - M);
        dsum = half_swap_add(dsum);
        float qn = 0.f;
#pragma unroll
        for (int ks = 0; ks < 16; ++ks) { const u32x4 qz = *reinterpret_cast<const u32x4*>(&qr[ks]); const LAS float* np = nprev + 16 * ks + 8 * hi;
            qn += (bflo(qz.x) * np[0] + bfhi(qz.x) * np[1]) + (bflo(qz.y) * np[2] + bfhi(qz.y) * np[3]) + (bflo(qz.z) * np[4] + bfhi(qz.z) * np[5]) + (bflo(qz.w) * np[6] + bfhi(qz.w) * np[7]); }
        qn = half_swap_add(qn);
        const float den = dsum + inter * qn;
        rowf = inter; rowd = 1.f / fmaxf(fabsf(den), __expf(-bl - M));
    } else { rowf = exp2f(lg2 * (float)(lrow + 1)); rowd = 1.f; }
    LAS float* rt = rowtab + wave * 64;
    if (hi == 0) { rt[c32] = rowf; rt[32 + c32] = rowd; }
    __syncthreads();
#pragma unroll
    for (int eb = 0; eb < NEB; ++eb) {
        const int e0 = (eg * NEB + eb) * 32;
        f32x16 n1 = f32x16{}, n2 = f32x16{};
#pragma unroll
        for (int ks = 0; ks < 16; ++ks) { n2 = mfma32(qr[ks], sf[ks], n2);
            if (eb + 1 < NEB) sf[ks] = *(const bf16x8*)(ST + (size_t)(e0 + 32 + c32) * 256 + 16 * ks + 8 * hi); }
#pragma unroll
        for (int sb = 0; sb < NLB; ++sb) if (sb <= lb) {
#pragma unroll
            for (int kk = 0; kk < 2; ++kk) { const bf16x8 vf = *(const LAS bf16x8*)(vT + (e0 + c32) * PITCH + 32 * sb + 16 * kk + 8 * hi); n1 = mfma32(pa[2 * sb + kk], vf, n1); } }
#pragma unroll
        for (int r = 0; r < 16; ++r) { const int rl = crow(r, hi); Kl[(32 * lb + rl) * KP + e0 + c32] = f2bf((n1[r] + rt[rl] * n2[r]) * rt[32 + rl]); }
        __builtin_amdgcn_sched_barrier(0);
    }
    __syncthreads();
#pragma unroll
    for (int l8 = 0; l8 < L / NWAVES; l8 += 8) {
        f32x4 v[8]; u32x2 gz[8];
#pragma unroll
        for (int j = 0; j < 8; ++j) { const int l = wave + NWAVES * (l8 + j), t = t0 + l; const u32x2 hz = *(const LAS u32x2*)(Kl + l * KP + 4 * lane); v[j] = (f32x4){bflo(hz.x), bfhi(hz.x), bflo(hz.y), bfhi(hz.y)};
            gz[j] = *(const u32x2*)(gsrc + (size_t)t * 8192 + 4 * lane); }
        const f32x4 gn = *(const f32x4*)(gain + 4 * lane);
#pragma unroll
        for (int j = 0; j < 8; ++j) { const int t = t0 + wave + NWAVES * (l8 + j);
            const float g0 = bflo(gz[j].x), g1 = bfhi(gz[j].x), g2 = bflo(gz[j].y), g3 = bfhi(gz[j].y); f32x4 x = v[j];
            if (!RET) { x[0] *= sigmoid_f(g0); x[1] *= sigmoid_f(g1); x[2] *= sigmoid_f(g2); x[3] *= sigmoid_f(g3); }
            const float rstd = rsqrtf(wave_sum((x[0] * x[0] + x[1] * x[1]) + (x[2] * x[2] + x[3] * x[3])) * (1.f / 256.f) + EPS);
            x = x * rstd * gn;
            if (RET) { x[0] *= silu_f(g0); x[1] *= silu_f(g1); x[2] *= silu_f(g2); x[3] *= silu_f(g3); }
            *(u32x2*)(MIX + (size_t)t * 2048 + 4 * lane) = (u32x2){cvt_pk_bf16(x[0], x[1]), cvt_pk_bf16(x[2], x[3])}; }
    }
    __syncthreads();
}
__device__ __forceinline__ void phase_mixout(const Ctx& C) {
    constexpr int NU = 8 * NCM + 8 * NCR;
    for (int u = C.wg; u < NU; u += C.nwg) {
#if !defined(MIX_ONLY) || MIX_ONLY == 0
        if (u < 8 * NCM) mixer_out_unit<false>(C, u / NCM, u % NCM);
#endif
#if !defined(MIX_ONLY) || MIX_ONLY == 1
        if (u >= 8 * NCM) mixer_out_unit<true>(C, (u - 8 * NCM) / NCR, (u - 8 * NCM) % NCR);
#endif
    }
}
__device__ __forceinline__ void phase_latent_norm(const Ctx& C) {
    const float* cq = (const float*)(C.ws + WS_CQKV); bf16_t* out = (bf16_t*)(C.ws + WS_CQKVN); bf16_t* kr = (bf16_t*)(C.ws + WS_KR);
    const f32x2* ropeM = (const f32x2*)(C.ws + WS_ROPEM);
    const int gw = C.wg * NWAVES + C.wave, NGW = C.nwg * NWAVES, lane = C.lane;
    for (int t = gw; t < T; t += NGW) {
        const float* row = cq + (size_t)t * NDQKV;
        const f32x4 a0 = *(const f32x4*)(row + 8 * lane), a1 = *(const f32x4*)(row + 8 * lane + 4);
        const f32x4 b0 = *(const f32x4*)(row + 512 + 8 * lane), b1 = *(const f32x4*)(row + 512 + 8 * lane + 4);
        const float kv = row[1024 + lane];
        const float sa = wave_sum((a0[0] * a0[0] + a0[1] * a0[1]) + (a0[2] * a0[2] + a0[3] * a0[3]) + (a1[0] * a1[0] + a1[1] * a1[1]) + (a1[2] * a1[2] + a1[3] * a1[3]));
        const float sb = wave_sum((b0[0] * b0[0] + b0[1] * b0[1]) + (b0[2] * b0[2] + b0[3] * b0[3]) + (b1[0] * b1[0] + b1[1] * b1[1]) + (b1[2] * b1[2] + b1[3] * b1[3]));
        const float sk = wave_sum(kv * kv);
        const float ra = rsqrtf(sa * (1.f / 512.f) + EPS), rb = rsqrtf(sb * (1.f / 512.f) + EPS), rk = rsqrtf(sk * (1.f / 64.f) + EPS);
        const f32x4 ga0 = *(const f32x4*)(C.g_cq + 8 * lane), ga1 = *(const f32x4*)(C.g_cq + 8 * lane + 4), gb0 = *(const f32x4*)(C.g_ckv + 8 * lane), gb1 = *(const f32x4*)(C.g_ckv + 8 * lane + 4);
        const f32x4 ya0 = a0 * ra * ga0, ya1 = a1 * ra * ga1, yb0 = b0 * rb * gb0, yb1 = b1 * rb * gb1;
        *(u32x4*)(out + (size_t)t * 1024 + 8 * lane) = (u32x4){cvt_pk_bf16(ya0[0], ya0[1]), cvt_pk_bf16(ya0[2], ya0[3]), cvt_pk_bf16(ya1[0], ya1[1]), cvt_pk_bf16(ya1[2], ya1[3])};
        *(u32x4*)(out + (size_t)t * 1024 + 512 + 8 * lane) = (u32x4){cvt_pk_bf16(yb0[0], yb0[1]), cvt_pk_bf16(yb0[2], yb0[3]), cvt_pk_bf16(yb1[0], yb1[1]), cvt_pk_bf16(yb1[2], yb1[3])};
        const float y = kv * rk * C.g_kr[lane]; const float partner = __shfl_xor(y, 32); const f32x2 cs = ropeM[(size_t)t * 32 + (lane & 31)];
        const float o = (lane < 32) ? (y * cs[0] - partner * cs[1]) : (y * cs[0] + partner * cs[1]);
        kr[(size_t)t * 64 + lane] = f2bf(o);
    }
}

__device__ __forceinline__ void unpack8(const u32x4 z, float (&f)[8]) { f[0] = bflo(z.x); f[1] = bfhi(z.x); f[2] = bflo(z.y); f[3] = bfhi(z.y); f[4] = bflo(z.z); f[5] = bfhi(z.z); f[6] = bflo(z.w); f[7] = bfhi(z.w); }
__device__ __forceinline__ u32x4 pack8f(const float (&f)[8]) { return (u32x4){cvt_pk_bf16(f[0], f[1]), cvt_pk_bf16(f[2], f[3]), cvt_pk_bf16(f[4], f[5]), cvt_pk_bf16(f[6], f[7])}; }
__device__ __forceinline__ float sum8sq(const float (&f)[8]) { return (f[0] * f[0] + f[1] * f[1]) + (f[2] * f[2] + f[3] * f[3]) + (f[4] * f[4] + f[5] * f[5]) + (f[6] * f[6] + f[7] * f[7]); }
__device__ __forceinline__ float xor4_dpp(float v, bool upper) { const float a = dpp_mov<0x104>(v), b = dpp_mov<0x114>(v); return upper ? b : a; }
__device__ __forceinline__ float red8(float v) { v += dpp_mov<0xB1>(v); v += dpp_mov<0x4E>(v); v += dpp_mov<0x141>(v); return v; }
constexpr size_t WS_KRB = WS_KA;
__device__ __forceinline__ void phase_kr_prep(const Ctx& C) {
    if (C.wg * NTHR >= T * 8) return;
    const float* kr = (const float*)(C.ws + WS_KR); bf16_t* KRB = (bf16_t*)(C.ws + WS_KRB); const f32x2* ropeM = (const f32x2*)(C.ws + WS_ROPEM);
    for (int g = C.wg * NTHR + C.tid; g < T * 8; g += C.nwg * NTHR) { const int t = g >> 3, sub = g & 7;
        const f32x4 kra = *(const f32x4*)(kr + (size_t)t * 64 + 8 * sub), krb = *(const f32x4*)(kr + (size_t)t * 64 + 8 * sub + 4);
        float kk[8] = {kra[0], kra[1], kra[2], kra[3], krb[0], krb[1], krb[2], krb[3]}; const float rkr = rsqrtf(red8(sum8sq(kk)) * (1.f / 64.f) + EPS); float ko[8];
#pragma unroll
        for (int i = 0; i < 8; ++i) kk[i] *= rkr * C.g_kr[8 * sub + i];
#pragma unroll
        for (int i = 0; i < 8; ++i) { const float partner = xor4_dpp(kk[i], sub >= 4); const f32x2 cs = ropeM[(size_t)t * 32 + 8 * (sub & 3) + i];
            ko[i] = (sub < 4) ? (kk[i] * cs[0] - partner * cs[1]) : (kk[i] * cs[0] + partner * cs[1]); }
        *(u32x4*)(KRB + (size_t)t * 64 + 8 * sub) = pack8f(ko); }
}
__device__ __forceinline__ void phase_qkv_heads(const Ctx& C) {
    const bf16_t* R = (const bf16_t*)(C.ws + WS_QKVR); const float* kr = (const float*)(C.ws + WS_KR);
    bf16_t* KRB = (bf16_t*)(C.ws + WS_KRB); bf16_t* VT = (bf16_t*)(C.ws + WS_VT);
    const f32x2* ropeM = (const f32x2*)(C.ws + WS_ROPEM);
    LAS bf16_t* vt = (LAS bf16_t*)C.lds;
    const int tid = C.tid, sl = tid >> 3, sub = tid & 7;
    for (int u = C.wg; u < NBATCH * MLA_H * (SEQ / 64); u += C.nwg) {
        const int sblk = u & 63, h = (u >> 6) & 15, b = u >> 10;
        const int s = sblk * 64 + sl, t = b * SEQ + s;
        const bf16_t* kvrow = R + (size_t)t * 7168 + 3072 + h * 256;
        const u32x4 zv0 = *(const u32x4*)(kvrow + 128 + 16 * sub), zv1 = *(const u32x4*)(kvrow + 128 + 16 * sub + 8);
        if (h == 0) {
            const f32x4 kra = *(const f32x4*)(kr + (size_t)t * 64 + 8 * sub), krb = *(const f32x4*)(kr + (size_t)t * 64 + 8 * sub + 4);
            float kk[8] = {kra[0], kra[1], kra[2], kra[3], krb[0], krb[1], krb[2], krb[3]}; const float rkr = rsqrtf(red8(sum8sq(kk)) * (1.f / 64.f) + EPS); float ko[8];
#pragma unroll
            for (int i = 0; i < 8; ++i) kk[i] *= rkr * C.g_kr[8 * sub + i];
#pragma unroll
            for (int i = 0; i < 8; ++i) { const float partner = xor4_dpp(kk[i], sub >= 4); const f32x2 cs = ropeM[(size_t)t * 32 + 8 * (sub & 3) + i];
                ko[i] = (sub < 4) ? (kk[i] * cs[0] - partner * cs[1]) : (kk[i] * cs[0] + partner * cs[1]); }
            *(u32x4*)(KRB + (size_t)t * 64 + 8 * sub) = pack8f(ko);
        }
        { const unsigned w[8] = {zv0.x, zv0.y, zv0.z, zv0.w, zv1.x, zv1.y, zv1.z, zv1.w};
#pragma unroll
          for (int i = 0; i < 8; ++i) { vt[(16 * sub + 2 * i) * 72 + sl] = (bf16_t)(w[i] & 0xffff); vt[(16 * sub + 2 * i + 1) * 72 + sl] = (bf16_t)(w[i] >> 16); } }
        __syncthreads();
        { const int d = tid >> 2, q4 = tid & 3; const LAS bf16_t* src = vt + d * 72 + 16 * q4;
          bf16_t* dst = VT + (((size_t)b * MLA_H + h) * VH + d) * SEQ + sblk * 64 + 16 * q4;
          *(u32x4*)dst = *(const LAS u32x4*)src; *(u32x4*)(dst + 8) = *(const LAS u32x4*)(src + 8); }
        __syncthreads();
    }
}

constexpr int ATT_KB = 25600, ATT_VB = 18432, ATT_VOFF = 2 * ATT_KB, ATT_ALOFF = ATT_VOFF + 3 * ATT_VB;
__device__ __forceinline__ void attn_block(const Ctx& C, int b, int h, int qb) {
    int lane_ = C.lane; asm volatile("" : "+v"(lane_));
    const int lane = lane_, wave = C.wave, tid = wave * 64 + lane, c32 = lane & 31, hi = lane >> 5;
    const bf16_t* Qg = (const bf16_t*)(C.ws + WS_QKVR) + (size_t)b * SEQ * 7168 + h * 192;
    const bf16_t* Kg = (const bf16_t*)(C.ws + WS_QKVR) + (size_t)b * SEQ * 7168 + 3072 + h * 256;
    const bf16_t* KRg = (const bf16_t*)(C.ws + WS_KRB) + (size_t)b * SEQ * 64;
    const bf16_t* Vg = (const bf16_t*)(C.ws + WS_VT) + (((size_t)b * MLA_H + h) * VH) * SEQ;
    bf16_t* Og = (bf16_t*)(C.ws + WS_AO) + (size_t)b * SEQ * 2048 + h * 128;
    LAS float* al = (LAS float*)(C.lds + ATT_ALOFF) + wave * 32;
    const int q0 = qb * 256, qw = q0 + 32 * wave, qpos = qw + c32;
        const int srow = tid >> 3, ssub = tid & 7;
    u32x4 sk[3], sv[2];
#define ATT_LOAD(k0_) do { const bf16_t* kp_ = Kg + (size_t)((k0_) + srow) * 7168 + 8 * ssub; const bf16_t* vp_ = Vg + (size_t)srow * SEQ + (k0_) + 8 * ssub; \
        sk[0] = *(const u32x4*)kp_; sk[1] = *(const u32x4*)(kp_ + 64); sk[2] = *(const u32x4*)(KRg + (size_t)((k0_) + srow) * 64 + 8 * ssub); sv[0] = *(const u32x4*)vp_; sv[1] = *(const u32x4*)(vp_ + (size_t)64 * SEQ); } while (0)
#define ATT_WRITE(kb_, vb_) do { LAS bf16_t* Kw = (LAS bf16_t*)(C.lds + (kb_) * ATT_KB) + srow * 200 + 8 * ssub; LAS bf16_t* Vw = (LAS bf16_t*)(C.lds + ATT_VOFF + (vb_) * ATT_VB) + srow * 72 + 8 * ssub; \
        float ka_[8], kb_f[8]; unpack8(sk[0], ka_); unpack8(sk[1], kb_f); const float rk_ = rsqrtf(red8(sum8sq(ka_) + sum8sq(kb_f)) * (1.f / 128.f) + EPS); \
        _Pragma("unroll") for (int i_ = 0; i_ < 8; ++i_) { ka_[i_] *= rk_; kb_f[i_] *= rk_; } \
        *(LAS u32x4*)Kw = pack8f(ka_); *(LAS u32x4*)(Kw + 64) = pack8f(kb_f); *(LAS u32x4*)(Kw + 128) = sk[2]; *(LAS u32x4*)Vw = sv[0]; *(LAS u32x4*)(Vw + 64 * 72) = sv[1]; } while (0)
    bf16x8 qr[12];
    { constexpr float QSCALE = 0.07216878364870322f * 1.4426950408889634f;
      const bf16_t* qrow = Qg + (size_t)qpos * 7168; float ssn = 0.f, ssr = 0.f; u32x4 zq[12];
#pragma unroll
      for (int ks = 0; ks < 12; ++ks) zq[ks] = *(const u32x4*)(qrow + 16 * ks + 8 * hi);
#pragma unroll
      for (int ks = 0; ks < 12; ++ks) { float f[8]; unpack8(zq[ks], f); if (ks < 8) ssn += sum8sq(f); else ssr += sum8sq(f); }
      const float rq = rsqrtf(half_swap_add(ssn) * (1.f / 128.f) + EPS) * QSCALE, rr = rsqrtf(half_swap_add(ssr) * (1.f / 64.f) + EPS);
#pragma unroll
      for (int ks = 0; ks < 8; ++ks) { float f[8]; unpack8(zq[ks], f); const f32x4 ga = *(const f32x4*)(C.g_qn + 16 * ks + 8 * hi), gb = *(const f32x4*)(C.g_qn + 16 * ks + 8 * hi + 4), ka = *(const f32x4*)(C.g_kn + 16 * ks + 8 * hi), kb = *(const f32x4*)(C.g_kn + 16 * ks + 8 * hi + 4);
#pragma unroll
          for (int j = 0; j < 4; ++j) { f[j] *= rq * ga[j] * ka[j]; f[4 + j] *= rq * gb[j] * kb[j]; }
          const u32x4 w = pack8f(f); qr[ks] = *reinterpret_cast<const bf16x8*>(&w); }
      const int tq = b * SEQ + qpos;
#pragma unroll
      for (int pr = 0; pr < 2; ++pr) {
          float x1[8], x2[8], o1[8], o2[8]; unpack8(zq[8 + pr], x1); unpack8(zq[10 + pr], x2);
          const f32x4 g1a = *(const f32x4*)(C.g_qr + 16 * pr + 8 * hi), g1b = *(const f32x4*)(C.g_qr + 16 * pr + 8 * hi + 4), g2a = *(const f32x4*)(C.g_qr + 32 + 16 * pr + 8 * hi), g2b = *(const f32x4*)(C.g_qr + 32 + 16 * pr + 8 * hi + 4);
          const f32x4* csp = (const f32x4*)((const float*)(C.ws + WS_ROPEM) + ((size_t)tq * 32 + 16 * pr + 8 * hi) * 2);
#pragma unroll
          for (int j = 0; j < 8; ++j) { x1[j] *= rr * (j < 4 ? g1a[j] : g1b[j - 4]); x2[j] *= rr * (j < 4 ? g2a[j] : g2b[j - 4]); }
#pragma unroll
          for (int j2 = 0; j2 < 4; ++j2) { const f32x4 cs = csp[j2];
              o1[2 * j2] = (x1[2 * j2] * cs[0] - x2[2 * j2] * cs[1]) * QSCALE; o2[2 * j2] = (x2[2 * j2] * cs[0] + x1[2 * j2] * cs[1]) * QSCALE;
              o1[2 * j2 + 1] = (x1[2 * j2 + 1] * cs[2] - x2[2 * j2 + 1] * cs[3]) * QSCALE; o2[2 * j2 + 1] = (x2[2 * j2 + 1] * cs[2] + x1[2 * j2 + 1] * cs[3]) * QSCALE; }
          const u32x4 w1 = pack8f(o1), w2 = pack8f(o2); qr[8 + pr] = *reinterpret_cast<const bf16x8*>(&w1); qr[10 + pr] = *reinterpret_cast<const bf16x8*>(&w2); } }
    constexpr float THR2 = 10.f;
    float m_reg = -1e30f, l_reg = 0.f; f32x16 o[4]; bf16x8 pa0 = bf16x8{}, pa1 = bf16x8{}, pa2 = bf16x8{}, pa3 = bf16x8{};
#pragma unroll
    for (int d = 0; d < 4; ++d) o[d] = f32x16{};
#define ATT_RESC_PA(PA_, al_) do { u32x4 w_ = *reinterpret_cast<const u32x4*>(&(PA_)); \
        _Pragma("unroll") for (int i_ = 0; i_ < 4; ++i_) w_[i_] = cvt_pk_bf16(bflo(w_[i_]) * (al_), bfhi(w_[i_]) * (al_)); PA_ = *reinterpret_cast<const bf16x8*>(&w_); } while (0)
#define ATT_MAXCHK(P_, HASPA) do { float pm_ = fmaxf(P_[0], P_[1]); \
        _Pragma("unroll") for (int r = 2; r < 16; ++r) pm_ = fmaxf(pm_, P_[r]); \
        pm_ = half_swap_max(pm_); \
        if (!__all(pm_ - m_reg <= THR2)) { const float mn_ = fmaxf(m_reg, pm_); const float alpha_ = __builtin_amdgcn_exp2f(m_reg - mn_); m_reg = mn_; l_reg *= alpha_; \
            if (HASPA) { ATT_RESC_PA(pa0, alpha_); ATT_RESC_PA(pa1, alpha_); } \
            if (hi == 0) al[c32] = alpha_; LDS_WAIT(); \
            _Pragma("unroll") for (int d = 0; d < 4; ++d) _Pragma("unroll") for (int r = 0; r < 16; ++r) o[d][r] *= al[crow(r, hi)]; } } while (0)
    const int ntile = (q0 + 256) / 64;
    ATT_LOAD(0); ATT_WRITE(0, 0);
    __syncthreads();
    for (int kt = 0; kt < ntile; ++kt) {
        const int k0 = kt * 64;
        if (kt + 1 < ntile) ATT_LOAD(k0 + 64);
        if (k0 <= qw + 31) {
            const LAS bf16_t* Kl = (const LAS bf16_t*)(C.lds + (kt & 1) * ATT_KB) + c32 * 200 + 8 * hi;
            const LAS bf16_t* Vl = (const LAS bf16_t*)(C.lds + ATT_VOFF + (kt & 1) * ATT_VB) + c32 * 72 + 8 * hi;
            const bool diag = (k0 + 63 > qw);
            const float NEG = -__builtin_inff();
            f32x16 p0 = f32x16{}, p1 = f32x16{};
#pragma unroll
            for (int ks = 0; ks < 12; ++ks) p0 = mfma32(*(const LAS bf16x8*)(Kl + 16 * ks), qr[ks], p0);
            if (diag) {
#pragma unroll
                for (int r = 0; r < 16; ++r) if (k0 + crow(r, hi) > qpos) p0[r] = NEG; }
            ATT_MAXCHK(p0, false);
#pragma unroll
            for (int ks = 0; ks < 12; ++ks) p1 = mfma32(*(const LAS bf16x8*)(Kl + 32 * 200 + 16 * ks), qr[ks], p1);
            { float ps = 0.f;
#pragma unroll
              for (int r = 0; r < 16; ++r) { p0[r] = __builtin_amdgcn_exp2f(p0[r] - m_reg); ps += p0[r]; }
              l_reg += ps; }
            PK4(p0, 0, pa0); PK4(p0, 8, pa1);
            if (diag) {
#pragma unroll
                for (int r = 0; r < 16; ++r) if (k0 + 32 + crow(r, hi) > qpos) p1[r] = NEG; }
            ATT_MAXCHK(p1, true);
#pragma unroll
            for (int d = 0; d < 4; ++d) { o[d] = mfma32(pa0, *(const LAS bf16x8*)(Vl + (32 * d) * 72), o[d]); o[d] = mfma32(pa1, *(const LAS bf16x8*)(Vl + (32 * d) * 72 + 16), o[d]); }
            { float ps = 0.f;
#pragma unroll
              for (int r = 0; r < 16; ++r) { p1[r] = __builtin_amdgcn_exp2f(p1[r] - m_reg); ps += p1[r]; }
              l_reg += ps; }
            PK4(p1, 0, pa2); PK4(p1, 8, pa3);
#pragma unroll
            for (int d = 0; d < 4; ++d) { o[d] = mfma32(pa2, *(const LAS bf16x8*)(Vl + (32 * d) * 72 + 32), o[d]); o[d] = mfma32(pa3, *(const LAS bf16x8*)(Vl + (32 * d) * 72 + 48), o[d]); }
        }
        if (kt + 1 < ntile) ATT_WRITE((kt + 1) & 1, (kt + 1) & 1);
        __syncthreads();
    }
    l_reg = half_swap_add(l_reg);
    if (hi == 0) al[c32] = 1.f / l_reg;
    LDS_WAIT();
    { LAS bf16_t* ot = (LAS bf16_t*)(C.lds + wave * 8704);
#pragma unroll
      for (int r = 0; r < 16; ++r) { const float il = al[crow(r, hi)];
#pragma unroll
          for (int d = 0; d < 4; ++d) ot[crow(r, hi) * 136 + 32 * d + c32] = f2bf(o[d][r] * il); }
      LDS_WAIT();
#pragma unroll
      for (int i = 0; i < 8; ++i) { const int ch = i * 64 + lane, row = ch >> 4, c16 = ch & 15;
          *(u32x4*)(Og + (size_t)(qw + row) * 2048 + 8 * c16) = *(const LAS u32x4*)(ot + row * 136 + 8 * c16); } }
    LDS_WAIT();
    __syncthreads();
#undef ATT_MAXCHK
#undef ATT_RESC_PA
#undef ATT_LOAD
#undef ATT_WRITE
}
__device__ __forceinline__ void phase_attention(const Ctx& C) {
    const int grp = (C.wg >> 3) % 3;
    for (int p = C.wg; p < NBATCH * MLA_H * 8; p += C.nwg) {
        const int bh = p >> 3, j = p & 7;
#pragma unroll 1
        for (int slot = 0; slot < 3; ++slot) {
            if (slot == grp && p == C.wg) expert_weights_range(C, EXP_P1_END, EXP_N_ALL, C.wg, C.nwg);
            if (slot < 2) attn_block(C, bh >> 4, bh & 15, slot == 0 ? 15 - j : j);
        }
    }
}
__device__ __forceinline__ void phase_moe_scatter(const Ctx& C) {
    const int* cnt = (const int*)(C.ws + WS_CNT); const int* rte = (const int*)(C.ws + WS_RTE);
    int* rtrow = (int*)(C.ws + WS_RTROW); int* tab = (int*)(C.ws + WS_MOETAB);
    LAS int* sh = (LAS int*)C.lds;
    const int tid = C.tid, lane = C.lane, wave = C.wave, rows_per_wg = T / C.nwg;
    if (wave == 0) {
        int tot = 0, pre = 0;
        if (C.nwg == 256) { int cv[32];
#pragma unroll
            for (int j = 0; j < 32; ++j) cv[j] = cnt[((lane >> 3) + 8 * j) * 8 + (lane & 7)];
#pragma unroll
            for (int j = 0; j < 32; ++j) { const int w = (lane >> 3) + 8 * j; if (w < C.wg) pre += cv[j]; tot += cv[j]; }
        } else for (int w = lane >> 3; w < C.nwg; w += 8) { const int c = cnt[w * 8 + (lane & 7)]; if (w < C.wg) pre += c; tot += c; }
        tot += __shfl_xor(tot, 8); tot += __shfl_xor(tot, 16); tot += __shfl_xor(tot, 32);
        pre += __shfl_xor(pre, 8); pre += __shfl_xor(pre, 16); pre += __shfl_xor(pre, 32);
        int start = 0, nrt = 0;
        for (int e = 0; e < 8; ++e) { const int te = __shfl(tot, e); if (e < lane) start += (te + 255) & ~255; nrt += (te + 255) >> 8; }
        if (lane < 8) { sh[lane] = start + pre; sh[8 + lane] = tot; sh[16 + lane] = start; }
        if (C.wg == 0 && lane < 8) { tab[lane] = start >> 8; tab[8 + lane] = (tot + 255) >> 8; }
        if (C.wg == 0 && lane == 0) tab[16] = nrt;
    }
    __syncthreads();
    if (wave == 0) {
        const int tl = lane >> 1, t = C.wg * rows_per_wg + tl; const int e = (tl < rows_per_wg) ? rte[2 * t + (lane & 1)] : -1;
        int rank = 0;
#pragma unroll
        for (int q = 0; q < 8; ++q) { const unsigned long long mk = __ballot(e == q); if (e == q) rank = __popcll(mk & ((1ull << lane) - 1ull)); }
        const int row = (e >= 0) ? sh[e] + rank : 0;
        if (e >= 0) rtrow[2 * t + (lane & 1)] = row;
        sh[32 + lane] = row;
    }
    __syncthreads();
    int* rowtok = (int*)(C.ws + WS_ROWTOK);
    if (tid < 2 * rows_per_wg) rowtok[sh[32 + tid]] = C.wg * rows_per_wg + (tid >> 1);
    if (C.wg < 8) { const int tot = sh[8 + C.wg], start = sh[16 + C.wg], r0 = start + tot, r1 = start + ((tot + 255) & ~255);
        for (int r = r0 + tid; r < r1; r += NTHR) rowtok[r] = T; }
    if (C.wg == 8 && tid < 128) ((u32x4*)(C.ws + WS_H + (size_t)T * D))[tid] = (u32x4){0u, 0u, 0u, 0u};
    __syncthreads();
}
constexpr int MOE_TOKS_OFF = 131072;
__device__ __forceinline__ const LAS int* moe_build_list(const Ctx& C, int npn, bool with_toks, bool split = false) {
    LAS int* t = (LAS int*)(C.lds + LDSCTL_OFF + 64); LAS int* list = (LAS int*)(C.lds + LDSCTL_OFF + 160);
    if (C.tid < 17) t[C.tid] = __hip_atomic_load((const int*)(C.ws + WS_MOETAB) + C.tid, __ATOMIC_RELAXED, __HIP_MEMORY_SCOPE_AGENT);
    __syncthreads();
    if (C.tid < 32) { int w = pg8::moe_unit_word(t, npn, C.nwg, C.wg, C.tid);
        if (split) { const int nfull = (t[16] * npn) / C.nwg; if (C.tid >= nfull) w = -1;
            if (C.tid == 31) { const int left = t[16] * npn - nfull * C.nwg, x = C.wg & 7, m = (C.wg >> 3) & 7, l = x + 8 * m; w = (l < left) ? pg8::moe_unit_word(t, npn, C.nwg, l, nfull) : -1; } }
        list[C.tid] = w; }
    __syncthreads();
    if (with_toks) { LAS int* toks = (LAS int*)(C.lds + MOE_TOKS_OFF); const int* rowtok = (const int*)(C.ws + WS_ROWTOK);
        if (C.tid < 256) { int tv[16];
#pragma unroll
            for (int i = 0; i < 16; ++i) { const int w = list[i]; tv[i] = rowtok[((w < 0 ? 0 : w) & 255) * 256 + C.tid]; }
#pragma unroll
            for (int i = 0; i < 16; ++i) toks[i * 256 + C.tid] = tv[i] * D; }
        __syncthreads(); }
    return list;
}
__device__ __forceinline__ void phase_moe_combine(const Ctx& C) {
    const bf16_t* x3 = (const bf16_t*)(C.ws + WS_X1); const bf16_t* OE = (const bf16_t*)(C.ws + WS_OE);
    const int* rtrow = (const int*)(C.ws + WS_RTROW); const float* rtw = (const float*)(C.ws + WS_RTW);
    const int gw = C.wg * NWAVES + C.wave, NGW = C.nwg * NWAVES, lane = C.lane;
    for (int t = gw; t < T; t += NGW) {
        const int r1 = rtrow[2 * t], r2 = rtrow[2 * t + 1]; const float w1 = rtw[2 * t], w2 = rtw[2 * t + 1];
        const u32x4* a = (const u32x4*)(OE + (size_t)r1 * D); const u32x4* b = (const u32x4*)(OE + (size_t)r2 * D);
        const u32x4* xr = (const u32x4*)(x3 + (size_t)t * D); f32x4* orow = (f32x4*)(C.out + (size_t)t * D);
#pragma unroll
        for (int j = 0; j < 4; ++j) { const int c = lane + 64 * j; const u32x4 av = a[c], bv = b[c]; const u32x4 xz = xr[c]; const f32x4 x0 = {bflo(xz.x), bfhi(xz.x), bflo(xz.y), bfhi(xz.y)}, x1 = {bflo(xz.z), bfhi(xz.z), bflo(xz.w), bfhi(xz.w)};
            f32x4 o0, o1;
            o0[0] = x0[0] + w1 * bflo(av.x) + w2 * bflo(bv.x); o0[1] = x0[1] + w1 * bfhi(av.x) + w2 * bfhi(bv.x); o0[2] = x0[2] + w1 * bflo(av.y) + w2 * bflo(bv.y); o0[3] = x0[3] + w1 * bfhi(av.y) + w2 * bfhi(bv.y);
            o1[0] = x1[0] + w1 * bflo(av.z) + w2 * bflo(bv.z); o1[1] = x1[1] + w1 * bfhi(av.z) + w2 * bfhi(bv.z); o1[2] = x1[2] + w1 * bflo(av.w) + w2 * bflo(bv.w); o1[3] = x1[3] + w1 * bfhi(av.w) + w2 * bfhi(bv.w);
            orow[2 * c] = o0; orow[2 * c + 1] = o1; }
    }
}

constexpr int NPHASE = 18;
struct Args { const void* in[27]; float* out; unsigned char* ws; int ph_lo, ph_hi; };
static_assert(sizeof(Args) == 27 * 8 + 8 + 8 + 8, "Args has no padding");

__global__ void __launch_bounds__(NTHR, 2) fwd_kernel(Args args) {
    extern __shared__ __attribute__((aligned(16))) unsigned char lds_raw[];
    Ctx C;
    C.lds = (LAS unsigned char*)lds_raw;
    C.tid = threadIdx.x; C.lane = C.tid & 63; C.wave = __builtin_amdgcn_readfirstlane(C.tid >> 6);
    C.nwg = gridDim.x; C.wg = blockIdx.x;
    C.x = (const float*)args.in[0]; C.pos = (const int*)args.in[1]; C.g_mix = (const float*)args.in[2]; C.g_ffn = (const float*)args.in[3]; C.w_in = (const float*)args.in[4];
    C.conv_w = (const float*)args.in[5]; C.b_gates = (const float*)args.in[6]; C.g_mo = (const float*)args.in[7]; C.g_ro = (const float*)args.in[8]; C.w_mix_out = (const float*)args.in[9];
    C.ffn_gate = (const float*)args.in[10]; C.ffn_up = (const float*)args.in[11]; C.ffn_down = (const float*)args.in[12]; C.w_dqkv = (const float*)args.in[13]; C.g_cq = (const float*)args.in[14];
    C.g_ckv = (const float*)args.in[15]; C.w_uq = (const float*)args.in[16]; C.w_ukv = (const float*)args.in[17]; C.g_qn = (const float*)args.in[18]; C.g_qr = (const float*)args.in[19];
    C.g_kn = (const float*)args.in[20]; C.g_kr = (const float*)args.in[21]; C.w_o = (const float*)args.in[22]; C.w_router = (const float*)args.in[23]; C.we_gate = (const float*)args.in[24];
    C.we_up = (const float*)args.in[25]; C.we_down = (const float*)args.in[26];
    C.out = args.out; C.ws = args.ws;
    unsigned char* ws = args.ws;
    volatile LAS unsigned* MISC = (volatile LAS unsigned*)(C.lds + MISC_OFF);
    for (int u = C.tid; u < (LDS_BYTES - LDSCTL_OFF) / 4; u += NTHR) ((LAS unsigned*)(C.lds + LDSCTL_OFF))[u] = 0u;
    __syncthreads();
    const int lo = args.ph_lo, hi = args.ph_hi;
    unsigned* barw = (unsigned*)(ws + WS_CTL) + CW_BAR;
    XcdBarrier bar; bar.bar = barw; bar.x = 0; bar.st = nullptr;
    if (hi - lo > 1) bar = xcd_barrier_post(barw, MISC + 8);
#ifdef ONLY_PHASE
#define IN(k) ((k) == ONLY_PHASE && lo <= (k) && (k) < hi)
#else
#define IN(k) (lo <= (k) && (k) < hi)
#endif
#define SEAM(k) do { if (IN(k) && IN((k) + 1)) xcd_barrier(bar); } while (0)
#ifdef PROBE_DUP
#define REPS(k) (((k) == PROBE_DUP) ? 2 : 1)
#else
#define REPS(k) 1
#endif
    bf16_t* Hn = (bf16_t*)(ws + WS_H);
    float* X1 = (float*)(ws + WS_X1); float* X2 = (float*)(ws + WS_X2);

    float* RSQ_X1 = (float*)(ws + WS_RSQ_X1); float* RSQ_X2 = (float*)(ws + WS_RSQ_X2); float* RSQ_CQ = (float*)(ws + WS_RSQ_CQ); float* RSQ_CKV = (float*)(ws + WS_RSQ_CKV);
    if (IN(0)) for (int rep_ = 0; rep_ < REPS(0); ++rep_) { phase_prologue(C); __syncthreads(); phase_norm<1>(C, C.x, C.g_mix, Hn, C.w_in + 4096, IN_COLS); } SEAM(0);
    if (IN(1)) for (int rep_ = 0; rep_ < REPS(1); ++rep_) { if (C.wg < 8) mlstm_scalar_scan(C, C.wg);
        pg8::Gemm g{Hn, (const bf16_t*)(ws + WS_WIN), D, D, D}; pg8::StaticOrder S; S.init(T, 8192, C.nwg, C.wg);
        pg8::EpiZ E{(bf16_t*)(ws + WS_Z), 8192, (const float*)(ws + WS_ROPER)};
        const int grp = (C.wg >> 3) & 3;
        { pg8::RangeOrder R{S, 0, grp}; pg8::gemm_phase<pg8::EpiZ, pg8::RangeOrder>(C.lds, g, R, E); }
        dense_weights_to_bf16(C, DI_WIN, DI_TOTAL); expert_weights_range(C, EXP_N_ALL, EXP_N_TOTAL2, C.wg, C.nwg); expert_weights_range(C, EXP_TAIL_END, EXP_P1_END, C.wg, C.nwg);
        { pg8::RangeOrder R{S, grp, 1 << 30}; pg8::gemm_phase<pg8::EpiZ, pg8::RangeOrder>(C.lds, g, R, E); } } SEAM(1);
    if (IN(2)) for (int rep_ = 0; rep_ < REPS(2); ++rep_) { phase_contrib(C); } SEAM(2);
    if (IN(3)) for (int rep_ = 0; rep_ < REPS(3); ++rep_) { phase_scan(C); } SEAM(3);
    if (IN(4)) for (int rep_ = 0; rep_ < REPS(4); ++rep_) { phase_mixout(C); } SEAM(4);
    if (IN(5)) for (int rep_ = 0; rep_ < REPS(5); ++rep_) { pg8::Gemm g{(const bf16_t*)(ws + WS_MIX), (const bf16_t*)(ws + WS_WOUT), D, D, D}; pg8::StaticOrder S; S.init(T, D, C.nwg, C.wg);
        pg8::EpiResNorm<true, true> E{(bf16_t*)X1, D, C.x, Hn, C.g_ffn, RSQ_X1}; pg8::gemm_phase<pg8::EpiResNorm<true, true>, pg8::StaticOrder>(C.lds, g, S, E); } SEAM(5);
    if (IN(6)) for (int rep_ = 0; rep_ < REPS(6); ++rep_) { pg8::Gemm g{Hn, (const bf16_t*)(ws + WS_WGU), D / 2, D / 2, D / 2}; pg8::StaticOrder S; S.init(T, 2 * DFF, C.nwg, C.wg);
        pg8::EpiSwiGLUScaled8 E{ws + WS_ACT, DFF, RSQ_X1, 1.f / D, EPS}; pg8::gemm_phase<pg8::EpiSwiGLUScaled8, pg8::StaticOrder, true, true, true>(C.lds, g, S, E);
        if (C.nwg == 256 && C.wg >= 128) expert_weights_range(C, 0, EXP_TAIL7, C.wg - 128, 128); else if (C.nwg != 256) expert_weights_range(C, 0, EXP_TAIL7, C.wg, C.nwg); } SEAM(6);
    if (IN(7)) for (int rep_ = 0; rep_ < REPS(7); ++rep_) { pg8::Gemm g{(const bf16_t*)(ws + WS_ACT), (const bf16_t*)(ws + WS_WD), DFF / 2, DFF / 2, DFF / 2}; pg8::StaticOrder S; S.init(T, D, C.nwg, C.wg);
        pg8::EpiResNorm<false> E{(bf16_t*)X2, D, X1, Hn, C.g_mix + D, RSQ_X2}; pg8::gemm_phase<pg8::EpiResNorm<false>, pg8::StaticOrder, true, true, true>(C.lds, g, S, E); } SEAM(7);
    if (IN(8)) for (int rep_ = 0; rep_ < REPS(8); ++rep_) { pg8::Gemm g{Hn, (const bf16_t*)(ws + WS_WDQKV), D, D, D}; pg8::StaticOrder S; S.init(T, NDQKV, C.nwg, C.wg);
        pg8::EpiLatent E{(bf16_t*)(ws + WS_CQKVN), (float*)(ws + WS_KR), RSQ_X2, RSQ_CQ, RSQ_CKV, C.g_cq, C.g_ckv, 1.f / D, EPS}; pg8::gemm_phase<pg8::EpiLatent, pg8::StaticOrder>(C.lds, g, S, E);
        if (C.nwg == 256 && C.wg >= 160) expert_weights_range(C, EXP_TAIL7, EXP_TAIL7 + EXP_TAIL9, C.wg - 160, 96); else if (C.nwg != 256) expert_weights_range(C, EXP_TAIL7, EXP_TAIL7 + EXP_TAIL9, C.wg, C.nwg); } SEAM(8);
    if (IN(9)) for (int rep_ = 0; rep_ < REPS(9); ++rep_) { phase_kr_prep(C); pg8::Gemm g{(const bf16_t*)(ws + WS_CQKVN), (const bf16_t*)(ws + WS_WUQKV), 512, 1024, 512}; pg8::DualOrder S; S.init(T, 7168, C.nwg, C.wg);
        pg8::EpiBf16Dual E{(bf16_t*)(ws + WS_QKVR), 7168, RSQ_CQ, RSQ_CKV, 1.f / 512.f, EPS, (bf16_t*)(ws + WS_VT), SEQ}; pg8::gemm_phase<pg8::EpiBf16Dual, pg8::DualOrder>(C.lds, g, S, E);
        if (C.nwg == 256 && C.wg >= 128) expert_weights_range(C, EXP_TAIL7 + EXP_TAIL9, EXP_TAIL_END, C.wg - 128, 128); else if (C.nwg != 256) expert_weights_range(C, EXP_TAIL7 + EXP_TAIL9, EXP_TAIL_END, C.wg, C.nwg); } SEAM(9);
    if (IN(11)) for (int rep_ = 0; rep_ < REPS(11); ++rep_) { phase_attention(C); } SEAM(11);
    if (IN(12)) for (int rep_ = 0; rep_ < REPS(12); ++rep_) { pg8::Gemm g{(const bf16_t*)(ws + WS_AO), (const bf16_t*)(ws + WS_WO), D, D, D}; pg8::StaticOrder S; S.init(T, D, C.nwg, C.wg);
        pg8::EpiF32 E{(bf16_t*)X1, D, (const bf16_t*)X2}; pg8::gemm_phase<pg8::EpiF32, pg8::StaticOrder>(C.lds, g, S, E); } SEAM(12);
    if (IN(13)) for (int rep_ = 0; rep_ < REPS(13); ++rep_) { phase_norm<2>(C, X1, C.g_ffn + D, Hn, C.w_router, 8); } SEAM(13);
    if (IN(14)) for (int rep_ = 0; rep_ < REPS(14); ++rep_) { phase_moe_scatter(C); } SEAM(14);
    if (IN(15)) for (int rep_ = 0; rep_ < REPS(15); ++rep_) { const LAS int* list = moe_build_list(C, 2 * DFF / 256, true);
        pg8::Gemm g{(const bf16_t*)(ws + WS_H), (const bf16_t*)(ws + WS_WEGU), D / 2, D / 2, D / 2}; pg8::MoeOrder S{list, 2 * DFF / 256, (const LAS int*)(C.lds + MOE_TOKS_OFF)};
        pg8::EpiSwiGLU8 E{ws + WS_ACTE, DFF}; pg8::gemm_phase<pg8::EpiSwiGLU8, pg8::MoeOrder, true, true, true, true>(C.lds, g, S, E); } SEAM(15);
    if (IN(16)) for (int rep_ = 0; rep_ < REPS(16); ++rep_) { const bool split = (C.nwg == 256); const LAS int* list = moe_build_list(C, D / 256, false, split);
        pg8::Gemm g{(const bf16_t*)(ws + WS_ACTE), (const bf16_t*)(ws + WS_WED), DFF / 2, DFF / 2, DFF / 2}; pg8::MoeOrder S{list, D / 256, (const LAS int*)(C.lds + MOE_TOKS_OFF)};
        pg8::EpiBf16 E{(bf16_t*)(ws + WS_OE), D}; pg8::gemm_phase<pg8::EpiBf16, pg8::MoeOrder, true, true, true>(C.lds, g, S, E);
        if (split) {
            const int w = __builtin_amdgcn_readfirstlane(list[31]);
            if (w >= 0) { const int rt = w & 255, pnl = (w >> 8) & 255, e = w >> 16, sl = C.wg >> 6, l = (C.wg & 7) + 8 * ((C.wg >> 3) & 7);
                const int koff = sl < 2 ? sl * 1536 : 3072 + (sl - 2) * 1280, kt = sl < 2 ? 12 : 10;
                pg8::Gemm g2{(const bf16_t*)(ws + WS_ACTE + koff), (const bf16_t*)(ws + WS_WED + koff), kt * 64, DFF / 2, DFF / 2};
                pg8::OneUnit S2{pg8::Unit{rt, e * (D / 256) + pnl, pnl, 0}, true};
                pg8::EpiSplitK E2{(bf16_t*)(ws + WS_OE), D, (float*)(ws + WS_SPLITK) + (size_t)l * (3 * 32 * 512 * 4), (unsigned*)(ws + WS_CTL) + CW_SPLITK + 16 * l, sl};
                pg8::gemm_phase<pg8::EpiSplitK, pg8::OneUnit, true, true, true>(C.lds, g2, S2, E2); } } } SEAM(16);
    if (IN(17)) for (int rep_ = 0; rep_ < REPS(17); ++rep_) { phase_moe_combine(C); }
#undef IN
#undef SEAM
}

extern "C" void kernel_launch(void* const* d_in, const int* in_sizes, int n_in, void* d_out, int out_size, void* d_ws, size_t ws_size, hipStream_t stream) {
    static int grid = 0;
    if (grid == 0) {
        if (n_in != 27 || out_size != T * D || ws_size < WS_END) { fprintf(stderr, "kernel_launch: unexpected problem (n_in %d, out %d, ws %zu < %zu)\n", n_in, out_size, ws_size, (size_t)WS_END); grid = -1; return; }
        int dev = 0, cus = 0;
        if (hipGetDevice(&dev) != hipSuccess || hipDeviceGetAttribute(&cus, hipDeviceAttributeMultiprocessorCount, dev) != hipSuccess) { grid = -1; return; }
        if (hipFuncSetAttribute((const void*)fwd_kernel, hipFuncAttributeMaxDynamicSharedMemorySize, LDS_BYTES) != hipSuccess) { fprintf(stderr, "kernel_launch: hipFuncSetAttribute failed\n"); grid = -1; return; }
        int per_cu = 0;
        if (hipOccupancyMaxActiveBlocksPerMultiprocessor(&per_cu, (const void*)fwd_kernel, NTHR, LDS_BYTES) != hipSuccess || per_cu < 1) fprintf(stderr, "kernel_launch: occupancy query reports %d\n", per_cu);
        (void)hipGetLastError();
        grid = 256;
        if (cus < 256) { fprintf(stderr, "kernel_launch: device has %d CUs, need 256\n", cus); grid = -1; return; }
    }
    if (grid < 0) return;
    if (hipMemsetAsync((char*)d_ws + WS_CTL, 0, CTL_ZERO_BYTES, stream) != hipSuccess) return;
    Args a{};
    for (int i = 0; i < 27; ++i) a.in[i] = d_in[i];
    a.out = (float*)d_out; a.ws = (unsigned char*)d_ws;
#if MK_ONE_LAUNCH
    a.ph_lo = 0; a.ph_hi = NPHASE;
    hipLaunchKernelGGL(fwd_kernel, dim3(grid), dim3(NTHR), LDS_BYTES, stream, a);
#else
    for (int ph = 0; ph < NPHASE; ++ph) { a.ph_lo = ph; a.ph_hi = ph + 1; hipLaunchKernelGGL(fwd_kernel, dim3(grid), dim3(NTHR), LDS_BYTES, stream, a); }
#endif
}
```

```cpp
#include <hip/hip_runtime.h>
#include <cstdio>
#include <cstdint>

#ifndef MK_ONE_LAUNCH
#define MK_ONE_LAUNCH 1
#endif

#define LAS __attribute__((address_space(3)))
#define GAS __attribute__((address_space(1)))
typedef unsigned short bf16_t;
typedef short bf16x8 __attribute__((ext_vector_type(8)));
typedef float f32x2 __attribute__((ext_vector_type(2)));
typedef float f32x4 __attribute__((ext_vector_type(4)));
typedef float f32x16 __attribute__((ext_vector_type(16)));
typedef unsigned u32x4 __attribute__((ext_vector_type(4)));
typedef unsigned u32x2 __attribute__((ext_vector_type(2)));

constexpr int T = 8192, SEQ = 4096, NBATCH = 2, D = 2048, DFF = 5632;
constexpr int IN_COLS = 8200, NEXP = 8;
constexpr int HM = 4, DH = 256;
constexpr int LM = 128, NCM = SEQ / LM;
constexpr int LR = 128, NCR = SEQ / LR;
constexpr int MLA_H = 16, QLORA = 512, KVLORA = 512, NOPE = 128, ROPE = 64, VH = 128, QKD = NOPE + ROPE;
constexpr int NDQKV = 1280;
constexpr float EPS = 1e-6f;
constexpr int MOE_ROWS = 18432;
constexpr int MOE_MAXRT = 72;

constexpr size_t MiB = 1u << 20;
constexpr size_t WS_CTL = 0, CTL_ZERO_BYTES = 128 * 1024;
constexpr size_t WS_SMALL = 1 * MiB;
constexpr size_t WS_ROPER = WS_SMALL;
constexpr size_t WS_ROPEM = WS_ROPER + 8 * MiB;
constexpr size_t WS_GI    = WS_ROPEM + 2 * MiB;
constexpr size_t WS_GF    = WS_GI + 128 * 1024;
constexpr size_t WS_BC    = WS_GF + 128 * 1024;
constexpr size_t WS_WL    = WS_BC + 128 * 1024;
constexpr size_t WS_MPREV = WS_WL + 128 * 1024;
constexpr size_t WS_DEC   = WS_MPREV + 4096;
constexpr size_t WS_UN    = WS_DEC + 4096;
constexpr size_t WS_RTE   = WS_UN + 512 * 1024;
constexpr size_t WS_RTW   = WS_RTE + 64 * 1024;
constexpr size_t WS_RTROW = WS_RTW + 64 * 1024;
constexpr size_t WS_CNT   = WS_RTROW + 64 * 1024;
constexpr size_t WS_MOETAB = WS_CNT + 8192;
constexpr size_t WS_KR    = WS_MOETAB + 4096;
constexpr size_t WS_RSQ_X1 = WS_KR + 2 * MiB;
constexpr size_t WS_RSQ_X2 = WS_RSQ_X1 + 256 * 1024;
constexpr size_t WS_RSQ_CQ = WS_RSQ_X2 + 256 * 1024;
constexpr size_t WS_RSQ_CKV = WS_RSQ_CQ + 64 * 1024;
constexpr size_t WS_ROWTOK = WS_RSQ_CKV + 64 * 1024;
static_assert(WS_ROWTOK + 18432 * 4 <= 16 * MiB, "small tables");
constexpr size_t WS_WIN   = 16 * MiB;
constexpr size_t WS_WOUT  = WS_WIN + 32 * MiB;
constexpr size_t WS_WGU   = WS_WOUT + 8 * MiB;
constexpr size_t WS_WD    = WS_WGU + 44 * MiB;
constexpr size_t WS_WDQKV = WS_WD + 22 * MiB;
constexpr size_t WS_WUQKV = WS_WDQKV + 5 * MiB;
constexpr size_t WS_WO    = WS_WUQKV + 7 * MiB;
constexpr size_t WS_WEGU  = WS_WO + 8 * MiB;
constexpr size_t WS_WED   = WS_WEGU + 176 * MiB;
constexpr size_t WS_H     = WS_WED + 88 * MiB;
constexpr size_t WS_X1    = WS_H + 32 * MiB;
constexpr size_t WS_X2    = WS_X1 + 64 * MiB;
constexpr size_t WS_OV    = WS_X2 + 64 * MiB;
constexpr size_t WS_Z     = WS_OV;
constexpr size_t WS_QKC   = WS_Z + 128 * MiB;
constexpr size_t WS_STM   = WS_QKC + 64 * MiB;
constexpr size_t WS_STR   = WS_STM + 64 * MiB;
constexpr size_t WS_MIX   = WS_STR + 32 * MiB;
constexpr size_t WS_ACT   = WS_MIX + 32 * MiB;
constexpr size_t WS_L0END = WS_ACT + 88 * MiB;
constexpr size_t WS_CQKV  = WS_OV;
constexpr size_t WS_CQKVN = WS_CQKV + 40 * MiB;
constexpr size_t WS_QKVR  = WS_CQKVN + 16 * MiB;
constexpr size_t WS_QA    = WS_QKVR + 112 * MiB;
constexpr size_t WS_KA    = WS_QA + 48 * MiB;
constexpr size_t WS_VT    = WS_KA + 48 * MiB;
constexpr size_t WS_AO    = WS_VT + 32 * MiB;
constexpr size_t WS_L1AEND = WS_AO + 32 * MiB;
constexpr size_t WS_HPERM = WS_OV;
constexpr size_t WS_ACTE  = WS_HPERM + 36 * MiB;
constexpr size_t WS_OE    = WS_ACTE + 99 * MiB;
constexpr size_t WS_SPLITK = WS_OE + 72 * MiB;
constexpr size_t WS_L1BEND = WS_SPLITK + 48 * MiB;
constexpr size_t WS_END = (WS_L0END > WS_L1AEND ? (WS_L0END > WS_L1BEND ? WS_L0END : WS_L1BEND) : (WS_L1AEND > WS_L1BEND ? WS_L1AEND : WS_L1BEND));
static_assert(WS_END <= (size_t)1400 * MiB, "d_ws map must stay under the guaranteed workspace size");

constexpr int CW_TMO = 0;
constexpr int CW_BAR = 4096;
constexpr int CW_SPLITK = 16384;
constexpr int RING_BYTES = 131072;
constexpr int LDSCTL_OFF = 155648, MISC_OFF = LDSCTL_OFF + 320;
constexpr int LDS_BYTES = LDSCTL_OFF + 1024;
constexpr int NWAVES = 8, NTHR = 512;

__device__ __forceinline__ unsigned cvt_pk_bf16(float lo, float hi) { unsigned r; asm volatile("v_cvt_pk_bf16_f32 %0, %1, %2" : "=v"(r) : "v"(lo), "v"(hi)); return r; }
__device__ __forceinline__ bf16_t f2bf(float f) { return (bf16_t)(cvt_pk_bf16(f, 0.f) & 0xffffu); }
__device__ __forceinline__ float bf2f(bf16_t b) { return __uint_as_float(((unsigned)b) << 16); }
__device__ __forceinline__ float bflo(unsigned w) { return __uint_as_float(w << 16); }
__device__ __forceinline__ float bfhi(unsigned w) { return __uint_as_float(w & 0xffff0000u); }
template <int CTRL> __device__ __forceinline__ float dpp_mov(float v) { return __builtin_bit_cast(float, __builtin_amdgcn_update_dpp(0, __builtin_bit_cast(int, v), CTRL, 0xf, 0xf, true)); }
__device__ __forceinline__ float half32_add(float v) { auto rr = __builtin_amdgcn_permlane32_swap(__float_as_uint(v), __float_as_uint(v), false, false); return __uint_as_float(rr[0]) + __uint_as_float(rr[1]); }
__device__ __forceinline__ float half32_max(float v) { auto rr = __builtin_amdgcn_permlane32_swap(__float_as_uint(v), __float_as_uint(v), false, false); return fmaxf(__uint_as_float(rr[0]), __uint_as_float(rr[1])); }
__device__ __forceinline__ float row16_sum(float v) { v += dpp_mov<0xB1>(v); v += dpp_mov<0x4E>(v); v += dpp_mov<0x141>(v); v += dpp_mov<0x140>(v); return v; }
__device__ __forceinline__ float wave_sum(float v) { v = row16_sum(v); v += __shfl_xor(v, 16); return half32_add(v); }
__device__ __forceinline__ float wave_max(float v) {
    v = fmaxf(v, dpp_mov<0xB1>(v)); v = fmaxf(v, dpp_mov<0x4E>(v)); v = fmaxf(v, dpp_mov<0x141>(v)); v = fmaxf(v, dpp_mov<0x140>(v));
    v = fmaxf(v, __shfl_xor(v, 16)); return half32_max(v);
}
__device__ __forceinline__ float silu_f(float x) { return x * __builtin_amdgcn_rcpf(1.f + __expf(-x)); }
__device__ __forceinline__ float sigmoid_f(float x) { return __builtin_amdgcn_rcpf(1.f + __expf(-x)); }
__device__ __forceinline__ float q8f(float x, float sc, float isc) { const int w = __builtin_amdgcn_cvt_pk_fp8_f32(x * sc, 0.f, 0, false); return __builtin_amdgcn_cvt_f32_fp8(w, 0) * isc; }
typedef int i32x8 __attribute__((ext_vector_type(8)));
typedef int i32x4 __attribute__((ext_vector_type(4)));
__device__ __forceinline__ unsigned pk4_fp8(float a, float b, float c, float d) { int w = __builtin_amdgcn_cvt_pk_fp8_f32(a, b, 0, false); w = __builtin_amdgcn_cvt_pk_fp8_f32(c, d, w, true); return (unsigned)w; }
constexpr float W8_SCALE = 64.f;
#ifndef FP8_EMU
#define FP8_EMU 0
#endif
#define LDS_WAIT() asm volatile("s_waitcnt lgkmcnt(0)" ::: "memory")
#define VM_WAIT() asm volatile("s_waitcnt vmcnt(0)" ::: "memory")
namespace pg8 {
#define PG8_LAS __attribute__((address_space(3)))
constexpr int BM = 256, BK = 64, HALF = 128, HTB = HALF * BK * 2, STAGE_BYTES = 8 * HTB, NXCD = 8, WGM = 8;

__host__ __device__ __forceinline__ int lds_byte(int r, int c) { const int st = (r >> 4) * 2 + (c >> 5), rr = r & 15, cc = c & 31, ob = rr * 64 + cc * 2; return st * 1024 + (ob ^ (((ob >> 9) & 1) << 5)); }
__host__ __device__ __forceinline__ void stage_rc(int b, int& R, int& C) { const int st = b / 1024, sb = b % 1024, swz = sb ^ (((sb >> 9) & 1) << 5); R = (st >> 1) * 16 + swz / 64; C = (st & 1) * 32 + (swz % 64) / 2; }
__host__ __device__ __forceinline__ int perm32(int rho) { const int n = rho >> 4, i = rho & 15; return 8 * (i >> 2) + 4 * n + (i & 3); }

struct Unit { int pm, pn, pc, aoff; };
struct Gemm { const bf16_t* A; const bf16_t* Bt; int K, lda, ldb; };

struct StaticOrder {
    int nM, nN, nwg, G, c;
    __host__ __device__ void init(int M, int N, int G_, int c_) { nM = M / BM; nN = N / BM; nwg = nM * nN; G = G_; c = c_; }
    __host__ __device__ bool next(int i, Unit& u) const {
        const long L = (long)i * G + c; if (L >= nwg) return false;
        int wgid = (int)L; { const int q = nwg / NXCD, r = nwg % NXCD, xcd = wgid % NXCD, off = wgid / NXCD; wgid = (xcd < r ? xcd * (q + 1) : r * (q + 1) + (xcd - r) * q) + off; }
        const int nig = WGM * nN, gid = wgid / nig, fm = gid * WGM, gsz = (nM - fm) < WGM ? (nM - fm) : WGM;
        u.pm = fm + ((wgid % nig) % gsz); u.pn = (wgid % nig) / gsz; u.pc = u.pn; u.aoff = 0; return true;
    }
};
struct RangeOrder { StaticOrder S; int lo, hi;
    __device__ __forceinline__ bool next(int i, Unit& u) const { return (lo + i < hi) && S.next(lo + i, u); } };
struct DualOrder : StaticOrder {
    __device__ bool next(int i, Unit& u) const { if (!StaticOrder::next(i, u)) return false; u.aoff = (u.pn >= 12) ? 512 * 2 : 0; return true; }
};
__device__ __forceinline__ int moe_unit_word(const PG8_LAS int* tab, int npn, int G, int c, int i) {
    const int nu = tab[16] * npn; const long L = (long)i * G + c; if (L >= nu) return -1;
    int id = (int)L; { const int q = nu / NXCD, r = nu % NXCD, xcd = id % NXCD, off = id / NXCD; id = (xcd < r ? xcd * (q + 1) : r * (q + 1) + (xcd - r) * q) + off; }
    int e = 0, base = 0;
    for (int j = 0; j < 7; ++j) { const int n = tab[8 + e] * npn; if (id >= base + n) { base += n; ++e; } }
    int cnt = tab[8 + e]; if (cnt < 1) cnt = 1;
    const int rr = id - base; const int pnl = rr / cnt, rt = tab[e] + rr % cnt;
    return rt | (pnl << 8) | (e << 16);
}
struct MoeOrder {
    const PG8_LAS int* list; int npn; const PG8_LAS int* toks;
    __device__ __forceinline__ int rowoff(int i, int r) const { return toks[i * 256 + r]; }
    __device__ __forceinline__ bool next(int i, Unit& u) const {
        const int w = __builtin_amdgcn_readfirstlane(list[i]); if (w < 0) return false;
        const int rt = w & 255, pnl = (w >> 8) & 255, e = w >> 16;
        u.pm = rt; u.pn = e * npn + pnl; u.pc = pnl; u.aoff = 0; return true;
    }
};

struct EpiBf16 {
    static constexpr bool PERM = true, AFTER_DRAIN = false; static constexpr int NSTORES = 16;
    bf16_t* O; int ldc;
    __device__ __forceinline__ void operator()(const f32x4 (&acc)[2][2][4][2], const Unit& u, int wr, int wc, int fr, int fq) const {
        const int row0 = u.pm * BM + wr * 64 + fr, col0 = u.pc * BM + wc * 32 + 8 * fq;
#pragma unroll
        for (int ai = 0; ai < 2; ++ai)
#pragma unroll
            for (int m = 0; m < 4; ++m) { bf16_t* rowp = O + (size_t)(row0 + ai * HALF + m * 16) * ldc + col0;
#pragma unroll
                for (int bj = 0; bj < 2; ++bj) { const f32x4 v0 = acc[ai][bj][m][0], v1 = acc[ai][bj][m][1];
                    u32x4 w; w.x = cvt_pk_bf16(v0[0], v0[1]); w.y = cvt_pk_bf16(v0[2], v0[3]); w.z = cvt_pk_bf16(v1[0], v1[1]); w.w = cvt_pk_bf16(v1[2], v1[3]);
                    *(u32x4*)(rowp + bj * HALF) = w; } }
    }
};
struct EpiZ {
    static constexpr bool PERM = true, AFTER_DRAIN = false; static constexpr int NSTORES = 16;
    bf16_t* O; int ldc; const float* rope;
    __device__ __forceinline__ void operator()(const f32x4 (&acc)[2][2][4][2], const Unit& u, int wr, int wc, int fr, int fq) const {
        const int row0 = u.pm * BM + wr * 64 + fr, col0 = u.pc * BM + wc * 32 + 8 * fq;
        const bool rot = (u.pc >= 16) && (u.pc < 24); const float sc = (u.pc >= 20) ? 0.0625f : 1.f;
#pragma unroll
        for (int ai = 0; ai < 2; ++ai)
#pragma unroll
            for (int m = 0; m < 4; ++m) { const int row = row0 + ai * HALF + m * 16; bf16_t* rowp = O + (size_t)row * ldc + col0;
                f32x4 a0 = acc[ai][0][m][0], a1 = acc[ai][0][m][1], b0 = acc[ai][1][m][0], b1 = acc[ai][1][m][1];
                if (rot) { const f32x4* cp = (const f32x4*)(rope + ((size_t)row * 128 + wc * 32 + 8 * fq) * 2);
                    const f32x4 c0 = cp[0], c1 = cp[1], c2 = cp[2], c3 = cp[3];
                    const f32x4 C0 = {c0[0], c0[2], c1[0], c1[2]}, S0 = {c0[1], c0[3], c1[1], c1[3]}, C1 = {c2[0], c2[2], c3[0], c3[2]}, S1 = {c2[1], c2[3], c3[1], c3[3]};
                    const f32x4 y0 = (a0 * C0 - b0 * S0) * sc, z0 = (b0 * C0 + a0 * S0) * sc, y1 = (a1 * C1 - b1 * S1) * sc, z1 = (b1 * C1 + a1 * S1) * sc;
                    a0 = y0; b0 = z0; a1 = y1; b1 = z1; }
                u32x4 w; w.x = cvt_pk_bf16(a0[0], a0[1]); w.y = cvt_pk_bf16(a0[2], a0[3]); w.z = cvt_pk_bf16(a1[0], a1[1]); w.w = cvt_pk_bf16(a1[2], a1[3]);
                *(u32x4*)rowp = w;
                w.x = cvt_pk_bf16(b0[0], b0[1]); w.y = cvt_pk_bf16(b0[2], b0[3]); w.z = cvt_pk_bf16(b1[0], b1[1]); w.w = cvt_pk_bf16(b1[2], b1[3]);
                *(u32x4*)(rowp + HALF) = w; }
    }
};
template <bool Q8 = false> struct EpiSwiGLU {
    static constexpr bool PERM = true, AFTER_DRAIN = false; static constexpr int NSTORES = 8;
    bf16_t* O; int ldc;
    __device__ __forceinline__ void operator()(const f32x4 (&acc)[2][2][4][2], const Unit& u, int wr, int wc, int fr, int fq) const {
        const int row0 = u.pm * BM + wr * 64 + fr, col0 = u.pc * HALF + wc * 32 + 8 * fq;
#pragma unroll
        for (int ai = 0; ai < 2; ++ai)
#pragma unroll
            for (int m = 0; m < 4; ++m) { bf16_t* rowp = O + (size_t)(row0 + ai * HALF + m * 16) * ldc + col0;
                float o[8];
#pragma unroll
                for (int n = 0; n < 2; ++n)
#pragma unroll
                    for (int j = 0; j < 4; ++j) { const float g = acc[ai][0][m][n][j], up = acc[ai][1][m][n][j]; float ov = g * up * __builtin_amdgcn_rcpf(1.f + __expf(-g)); if (Q8) ov = q8f(ov, 1.f, 1.f); o[n * 4 + j] = ov; }
                u32x4 w; w.x = cvt_pk_bf16(o[0], o[1]); w.y = cvt_pk_bf16(o[2], o[3]); w.z = cvt_pk_bf16(o[4], o[5]); w.w = cvt_pk_bf16(o[6], o[7]);
                *(u32x4*)rowp = w; }
    }
};
struct EpiSwiGLU8 {
    static constexpr bool PERM = true, AFTER_DRAIN = false; static constexpr int NSTORES = 8;
    unsigned char* O; int ldc;
    __device__ __forceinline__ void operator()(const f32x4 (&acc)[2][2][4][2], const Unit& u, int wr, int wc, int fr, int fq) const {
        const int row0 = u.pm * BM + wr * 64 + fr, col0 = u.pc * HALF + wc * 32 + 8 * fq;
#pragma unroll
        for (int ai = 0; ai < 2; ++ai)
#pragma unroll
            for (int m = 0; m < 4; ++m) { unsigned char* rowp = O + (size_t)(row0 + ai * HALF + m * 16) * ldc + col0;
                float o[8];
#pragma unroll
                for (int n = 0; n < 2; ++n)
#pragma unroll
                    for (int j = 0; j < 4; ++j) { const float g = acc[ai][0][m][n][j], up = acc[ai][1][m][n][j]; o[n * 4 + j] = g * up * __builtin_amdgcn_rcpf(1.f + __expf(-g)); }
                *(u32x2*)rowp = (u32x2){pk4_fp8(o[0], o[1], o[2], o[3]), pk4_fp8(o[4], o[5], o[6], o[7])}; }
    }
};
struct EpiF32 {
    static constexpr bool PERM = true, AFTER_DRAIN = false; static constexpr int NSTORES = 16;
    bf16_t* C; int ldc; const bf16_t* res;
    __device__ __forceinline__ void operator()(const f32x4 (&acc)[2][2][4][2], const Unit& u, int wr, int wc, int fr, int fq) const {
        const int row0 = u.pm * BM + wr * 64 + fr, col0 = u.pc * BM + wc * 32 + 8 * fq;
#pragma unroll
        for (int ai = 0; ai < 2; ++ai)
#pragma unroll
            for (int m = 0; m < 4; ++m) { const size_t off = (size_t)(row0 + ai * HALF + m * 16) * ldc + col0;
#pragma unroll
                for (int bj = 0; bj < 2; ++bj) { f32x4 v0 = acc[ai][bj][m][0], v1 = acc[ai][bj][m][1]; const u32x4 rz = *(const u32x4*)(res + off + bj * HALF);
                    v0[0] += bflo(rz.x); v0[1] += bfhi(rz.x); v0[2] += bflo(rz.y); v0[3] += bfhi(rz.y); v1[0] += bflo(rz.z); v1[1] += bfhi(rz.z); v1[2] += bflo(rz.w); v1[3] += bfhi(rz.w);
                    *(u32x4*)(C + off + bj * HALF) = (u32x4){cvt_pk_bf16(v0[0], v0[1]), cvt_pk_bf16(v0[2], v0[3]), cvt_pk_bf16(v1[0], v1[1]), cvt_pk_bf16(v1[2], v1[3])}; } }
    }
};

__device__ __forceinline__ float fq_reduce(float s) { s += __shfl_xor(s, 16); return half32_add(s); }
__device__ __forceinline__ float slot_sum8(const float* p) { const f32x4 a = *(const f32x4*)p, b = *(const f32x4*)(p + 4); return ((a[0] + a[1]) + (a[2] + a[3])) + ((b[0] + b[1]) + (b[2] + b[3])); }
__device__ __forceinline__ void rowsq_publish(const float (&ss)[2][4], PG8_LAS unsigned char* lds, int pm, int wr, int wc, int fr, int fq, float* slot, int nslot, int sidx, bool active) {
    PG8_LAS float* P = (PG8_LAS float*)lds;
#pragma unroll
    for (int ai = 0; ai < 2; ++ai)
#pragma unroll
        for (int m = 0; m < 4; ++m) if (fq == 0) P[(ai * HALF + wr * 64 + m * 16 + fr) * 4 + wc] = ss[ai][m];
    asm volatile("s_waitcnt lgkmcnt(0)" ::: "memory"); __builtin_amdgcn_s_barrier(); asm volatile("" ::: "memory");
    const int row = threadIdx.x;
    if (row < 256 && active) { const f32x4 q = *(const PG8_LAS f32x4*)(P + row * 4); slot[(size_t)(pm * BM + row) * nslot + sidx] = (q[0] + q[1]) + (q[2] + q[3]); }
    asm volatile("s_waitcnt lgkmcnt(0)" ::: "memory"); __builtin_amdgcn_s_barrier(); asm volatile("" ::: "memory");
}
template <bool H8 = false, bool RF32 = false> struct EpiResNorm {
    static constexpr bool PERM = true, AFTER_DRAIN = true; static constexpr int NSTORES = 0;
    bf16_t* C; int ldc; const void* res; bf16_t* H; const float* gain; float* slot;
    __device__ __forceinline__ void fused(const f32x4 (&acc)[2][2][4][2], const Unit& u, int wr, int wc, int fr, int fq, PG8_LAS unsigned char* lds) const {
        const int row0 = u.pm * BM + wr * 64 + fr, col0 = u.pc * BM + wc * 32 + 8 * fq;
        f32x4 gv[2][2]; float ss[2][4];
#pragma unroll
        for (int bj = 0; bj < 2; ++bj)
#pragma unroll
            for (int n = 0; n < 2; ++n) gv[bj][n] = *(const f32x4*)(gain + col0 + bj * HALF + n * 4);
#pragma unroll
        for (int ai = 0; ai < 2; ++ai)
#pragma unroll
            for (int m = 0; m < 4; ++m) { const int row = row0 + ai * HALF + m * 16; const size_t off = (size_t)row * ldc + col0; float s = 0.f;
#pragma unroll
                for (int bj = 0; bj < 2; ++bj) { f32x4 v0 = acc[ai][bj][m][0], v1 = acc[ai][bj][m][1];
                    if (RF32) { v0 += *(const f32x4*)((const float*)res + off + bj * HALF); v1 += *(const f32x4*)((const float*)res + off + bj * HALF + 4); }
                    else { const u32x4 rz = *(const u32x4*)((const bf16_t*)res + off + bj * HALF);
                        v0[0] += bflo(rz.x); v0[1] += bfhi(rz.x); v0[2] += bflo(rz.y); v0[3] += bfhi(rz.y); v1[0] += bflo(rz.z); v1[1] += bfhi(rz.z); v1[2] += bflo(rz.w); v1[3] += bfhi(rz.w); }
                    *(u32x4*)(C + off + bj * HALF) = (u32x4){cvt_pk_bf16(v0[0], v0[1]), cvt_pk_bf16(v0[2], v0[3]), cvt_pk_bf16(v1[0], v1[1]), cvt_pk_bf16(v1[2], v1[3])};
                    s += ((v0[0] * v0[0] + v0[1] * v0[1]) + (v0[2] * v0[2] + v0[3] * v0[3])) + ((v1[0] * v1[0] + v1[1] * v1[1]) + (v1[2] * v1[2] + v1[3] * v1[3]));
                    const f32x4 h0 = v0 * gv[bj][0], h1 = v1 * gv[bj][1];
                    if (H8) *(u32x2*)((unsigned char*)H + off + bj * HALF) = (u32x2){pk4_fp8(h0[0], h0[1], h0[2], h0[3]), pk4_fp8(h1[0], h1[1], h1[2], h1[3])};
                    else *(u32x4*)(H + off + bj * HALF) = (u32x4){cvt_pk_bf16(h0[0], h0[1]), cvt_pk_bf16(h0[2], h0[3]), cvt_pk_bf16(h1[0], h1[1]), cvt_pk_bf16(h1[2], h1[3])}; }
                ss[ai][m] = fq_reduce(s); }
        rowsq_publish(ss, lds, u.pm, wr, wc, fr, fq, slot, 8, u.pc, true);
    }
};
struct EpiSwiGLUScaled {
    static constexpr bool PERM = true, AFTER_DRAIN = false; static constexpr int NSTORES = 8;
    bf16_t* O; int ldc; const float* slot; float inv_n, eps;
    __device__ __forceinline__ void operator()(const f32x4 (&acc)[2][2][4][2], const Unit& u, int wr, int wc, int fr, int fq) const {
        const int row0 = u.pm * BM + wr * 64 + fr, col0 = u.pc * HALF + wc * 32 + 8 * fq;
#pragma unroll
        for (int ai = 0; ai < 2; ++ai)
#pragma unroll
            for (int m = 0; m < 4; ++m) { const int row = row0 + ai * HALF + m * 16; bf16_t* rowp = O + (size_t)row * ldc + col0;
                const float rs = rsqrtf(slot_sum8(slot + (size_t)row * 8) * inv_n + eps); float o[8];
#pragma unroll
                for (int n = 0; n < 2; ++n)
#pragma unroll
                    for (int j = 0; j < 4; ++j) { const float g = acc[ai][0][m][n][j] * rs, up = acc[ai][1][m][n][j] * rs; o[n * 4 + j] = g * up * __builtin_amdgcn_rcpf(1.f + __expf(-g)); }
                u32x4 w; w.x = cvt_pk_bf16(o[0], o[1]); w.y = cvt_pk_bf16(o[2], o[3]); w.z = cvt_pk_bf16(o[4], o[5]); w.w = cvt_pk_bf16(o[6], o[7]);
                *(u32x4*)rowp = w; }
    }
};
struct EpiSwiGLUScaled8 {
    static constexpr bool PERM = true, AFTER_DRAIN = false; static constexpr int NSTORES = 8;
    unsigned char* O; int ldc; const float* slot; float inv_n, eps;
    __device__ __forceinline__ void operator()(const f32x4 (&acc)[2][2][4][2], const Unit& u, int wr, int wc, int fr, int fq) const {
        const int row0 = u.pm * BM + wr * 64 + fr, col0 = u.pc * HALF + wc * 32 + 8 * fq;
#pragma unroll
        for (int ai = 0; ai < 2; ++ai)
#pragma unroll
            for (int m = 0; m < 4; ++m) { const int row = row0 + ai * HALF + m * 16; unsigned char* rowp = O + (size_t)row * ldc + col0;
                const float rs = rsqrtf(slot_sum8(slot + (size_t)row * 8) * inv_n + eps); float o[8];
#pragma unroll
                for (int n = 0; n < 2; ++n)
#pragma unroll
                    for (int j = 0; j < 4; ++j) { const float g = acc[ai][0][m][n][j] * rs, up = acc[ai][1][m][n][j] * rs; o[n * 4 + j] = g * up * __builtin_amdgcn_rcpf(1.f + __expf(-g)); }
                *(u32x2*)rowp = (u32x2){pk4_fp8(o[0], o[1], o[2], o[3]), pk4_fp8(o[4], o[5], o[6], o[7])}; }
    }
};
struct EpiLatent {
    static constexpr bool PERM = true, AFTER_DRAIN = true; static constexpr int NSTORES = 0;
    bf16_t* O; float* kr; const float* slot_x; float* slot_cq; float* slot_ckv; const float* g_cq; const float* g_ckv; float inv_n, eps;
    __device__ __forceinline__ void fused(const f32x4 (&acc)[2][2][4][2], const Unit& u, int wr, int wc, int fr, int fq, PG8_LAS unsigned char* lds) const {
        const int row0 = u.pm * BM + wr * 64 + fr, ct = wc * 32 + 8 * fq;
        const bool lat = u.pc < 4;
        const float* gain = (u.pc < 2 ? g_cq + u.pc * BM : g_ckv + (u.pc - 2) * BM);
        f32x4 gv[2][2]; float ss[2][4];
#pragma unroll
        for (int bj = 0; bj < 2; ++bj)
#pragma unroll
            for (int n = 0; n < 2; ++n) gv[bj][n] = lat ? *(const f32x4*)(gain + ct + bj * HALF + n * 4) : (f32x4){0.f, 0.f, 0.f, 0.f};
#pragma unroll
        for (int ai = 0; ai < 2; ++ai)
#pragma unroll
            for (int m = 0; m < 4; ++m) { const int row = row0 + ai * HALF + m * 16; const float rs = rsqrtf(slot_sum8(slot_x + (size_t)row * 8) * inv_n + eps); float s = 0.f;
                if (lat) {
#pragma unroll
                    for (int bj = 0; bj < 2; ++bj) { const f32x4 v0 = acc[ai][bj][m][0] * rs, v1 = acc[ai][bj][m][1] * rs;
                        s += ((v0[0] * v0[0] + v0[1] * v0[1]) + (v0[2] * v0[2] + v0[3] * v0[3])) + ((v1[0] * v1[0] + v1[1] * v1[1]) + (v1[2] * v1[2] + v1[3] * v1[3]));
                        const f32x4 h0 = v0 * gv[bj][0], h1 = v1 * gv[bj][1];
                        *(u32x4*)(O + (size_t)row * 1024 + u.pc * BM + ct + bj * HALF) = (u32x4){cvt_pk_bf16(h0[0], h0[1]), cvt_pk_bf16(h0[2], h0[3]), cvt_pk_bf16(h1[0], h1[1]), cvt_pk_bf16(h1[2], h1[3])}; }
                } else {
                    if (ct < 64) { *(f32x4*)(kr + (size_t)row * 64 + ct) = acc[ai][0][m][0] * rs; *(f32x4*)(kr + (size_t)row * 64 + ct + 4) = acc[ai][0][m][1] * rs; }
                }
                ss[ai][m] = fq_reduce(s); }
        rowsq_publish(ss, lds, u.pm, wr, wc, fr, fq, (u.pc < 2 ? slot_cq : slot_ckv), 2, u.pc & 1, lat);
    }
};
static_assert(SEQ == 4096, "EpiBf16Dual splits the row index with a shift");
struct EpiBf16Dual {
    static constexpr bool PERM = true, AFTER_DRAIN = false; static constexpr int NSTORES = 16;
    bf16_t* O; int ldc; const float* slot_cq; const float* slot_ckv; float inv_n, eps; bf16_t* VT; int seq;
    __device__ __forceinline__ void operator()(const f32x4 (&acc)[2][2][4][2], const Unit& u, int wr, int wc, int fr, int fq) const {
        const int row0 = u.pm * BM + wr * 64 + fr, col0 = u.pc * BM + wc * 32 + 8 * fq; const bool kv = (u.pn >= 12); const float* sl = kv ? slot_ckv : slot_cq;
        const bool odd = fr & 1;
#pragma unroll
        for (int ai = 0; ai < 2; ++ai)
#pragma unroll
            for (int m = 0; m < 4; ++m) { const int row = row0 + ai * HALF + m * 16; bf16_t* rowp = O + (size_t)row * ldc + col0; const f32x2 sq = *(const f32x2*)(sl + (size_t)row * 2); const float rs = rsqrtf((sq[0] + sq[1]) * inv_n + eps);
                { const f32x4 v0 = acc[ai][0][m][0] * rs, v1 = acc[ai][0][m][1] * rs;
                  u32x4 w; w.x = cvt_pk_bf16(v0[0], v0[1]); w.y = cvt_pk_bf16(v0[2], v0[3]); w.z = cvt_pk_bf16(v1[0], v1[1]); w.w = cvt_pk_bf16(v1[2], v1[3]);
                  *(u32x4*)rowp = w; }
                const f32x4 v0 = acc[ai][1][m][0] * rs, v1 = acc[ai][1][m][1] * rs;
                if (!kv) { u32x4 w; w.x = cvt_pk_bf16(v0[0], v0[1]); w.y = cvt_pk_bf16(v0[2], v0[3]); w.z = cvt_pk_bf16(v1[0], v1[1]); w.w = cvt_pk_bf16(v1[2], v1[3]);
                    *(u32x4*)(rowp + HALF) = w; }
                else { const int bq = row >> 12, sq_ = row & 4095, hd = u.pn - 12;
                    bf16_t* vt = VT + (((size_t)bq * 16 + hd) * 128 + wc * 32 + 8 * fq) * seq + (sq_ & ~1);
                    const float val[8] = {v0[0], v0[1], v0[2], v0[3], v1[0], v1[1], v1[2], v1[3]};
#pragma unroll
                    for (int i = 0; i < 8; i += 2) { const float send = odd ? val[i] : val[i + 1];
                        const float recv = __builtin_bit_cast(float, __builtin_amdgcn_update_dpp(0, __builtin_bit_cast(int, send), 0xB1, 0xf, 0xf, true));
                        const unsigned pr = odd ? cvt_pk_bf16(recv, val[i + 1]) : cvt_pk_bf16(val[i], recv);
                        *(unsigned*)(vt + (size_t)(i + (odd ? 1 : 0)) * seq) = pr; } } }
    }
};

struct OneUnit { Unit u; bool on;
    __device__ __forceinline__ bool next(int i, Unit& o) const { if (i != 0 || !on) return false; o = u; return true; }
    __device__ __forceinline__ int rowoff(int, int) const { return 0; } };
struct EpiSplitK {
    static constexpr bool PERM = true, AFTER_DRAIN = true; static constexpr int NSTORES = 16;
    bf16_t* O; int ldc; float* part; unsigned* flag; int slice;
    __device__ __forceinline__ void fused(const f32x4 (&acc)[2][2][4][2], const Unit& u, int wr, int wc, int fr, int fq, PG8_LAS unsigned char* lds) const {
        const int tid = threadIdx.x;
        if (slice != 0) {
            f32x4* p = (f32x4*)part + (size_t)(slice - 1) * (32 * 512) + tid;
#pragma unroll
            for (int ai = 0; ai < 2; ++ai)
#pragma unroll
                for (int bj = 0; bj < 2; ++bj)
#pragma unroll
                    for (int m = 0; m < 4; ++m)
#pragma unroll
                        for (int n = 0; n < 2; ++n) p[(((ai * 2 + bj) * 4 + m) * 2 + n) * 512] = acc[ai][bj][m][n];
            asm volatile("s_waitcnt vmcnt(0)" ::: "memory");
            __syncthreads();
            if (tid == 0) { __builtin_amdgcn_fence(__ATOMIC_RELEASE, "agent"); asm volatile("s_waitcnt vmcnt(0)" ::: "memory"); (void)__hip_atomic_fetch_add(flag, 1u, __ATOMIC_RELAXED, __HIP_MEMORY_SCOPE_AGENT); }
        } else {
            if (tid == 0) { unsigned sp = 0; while (__hip_atomic_load(flag, __ATOMIC_RELAXED, __HIP_MEMORY_SCOPE_AGENT) < 3u) { __builtin_amdgcn_s_sleep(1); if (++sp > (1u << 22)) break; }
                __builtin_amdgcn_fence(__ATOMIC_ACQUIRE, "agent"); asm volatile("s_waitcnt vmcnt(0)" ::: "memory"); }
            __syncthreads();
            const f32x4* p = (const f32x4*)part + tid;
            const int row0 = u.pm * BM + wr * 64 + fr, col0 = u.pc * BM + wc * 32 + 8 * fq;
#pragma unroll
            for (int ai = 0; ai < 2; ++ai)
#pragma unroll
                for (int m = 0; m < 4; ++m) { bf16_t* rowp = O + (size_t)(row0 + ai * HALF + m * 16) * ldc + col0;
#pragma unroll
                    for (int bj = 0; bj < 2; ++bj) { const int j0 = ((ai * 2 + bj) * 4 + m) * 2;
                        const f32x4 v0 = ((acc[ai][bj][m][0] + p[j0 * 512]) + p[(32 + j0) * 512]) + p[(64 + j0) * 512], v1 = ((acc[ai][bj][m][1] + p[(j0 + 1) * 512]) + p[(33 + j0) * 512]) + p[(65 + j0) * 512];
                        u32x4 w; w.x = cvt_pk_bf16(v0[0], v0[1]); w.y = cvt_pk_bf16(v0[2], v0[3]); w.z = cvt_pk_bf16(v1[0], v1[1]); w.w = cvt_pk_bf16(v1[2], v1[3]);
                        *(u32x4*)(rowp + bj * HALF) = w; } }
        }
    }
};

template <class Epi, class Sched, bool ALIGN_EPI = true, bool SP2 = true, bool FP8 = false, bool GATHER = false>
__device__ __forceinline__ void gemm_phase(PG8_LAS unsigned char* lds, const Gemm g, const Sched& S, const Epi& E) {
    const int tid = threadIdx.x, wid = __builtin_amdgcn_readfirstlane(tid >> 6), lane = tid & 63, wr = wid >> 2, wc = wid & 3, fr = lane & 15, fq = lane >> 4;
    const int K = g.K, nt = K / BK;
    unsigned voffA[2], voffB[2];
#pragma unroll
    for (int i = 0; i < 2; ++i) { int R, C; stage_rc(tid * 16 + i * 8192, R, C); const int Rb = Epi::PERM ? ((R & ~31) + perm32(R & 31)) : R;
        voffA[i] = (unsigned)(R * g.lda + C) * 2u; voffB[i] = (unsigned)(Rb * g.ldb + C) * 2u; }
    unsigned vAc[2][2] = {{0u, 0u}, {0u, 0u}}; unsigned (&vAn)[2][2] = vAc; int Rg0 = 0, Cg2 = 0;
    if constexpr (GATHER) { static_assert(SP2, "gather: SP2 form only"); int C0; stage_rc(tid * 16, Rg0, C0); Cg2 = 2 * C0; }
#define PG8_GOFF(dst, ui_) do { _Pragma("unroll") for (int h_ = 0; h_ < 2; ++h_) _Pragma("unroll") for (int i_ = 0; i_ < 2; ++i_) dst[h_][i_] = (unsigned)(S.rowoff(ui_, h_ * HALF + 64 * i_ + Rg0) + Cg2); } while (0)
#define PG8_STAGE_A(bufoff, gbase, h, nx) do { if constexpr (GATHER) { unsigned v_[2] = {(nx) ? vAn[h][0] : vAc[h][0], (nx) ? vAn[h][1] : vAc[h][1]}; PG8_STAGE(bufoff, gbase, v_); } \
        else PG8_STAGE(bufoff, (gbase) + (h) * hstepA, voffA); } while (0)
    const size_t kstep = (size_t)(BK * 2);
    const size_t hstepA = (size_t)HALF * g.lda * 2, hstepB = (size_t)HALF * g.ldb * 2;
    const size_t tstepA = 2 * hstepA, tstepB = 2 * hstepB;
    const unsigned ldsw = (unsigned)wid * 1024u;
    const int aoff = lds_byte(wr * 64 + fr, fq * 8), boff = lds_byte(wc * 32 + fr, fq * 8);
#define PG8_SA(b, h) (((b) * 2 + (h)) * HTB)
#define PG8_SB(b, h) ((4 + (b) * 2 + (h)) * HTB)
#define PG8_STAGE(bufoff, gbase, voff) do { _Pragma("unroll") for (int _i = 0; _i < 2; ++_i) \
        __builtin_amdgcn_global_load_lds((const unsigned*)((const char*)(gbase) + (voff)[_i]), (PG8_LAS unsigned*)(lds + (bufoff) + ldsw + _i * 8192), 16, 0, 0); } while (0)
#define PG8_LDA(dst, b, h) do { _Pragma("unroll") for (int m = 0; m < 4; ++m) { \
        if constexpr (FP8) { dst##8[m].lo = *(const PG8_LAS i32x4*)(lds + PG8_SA(b, h) + aoff + m * 2048); dst##8[m].hi = *(const PG8_LAS i32x4*)(lds + PG8_SA(b, h) + aoff + m * 2048 + 1024); } \
        else { _Pragma("unroll") for (int k = 0; k < 2; ++k) dst[m][k] = *(const PG8_LAS bf16x8*)(lds + PG8_SA(b, h) + aoff + m * 2048 + k * 1024); } } } while (0)
#define PG8_LDB(dst, b, h) do { _Pragma("unroll") for (int n = 0; n < 2; ++n) { \
        if constexpr (FP8) { dst##8[n].lo = *(const PG8_LAS i32x4*)(lds + PG8_SB(b, h) + boff + n * 2048); dst##8[n].hi = *(const PG8_LAS i32x4*)(lds + PG8_SB(b, h) + boff + n * 2048 + 1024); } \
        else { _Pragma("unroll") for (int k = 0; k < 2; ++k) dst[n][k] = *(const PG8_LAS bf16x8*)(lds + PG8_SB(b, h) + boff + n * 2048 + k * 1024); } } } while (0)
#define PG8_MMA(ai, bj, At, Bt) do { __builtin_amdgcn_s_setprio(1); \
        if constexpr (FP8) { _Pragma("unroll") for (int m = 0; m < 4; ++m) _Pragma("unroll") for (int n = 0; n < 2; ++n) \
            asm volatile("v_mfma_scale_f32_16x16x128_f8f6f4 %0, %1, %2, %0, %3, %4 op_sel_hi:[0,0,0]" : "+v"(acc[ai][bj][m][n]) : "v"(Bt##8[n]), "v"(At##8[m]), "v"(sclW), "v"(sclX)); } \
        else { _Pragma("unroll") for (int m = 0; m < 4; ++m) _Pragma("unroll") for (int n = 0; n < 2; ++n) _Pragma("unroll") for (int k = 0; k < 2; ++k) \
            acc[ai][bj][m][n] = __builtin_amdgcn_mfma_f32_16x16x32_bf16(Bt[n][k], At[m][k], acc[ai][bj][m][n], 0, 0, 0); } \
          \
        __builtin_amdgcn_s_setprio(0); } while (0)
#define PG8_WAIT_V(n) asm volatile("s_waitcnt vmcnt(" #n ")" ::: "memory")
#define PG8_WAIT_L(n) asm volatile("s_waitcnt lgkmcnt(" #n ")" ::: "memory")
#define PG8_WAIT_V8R(relax_) do { if (relax_) asm volatile("s_waitcnt vmcnt(%0)" :: "i"(8 + Epi::NSTORES) : "memory"); else asm volatile("s_waitcnt vmcnt(8)" ::: "memory"); } while (0)
#define PG8_BAR __builtin_amdgcn_s_barrier()
#define PG8_SCHED __builtin_amdgcn_sched_barrier(0)
    Unit cur, nxt; int ui = 0;
    if (!S.next(0, cur)) return;
    f32x4 acc[2][2][4][2];
#pragma unroll
    for (int a = 0; a < 2; ++a)
#pragma unroll
        for (int b = 0; b < 2; ++b)
#pragma unroll
            for (int m = 0; m < 4; ++m)
#pragma unroll
                for (int n = 0; n < 2; ++n) acc[a][b][m][n] = (f32x4){0.f, 0.f, 0.f, 0.f};
    const int sclW = 0x79797979, sclX = 0x7f7f7f7f;
    bf16x8 At[4][2], B0[2][2], B1[2][2]; i32x8 At8[4], B08[2], B18[2];
    const char* cA = (const char*)g.A + (GATHER ? (size_t)0 : (size_t)cur.pm * tstepA) + cur.aoff; const char* cB = (const char*)g.Bt + (size_t)cur.pn * tstepB;
    if constexpr (GATHER) PG8_GOFF(vAc, 0);
    if constexpr (SP2) {
        PG8_STAGE(PG8_SB(0, 0), cB, voffB); PG8_STAGE(PG8_SB(0, 1), cB + hstepB, voffB); PG8_STAGE_A(PG8_SA(0, 0), cA, 0, false); PG8_STAGE_A(PG8_SA(0, 1), cA, 1, false);
        if (wr == 1) PG8_BAR;
        PG8_WAIT_V(2); PG8_BAR;
        PG8_STAGE(PG8_SB(1, 0), cB + kstep, voffB); PG8_STAGE_A(PG8_SA(1, 0), cA + kstep, 0, false); PG8_STAGE(PG8_SB(1, 1), cB + hstepB + kstep, voffB);
        PG8_WAIT_V(6); PG8_BAR;
    } else {
        PG8_STAGE(PG8_SB(0, 0), cB, voffB); PG8_STAGE(PG8_SA(0, 0), cA, voffA); PG8_STAGE(PG8_SB(0, 1), cB + hstepB, voffB); PG8_STAGE(PG8_SA(0, 1), cA + hstepA, voffA);
        if (wr == 1) PG8_BAR;
        PG8_WAIT_V(4); PG8_BAR;
        PG8_STAGE(PG8_SB(1, 0), cB + kstep, voffB); PG8_STAGE(PG8_SA(1, 0), cA + kstep, voffA); PG8_STAGE(PG8_SB(1, 1), cB + hstepB + kstep, voffB);
        PG8_WAIT_V(6); PG8_BAR;
    }
    for (;;) {
        const bool has_next = S.next(ui + 1, nxt);
        const char* nA = has_next ? (const char*)g.A + (GATHER ? (size_t)0 : (size_t)nxt.pm * tstepA) + nxt.aoff : cA;
        const char* nB = has_next ? (const char*)g.Bt + (size_t)nxt.pn * tstepB : cB;
        for (int t = 0; t < nt; t += 2) {
            const bool last = (t == nt - 2);
            const char* a1 = cA + (size_t)(t + 1) * kstep;
            const char* a2 = last ? nA : cA + (size_t)(t + 2) * kstep; const char* b2 = last ? nB : cB + (size_t)(t + 2) * kstep;
            const char* a3 = a2 + kstep; const char* b3 = b2 + kstep;
            if constexpr (SP2) {
            unsigned vAn[2][2] = {{vAc[0][0], vAc[0][1]}, {vAc[1][0], vAc[1][1]}};
            if constexpr (GATHER) { if (last && has_next) PG8_GOFF(vAn, ui + 1); }
            constexpr bool relax = false;
            PG8_LDB(B0, 0, 0); PG8_LDB(B1, 0, 1); PG8_SCHED; PG8_LDA(At, 0, 0); PG8_STAGE_A(PG8_SA(1, 1), a1, 1, false);
            PG8_WAIT_V8R(relax); PG8_WAIT_L(0); PG8_BAR; PG8_MMA(0, 0, At, B0); PG8_MMA(0, 1, At, B1); PG8_BAR; PG8_SCHED;
            PG8_LDA(At, 0, 1); PG8_STAGE(PG8_SB(0, 0), b2, voffB); PG8_STAGE(PG8_SB(0, 1), b2 + hstepB, voffB); PG8_STAGE_A(PG8_SA(0, 0), a2, 0, last);
            PG8_WAIT_V8R(relax); PG8_WAIT_L(0); PG8_BAR; PG8_MMA(1, 0, At, B0); PG8_MMA(1, 1, At, B1); PG8_BAR; PG8_SCHED;
            PG8_LDB(B0, 1, 0); PG8_LDB(B1, 1, 1); PG8_SCHED; PG8_LDA(At, 1, 0); PG8_STAGE_A(PG8_SA(0, 1), a2, 1, last);
            PG8_WAIT_V(8); PG8_WAIT_L(0); PG8_BAR; PG8_MMA(0, 0, At, B0); PG8_MMA(0, 1, At, B1); PG8_BAR; PG8_SCHED;
            PG8_LDA(At, 1, 1); PG8_STAGE(PG8_SB(1, 0), b3, voffB); PG8_STAGE(PG8_SB(1, 1), b3 + hstepB, voffB); PG8_STAGE_A(PG8_SA(1, 0), a3, 0, last);
            PG8_WAIT_V(8); PG8_WAIT_L(0); PG8_BAR; PG8_MMA(1, 0, At, B0); PG8_MMA(1, 1, At, B1); PG8_BAR; PG8_SCHED;
            } else {
            PG8_LDB(B0, 0, 0); PG8_SCHED; PG8_LDA(At, 0, 0); PG8_STAGE(PG8_SA(1, 1), a1 + hstepA, voffA);
            PG8_WAIT_L(8); PG8_BAR; PG8_WAIT_L(0); PG8_MMA(0, 0, At, B0); PG8_BAR; PG8_SCHED;
            PG8_LDB(B1, 0, 1); PG8_STAGE(PG8_SB(0, 0), b2, voffB);
            PG8_BAR; PG8_WAIT_L(0); PG8_MMA(0, 1, At, B1); PG8_BAR;
            PG8_LDA(At, 0, 1); PG8_STAGE(PG8_SA(0, 0), a2, voffA);
            PG8_BAR; PG8_WAIT_L(0); PG8_MMA(1, 0, At, B0); PG8_BAR; PG8_SCHED;
            PG8_STAGE(PG8_SB(0, 1), b2 + hstepB, voffB);
            PG8_WAIT_V(6); PG8_BAR; PG8_MMA(1, 1, At, B1); PG8_BAR;
            PG8_LDB(B0, 1, 0); PG8_SCHED; PG8_LDA(At, 1, 0); PG8_STAGE(PG8_SA(0, 1), a2 + hstepA, voffA);
            PG8_WAIT_L(8); PG8_BAR; PG8_WAIT_L(0); PG8_MMA(0, 0, At, B0); PG8_BAR; PG8_SCHED;
            PG8_LDB(B1, 1, 1); PG8_STAGE(PG8_SB(1, 0), b3, voffB);
            PG8_BAR; PG8_WAIT_L(0); PG8_MMA(0, 1, At, B1); PG8_BAR;
            PG8_LDA(At, 1, 1); PG8_STAGE(PG8_SA(1, 0), a3, voffA);
            PG8_BAR; PG8_WAIT_L(0); PG8_MMA(1, 0, At, B0); PG8_BAR; PG8_SCHED;
            PG8_STAGE(PG8_SB(1, 1), b3 + hstepB, voffB);
            PG8_WAIT_V(6); PG8_BAR; PG8_MMA(1, 1, At, B1); PG8_BAR;
            }
        }
        if constexpr (ALIGN_EPI) { if (wr == 0) PG8_BAR; }
        asm volatile("s_nop 15\n\ts_nop 15" ::: "memory");
        if constexpr (!Epi::AFTER_DRAIN) E(acc, cur, wr, wc, fr, fq);
        if (!has_next) break;
#pragma unroll
        for (int a = 0; a < 2; ++a)
#pragma unroll
            for (int b = 0; b < 2; ++b)
#pragma unroll
                for (int m = 0; m < 4; ++m)
#pragma unroll
                    for (int n = 0; n < 2; ++n) acc[a][b][m][n] = (f32x4){0.f, 0.f, 0.f, 0.f};
        cur = nxt; cA = nA; cB = nB; ++ui;
        if constexpr (GATHER) PG8_GOFF(vAc, ui);
        if constexpr (ALIGN_EPI) { if (wr == 1) PG8_BAR; }
    }
    PG8_WAIT_V(0);
    if constexpr (!ALIGN_EPI) { if (wr == 0) PG8_BAR; }
    PG8_BAR;
    if constexpr (Epi::AFTER_DRAIN) E.fused(acc, cur, wr, wc, fr, fq, lds);
#undef PG8_SA
#undef PG8_SB
#undef PG8_STAGE
#undef PG8_LDA
#undef PG8_LDB
#undef PG8_MMA
#undef PG8_WAIT_V
#undef PG8_WAIT_L
#undef PG8_GOFF
#undef PG8_STAGE_A
#undef PG8_WAIT_V8R
#undef PG8_BAR
#undef PG8_SCHED
}
}
#define XB_TMO      128
#define XB_XCNT(j)  (256  + 64 * (j))
#define XB_XSUB(j)  (1280 + 64 * (j))
#define XB_XGEN(j)  (2304 + 64 * (j))
#define XB_TOP      3328
#define XB_TOPGEN   3392
#define XCD_BAR_WORDS 3456
#define XB_SPIN_CAP (1u << 18)

__device__ __forceinline__ unsigned xb_ld(unsigned* p)              { return __hip_atomic_load(p, __ATOMIC_RELAXED, __HIP_MEMORY_SCOPE_AGENT); }
__device__ __forceinline__ unsigned xb_add(unsigned* p, unsigned v) { return __hip_atomic_fetch_add(p, v, __ATOMIC_RELAXED, __HIP_MEMORY_SCOPE_AGENT); }
__device__ __forceinline__ unsigned xb_xcc_id() { return (unsigned)__builtin_amdgcn_s_getreg((3 << 11) | 20) & 0xFu; }
#define XB_SPIN(cond, bar) do { unsigned _sp = 0; while (cond) { __builtin_amdgcn_s_sleep(1); \
    if ((++_sp & 255u) == 0u) { if (xb_ld(&(bar)[XB_TMO])) break; if (_sp > XB_SPIN_CAP) { atomicAdd(&(bar)[XB_TMO], 1u); break; } } } } while (0)

struct XcdBarrier { unsigned* bar; unsigned x; volatile LAS unsigned* st; };

__device__ __forceinline__ XcdBarrier xcd_barrier_post(unsigned* bar, volatile LAS unsigned* st) {
    XcdBarrier b; b.bar = bar; b.x = xb_xcc_id(); b.st = st;
    if (threadIdx.x == 0) (void)xb_add(&bar[XB_XCNT(b.x)], 1u);
    return b;
}
__device__ __forceinline__ void xcd_barrier_complete(unsigned* bar, unsigned x, unsigned& nloc, unsigned& nx) {
    const unsigned G = gridDim.x * gridDim.y * gridDim.z;
    unsigned sum, cnt, mine, sp = 0u;
    for (;;) {
        sum = 0u; cnt = 0u; mine = 0u;
#pragma unroll
        for (unsigned j = 0; j < 16; ++j) { const unsigned c = xb_ld(&bar[XB_XCNT(j)]); sum += c; cnt += (c > 0u) ? 1u : 0u; mine = (j == x) ? c : mine; }
        if (sum == G) break;
        __builtin_amdgcn_s_sleep(1);
        if ((++sp & 255u) == 0u) { if (xb_ld(&bar[XB_TMO])) break; if (sp > XB_SPIN_CAP) { atomicAdd(&bar[XB_TMO], 1u); break; } }
    }
    nloc = mine > 0u ? mine : 1u; nx = cnt > 0u ? cnt : 1u;
}
__device__ __forceinline__ void xcd_barrier(const XcdBarrier& b) {
    asm volatile("s_waitcnt vmcnt(0)" ::: "memory");
    __syncthreads();
    if (threadIdx.x == 0) {
        unsigned* bar = b.bar;
        __builtin_amdgcn_s_waitcnt(0);
        unsigned nloc = b.st[0], nx = b.st[1];
        if (nloc == 0u) { xcd_barrier_complete(bar, b.x, nloc, nx); b.st[0] = nloc; b.st[1] = nx; }
        const unsigned old = xb_add(&bar[XB_XSUB(b.x)], 1u);
        const unsigned gen = old / nloc;
        if (old + 1u == (gen + 1u) * nloc) {
            __builtin_amdgcn_fence(__ATOMIC_RELEASE, "agent");
            asm volatile("s_waitcnt vmcnt(0)" ::: "memory");
            (void)xb_add(&bar[XB_TOP], 1u);
        }
        { const unsigned target = (gen + 1u) * nx; XB_SPIN(xb_ld(&bar[XB_TOP]) < target, bar); }
        __builtin_amdgcn_fence(__ATOMIC_ACQUIRE, "agent");
        asm volatile("s_waitcnt vmcnt(0)" ::: "memory");
    }
    __syncthreads();
}

struct Ctx {
    LAS unsigned char* lds;
    int tid, lane, wave, wg, nwg;
    const float *x; const int* pos;
    const float *g_mix, *g_ffn, *w_in, *conv_w, *b_gates, *g_mo, *g_ro, *w_mix_out, *ffn_gate, *ffn_up, *ffn_down;
    const float *w_dqkv, *g_cq, *g_ckv, *w_uq, *w_ukv, *g_qn, *g_qr, *g_kn, *g_kr, *w_o, *w_router, *we_gate, *we_up, *we_down;
    float* out; unsigned char* ws;
};

template <bool Q8 = false>
__device__ __forceinline__ void transpose_item(const float* src, int lds_, bf16_t* dst, int ldd, LAS float* scr, int lane) {
    f32x4 v[8]; const int l8 = lane & 7, kr = lane >> 3;
#pragma unroll
    for (int i = 0; i < 8; ++i) v[i] = *(const f32x4*)(src + (size_t)(kr + 8 * i) * lds_ + 4 * l8);
#pragma unroll
    for (int i = 0; i < 8; ++i) { LAS float* d = scr + (kr + 8 * i) * 33 + 4 * l8; d[0] = v[i][0]; d[1] = v[i][1]; d[2] = v[i][2]; d[3] = v[i][3]; }
    LDS_WAIT(); asm volatile("" ::: "memory");
    const int c = lane & 7;
#pragma unroll
    for (int j = 0; j < 4; ++j) { const int n = (lane >> 3) + 8 * j; const LAS float* s = scr + (8 * c) * 33 + n;
        u32x4 o; o.x = cvt_pk_bf16(s[0 * 33], s[1 * 33]); o.y = cvt_pk_bf16(s[2 * 33], s[3 * 33]); o.z = cvt_pk_bf16(s[4 * 33], s[5 * 33]); o.w = cvt_pk_bf16(s[6 * 33], s[7 * 33]);
        *(u32x4*)(dst + (size_t)n * ldd + 8 * c) = o; }
    LDS_WAIT(); asm volatile("" ::: "memory");
}
template <bool Q8 = false>
__device__ __forceinline__ void tr_plain(const float* W, int K, int N, bf16_t* WT, int r, LAS float* scr, int lane) {
    const int nblk = N / 32, kb = r / nblk, nb = r % nblk;
    transpose_item<Q8>(W + (size_t)(64 * kb) * N + 32 * nb, N, WT + (size_t)(32 * nb) * K + 64 * kb, K, scr, lane);
}
template <bool Q8 = false>
__device__ __forceinline__ void tr_gu(const float* Wg, const float* Wu, bf16_t* WT, int r, LAS float* scr, int lane) {
    constexpr int nblk = (2 * DFF) / 32; const int kb = r / nblk, nb = r % nblk, n0 = 32 * nb, j = n0 >> 8, within = n0 & 255;
    const float* src = (within < 128 ? Wg : Wu) + (size_t)(64 * kb) * DFF + 128 * j + (within & 127);
    transpose_item<Q8>(src, DFF, WT + (size_t)n0 * D + 64 * kb, D, scr, lane);
}
__device__ __forceinline__ void transpose_item8(const float* src, int lds_, unsigned char* dst, int ldd, LAS float* scr, int lane) {
    f32x4 v[2][8]; const int l8 = lane & 7, kr = lane >> 3;
#pragma unroll
    for (int hf = 0; hf < 2; ++hf)
#pragma unroll
        for (int i = 0; i < 8; ++i) v[hf][i] = *(const f32x4*)(src + (size_t)(64 * hf + kr + 8 * i) * lds_ + 4 * l8);
#pragma unroll
    for (int hf = 0; hf < 2; ++hf) {
#pragma unroll
        for (int i = 0; i < 8; ++i) { LAS float* d = scr + (kr + 8 * i) * 33 + 4 * l8; d[0] = v[hf][i][0]; d[1] = v[hf][i][1]; d[2] = v[hf][i][2]; d[3] = v[hf][i][3]; }
        LDS_WAIT(); asm volatile("" ::: "memory");
        const int n = lane >> 1, hh = lane & 1; const LAS float* sp = scr + (32 * hh) * 33 + n; unsigned w[8];
#pragma unroll
        for (int q = 0; q < 8; ++q) w[q] = pk4_fp8(sp[(4 * q) * 33] * W8_SCALE, sp[(4 * q + 1) * 33] * W8_SCALE, sp[(4 * q + 2) * 33] * W8_SCALE, sp[(4 * q + 3) * 33] * W8_SCALE);
        unsigned char* d = dst + (size_t)n * ldd + 64 * hf + 32 * hh;
        *(u32x4*)d = (u32x4){w[0], w[1], w[2], w[3]}; *(u32x4*)(d + 16) = (u32x4){w[4], w[5], w[6], w[7]};
        LDS_WAIT(); asm volatile("" ::: "memory");
    }
}
__device__ __forceinline__ void zero_item(bf16_t* dst, int ldd, int lane) {
#pragma unroll
    for (int j = 0; j < 4; ++j) { const int n = (lane >> 3) + 8 * j; *(u32x4*)(dst + (size_t)n * ldd + 8 * (lane & 7)) = (u32x4){0u, 0u, 0u, 0u}; }
}

constexpr int I_WIN = 32 * 256, I_WOUT = 32 * 64, I_WGU = 32 * 352, I_WD = 88 * 64, I_WDQKV = 32 * 40, I_WUQ = 8 * 96, I_WUKV = 8 * 128, I_WO = 32 * 64;
constexpr int I_DENSE = I_WIN + I_WOUT + I_WGU + I_WD + I_WDQKV + I_WUQ + I_WUKV + I_WO;
constexpr int I_EGU8 = 16 * 352, I_ED8 = 44 * 64;
constexpr int I_EXP = I_EGU8 + I_ED8;
constexpr int I_TOTAL = I_DENSE + NEXP * I_EXP;

__device__ __forceinline__ void weight_item(const Ctx& C, int it, LAS float* scr) {
    int r = it; unsigned char* ws = C.ws; const int lane = C.lane;
    if (r < I_WIN) { constexpr int nblk = 256; const int kb = r / nblk, nb = r % nblk, n0 = 32 * nb, sc = n0 + (n0 >= 4096 ? 8 : 0);
        transpose_item(C.w_in + (size_t)(64 * kb) * IN_COLS + sc, IN_COLS, (bf16_t*)(ws + WS_WIN) + (size_t)n0 * D + 64 * kb, D, scr, lane); return; } r -= I_WIN;
    if (r < I_WOUT) { tr_plain(C.w_mix_out, D, D, (bf16_t*)(ws + WS_WOUT), r, scr, lane); return; } r -= I_WOUT;
    if (r < I_WGU) { tr_gu<(FP8_EMU >= 2)>(C.ffn_gate, C.ffn_up, (bf16_t*)(ws + WS_WGU), r, scr, lane); return; } r -= I_WGU;
    if (r < I_WD) { tr_plain<(FP8_EMU >= 2)>(C.ffn_down, DFF, D, (bf16_t*)(ws + WS_WD), r, scr, lane); return; } r -= I_WD;
    if (r < I_WDQKV) { constexpr int nblk = 40; const int kb = r / nblk, nb = r % nblk; bf16_t* dst = (bf16_t*)(ws + WS_WDQKV) + (size_t)(32 * nb) * D + 64 * kb;
        if (nb < 34) transpose_item(C.w_dqkv + (size_t)(64 * kb) * 1088 + 32 * nb, 1088, dst, D, scr, lane); else zero_item(dst, D, lane); return; } r -= I_WDQKV;
    if (r < I_WUQ) { tr_plain(C.w_uq, 512, 3072, (bf16_t*)(ws + WS_WUQKV), r, scr, lane); return; } r -= I_WUQ;
    if (r < I_WUKV) { tr_plain(C.w_ukv, 512, 4096, (bf16_t*)(ws + WS_WUQKV) + (size_t)3072 * 512, r, scr, lane); return; } r -= I_WUKV;
    if (r < I_WO) { tr_plain(C.w_o, D, D, (bf16_t*)(ws + WS_WO), r, scr, lane); return; } r -= I_WO;
    const int e = r / I_EXP; r -= e * I_EXP;
    if (r < I_EGU8) { constexpr int nblk = 352; const int kb = r / nblk, nb = r % nblk, n0 = 32 * nb, j = n0 >> 8, within = n0 & 255;
        const float* src = (within < 128 ? C.we_gate : C.we_up) + (size_t)e * D * DFF + (size_t)(128 * kb) * DFF + 128 * j + (within & 127);
        transpose_item8(src, DFF, ws + WS_WEGU + ((size_t)e * 2 * DFF + n0) * D + 128 * kb, D, scr, lane); return; } r -= I_EGU8;
    { constexpr int nblk = 64; const int kb = r / nblk, nb = r % nblk;
        transpose_item8(C.we_down + (size_t)e * DFF * D + (size_t)(128 * kb) * D + 32 * nb, D, ws + WS_WED + ((size_t)e * D + 32 * nb) * DFF + 128 * kb, DFF, scr, lane); }
}

constexpr int EXP_ITEMS_GU = 16 * 44, EXP_ITEMS_D = 44 * 8, EXP_ITEMS = EXP_ITEMS_GU + EXP_ITEMS_D;
struct ExpItem { const float* p; unsigned char* dst; int ld, ldd; };
constexpr int EXP_N_GU = NEXP * EXP_ITEMS_GU, EXP_N_ALL = NEXP * EXP_ITEMS, EXP_N_FFN = EXP_ITEMS_GU, EXP_N_TOTAL = EXP_N_ALL + EXP_N_FFN, EXP_N_FD = EXP_ITEMS_D, EXP_N_TOTAL2 = EXP_N_TOTAL + EXP_N_FD;
__device__ __forceinline__ ExpItem exp_item(const Ctx& C, int it) {
    ExpItem I; const int w = C.wave, l = C.lane;
    if (it < EXP_N_GU) { const int e = it / EXP_ITEMS_GU, r = it - e * EXP_ITEMS_GU; const int kb = r / 44, j = r - kb * 44, within = 4 * l;
        I.p = (within < 128 ? C.we_gate : C.we_up) + (size_t)e * D * DFF + (size_t)(128 * kb + 16 * w) * DFF + 128 * j + (within & 127); I.ld = DFF;
        I.dst = C.ws + WS_WEGU + ((size_t)e * 2 * DFF + 256 * j) * D + 128 * kb; I.ldd = D; }
    else if (it >= EXP_N_TOTAL) { const int r = it - EXP_N_TOTAL; const int kb = r >> 3, nb = r & 7;
        I.p = C.ffn_down + (size_t)(128 * kb + 16 * w) * D + 256 * nb + 4 * l; I.ld = D;
        I.dst = C.ws + WS_WD + (size_t)(256 * nb) * DFF + 128 * kb; I.ldd = DFF; }
    else if (it >= EXP_N_ALL) { const int r = it - EXP_N_ALL; const int kb = r / 44, j = r - kb * 44, within = 4 * l;
        I.p = (within < 128 ? C.ffn_gate : C.ffn_up) + (size_t)(128 * kb + 16 * w) * DFF + 128 * j + (within & 127); I.ld = DFF;
        I.dst = C.ws + WS_WGU + (size_t)(256 * j) * D + 128 * kb; I.ldd = D; }
    else { const int q = it - EXP_N_GU, e = q / EXP_ITEMS_D, r = q - e * EXP_ITEMS_D; const int kb = r >> 3, nb = r & 7;
        I.p = C.we_down + (size_t)e * DFF * D + (size_t)(128 * kb + 16 * w) * D + 256 * nb + 4 * l; I.ld = D;
        I.dst = C.ws + WS_WED + ((size_t)e * D + 256 * nb) * DFF + 128 * kb; I.ldd = DFF; }
    return I;
}
#define EXP_LOAD(V, I) do { _Pragma("unroll") for (int i_ = 0; i_ < 16; ++i_) V[i_] = __builtin_nontemporal_load((const f32x4*)((I).p + (size_t)i_ * (I).ld)); } while (0)
#define EXP_PROC(V, I, BUF) do { LAS unsigned* buf_ = (LAS unsigned*)(C.lds + (BUF) * 32768); const int w_ = C.wave, l_ = C.lane; \
        _Pragma("unroll") for (int i_ = 0; i_ < 16; ++i_) buf_[(16 * w_ + i_) * 64 + (l_ ^ (w_ << 3))] = pk4_fp8(V[i_][0] * W8_SCALE, V[i_][1] * W8_SCALE, V[i_][2] * W8_SCALE, V[i_][3] * W8_SCALE); \
        __syncthreads(); \
        const int kq_ = C.tid & 7, g_ = C.tid >> 3; unsigned d_[16]; \
        _Pragma("unroll") for (int j_ = 0; j_ < 16; ++j_) d_[j_] = buf_[(16 * kq_ + j_) * 64 + (g_ ^ (kq_ << 3))]; \
        _Pragma("unroll") for (int i_ = 0; i_ < 4; ++i_) { u32x4 o_; \
            _Pragma("unroll") for (int b_ = 0; b_ < 4; ++b_) o_[b_] = ((d_[4 * b_] >> (8 * i_)) & 0xffu) | (((d_[4 * b_ + 1] >> (8 * i_)) & 0xffu) << 8) | (((d_[4 * b_ + 2] >> (8 * i_)) & 0xffu) << 16) | (((d_[4 * b_ + 3] >> (8 * i_)) & 0xffu) << 24); \
            __builtin_nontemporal_store(o_, (u32x4*)((I).dst + (size_t)(4 * g_ + i_) * (I).ldd + 16 * kq_)); } } while (0)
#ifndef EXP_N7
#define EXP_N7 6
#endif
#ifndef EXP_N9
#define EXP_N9 8
#endif
#ifndef EXP_N10
#define EXP_N10 2
#endif
constexpr int EXP_P1_END = 2560;
constexpr int EXP_TAIL7 = 128 * EXP_N7, EXP_TAIL9 = 96 * EXP_N9, EXP_TAIL10 = 128 * EXP_N10, EXP_TAIL_END = EXP_TAIL7 + EXP_TAIL9 + EXP_TAIL10;
static_assert(EXP_TAIL_END <= EXP_N_GU, "tail items are gate/up items");
__device__ __forceinline__ void expert_weights_range(const Ctx& C, int lo, int hi, int rank, int nranks) {
    f32x4 va[16], vb[16]; ExpItem Ia, Ib;
    int it = lo + rank; asm volatile("" : "+s"(it));
    if (it < hi) { Ia = exp_item(C, it); EXP_LOAD(va, Ia); }
    while (it < hi) {
        const int itb = it + nranks;
        if (itb < hi) { Ib = exp_item(C, itb); EXP_LOAD(vb, Ib); }
        EXP_PROC(va, Ia, 0);
        if (itb >= hi) break;
        const int ita = itb + nranks;
        if (ita < hi) { Ia = exp_item(C, ita); EXP_LOAD(va, Ia); }
        EXP_PROC(vb, Ib, 1);
        it = ita;
    }
    __syncthreads();
}
#undef EXP_LOAD
#undef EXP_PROC

struct DenItem { const float* p; bf16_t* dst; int ld, ldd; int valid; int q8; };
constexpr int DI_WIN = 32 * 32, DI_WOUT = 32 * 8, DI_GU = 32 * 44, DI_WD = 0  , DI_DQKV = 32 * 5, DI_UQ = 8 * 12, DI_UKV = 8 * 16, DI_WO = 32 * 8;
constexpr int DI_TOTAL = DI_WIN + DI_WOUT + DI_WD + DI_DQKV + DI_UQ + DI_UKV + DI_WO;
__device__ __forceinline__ DenItem den_item(const Ctx& C, int it) {
    DenItem I; I.valid = 1; I.q8 = 0; int r = it; const int w = C.wave, l = C.lane; unsigned char* ws = C.ws;
    if (r < DI_WIN) { const int kb = r >> 5, nb = r & 31, n0 = 256 * nb; I.ld = IN_COLS; I.p = C.w_in + (size_t)(64 * kb + 8 * w) * IN_COLS + n0 + (n0 >= 4096 ? 8 : 0) + 4 * l; I.dst = (bf16_t*)(ws + WS_WIN) + (size_t)n0 * D + 64 * kb; I.ldd = D; return I; } r -= DI_WIN;
    if (r < DI_WOUT) { const int kb = r >> 3, nb = r & 7; I.ld = D; I.p = C.w_mix_out + (size_t)(64 * kb + 8 * w) * D + 256 * nb + 4 * l; I.dst = (bf16_t*)(ws + WS_WOUT) + (size_t)(256 * nb) * D + 64 * kb; I.ldd = D; return I; } r -= DI_WOUT;
    if (r < DI_WD) { const int kb = r >> 3, nb = r & 7; I.ld = D; I.p = C.ffn_down + (size_t)(64 * kb + 8 * w) * D + 256 * nb + 4 * l; I.dst = (bf16_t*)(ws + WS_WD) + (size_t)(256 * nb) * DFF + 64 * kb; I.ldd = DFF; return I; } r -= DI_WD;
    if (r < DI_DQKV) { const int kb = r / 5, nb = r - kb * 5; I.ld = 1088; I.valid = (256 * nb + 4 * l) < 1088; I.p = C.w_dqkv + (size_t)(64 * kb + 8 * w) * 1088 + (I.valid ? 256 * nb + 4 * l : 0); I.dst = (bf16_t*)(ws + WS_WDQKV) + (size_t)(256 * nb) * D + 64 * kb; I.ldd = D; return I; } r -= DI_DQKV;
    if (r < DI_UQ) { const int kb = r / 12, nb = r - kb * 12; I.ld = 3072; I.p = C.w_uq + (size_t)(64 * kb + 8 * w) * 3072 + 256 * nb + 4 * l; I.dst = (bf16_t*)(ws + WS_WUQKV) + (size_t)(256 * nb) * 512 + 64 * kb; I.ldd = 512; return I; } r -= DI_UQ;
    if (r < DI_UKV) { const int kb = r >> 4, nb = r & 15; I.ld = 4096; I.p = C.w_ukv + (size_t)(64 * kb + 8 * w) * 4096 + 256 * nb + 4 * l; I.dst = (bf16_t*)(ws + WS_WUQKV) + (size_t)(3072 + 256 * nb) * 512 + 64 * kb; I.ldd = 512; return I; } r -= DI_UKV;
    { const int kb = r >> 3, nb = r & 7; I.ld = D; I.p = C.w_o + (size_t)(64 * kb + 8 * w) * D + 256 * nb + 4 * l; I.dst = (bf16_t*)(ws + WS_WO) + (size_t)(256 * nb) * D + 64 * kb; I.ldd = D; return I; }
}
#define DEN_LOAD(V, I) do { _Pragma("unroll") for (int i_ = 0; i_ < 8; ++i_) V[i_] = (I).valid ? __builtin_nontemporal_load((const f32x4*)((I).p + (size_t)i_ * (I).ld)) : (f32x4){0.f, 0.f, 0.f, 0.f}; } while (0)
#define DEN_PROC(V, I, BUF) do { LAS unsigned* buf_ = (LAS unsigned*)(C.lds + (BUF) * 32768); const int w_ = C.wave, l_ = C.lane; \
        _Pragma("unroll") for (int i_ = 0; i_ < 8; ++i_) { const f32x4 x_ = V[i_]; \
            *(LAS u32x2*)(buf_ + (8 * w_ + i_) * 128 + ((2 * l_) ^ (8 * w_))) = (u32x2){cvt_pk_bf16(x_[0], x_[1]), cvt_pk_bf16(x_[2], x_[3])}; } \
        __syncthreads(); \
        const int c_ = C.tid & 7, g0_ = C.tid >> 3; \
        _Pragma("unroll") for (int ps_ = 0; ps_ < 2; ++ps_) { const int g_ = g0_ + 64 * ps_; unsigned d_[8]; \
            _Pragma("unroll") for (int j_ = 0; j_ < 8; ++j_) d_[j_] = buf_[(8 * c_ + j_) * 128 + (g_ ^ (8 * c_))]; \
            u32x4 o0_, o1_; \
            _Pragma("unroll") for (int j_ = 0; j_ < 4; ++j_) { o0_[j_] = (d_[2 * j_] & 0xffffu) | (d_[2 * j_ + 1] << 16); o1_[j_] = (d_[2 * j_] >> 16) | (d_[2 * j_ + 1] & 0xffff0000u); } \
            __builtin_nontemporal_store(o0_, (u32x4*)((I).dst + (size_t)(2 * g_) * (I).ldd + 8 * c_)); __builtin_nontemporal_store(o1_, (u32x4*)((I).dst + (size_t)(2 * g_ + 1) * (I).ldd + 8 * c_)); } } while (0)
__device__ __forceinline__ void dense_weights_to_bf16(const Ctx& C, int lo, int N) {
    f32x4 va[8], vb[8]; DenItem Ia, Ib;
    int it = lo + C.wg; asm volatile("" : "+s"(it));
    if (it < N) { Ia = den_item(C, it); DEN_LOAD(va, Ia); }
    while (it < N) {
        const int itb = it + C.nwg;
        if (itb < N) { Ib = den_item(C, itb); DEN_LOAD(vb, Ib); }
        DEN_PROC(va, Ia, 0);
        if (itb >= N) break;
        const int ita = itb + C.nwg;
        if (ita < N) { Ia = den_item(C, ita); DEN_LOAD(va, Ia); }
        DEN_PROC(vb, Ib, 1);
        it = ita;
    }
    __syncthreads();
}
#undef DEN_LOAD
#undef DEN_PROC

__device__ __forceinline__ f32x2 rope_cs(float a) {
    const float k = rintf(a * 0.15915494309189535f);
    float r = fmaf(-k, 6.2831854820251465f, a); r = fmaf(-k, -1.7484555e-7f, r);
    const float tr = r * 0.15915494309189535f;
    return (f32x2){__builtin_amdgcn_cosf(tr), __builtin_amdgcn_sinf(tr)};
}
__device__ __forceinline__ void phase_prologue(const Ctx& C) {
    LAS float* scr = (LAS float*)(C.lds + C.wave * 16384);
    const int gw = C.wg * NWAVES + C.wave, NGW = C.nwg * NWAVES;
    dense_weights_to_bf16(C, 0, DI_WIN);
    const int gt = C.wg * NTHR + C.tid, NGT = C.nwg * NTHR;
    f32x2* rr = (f32x2*)(C.ws + WS_ROPER); f32x2* rm = (f32x2*)(C.ws + WS_ROPEM);
    for (int i = gt; i < T * 128; i += NGT) { const int t = i >> 7, j = i & 127; const float inv = exp2f(-(float)j * (13.287712379549449f / 128.f)); const float a = (float)C.pos[t] * inv; rr[i] = rope_cs(a); }
    for (int i = gt; i < T * 32; i += NGT) { const int t = i >> 5, j = i & 31; const float inv = exp2f(-(float)j * (13.287712379549449f / 32.f)); const float a = (float)C.pos[t] * inv; rm[i] = rope_cs(a); }
}

template <int MODE, bool Q8 = false>
__device__ __forceinline__ void phase_norm(const Ctx& C, const float* xin, const float* gain, bf16_t* hout, const float* w8, int w8ld) {
    LAS float* wT = (LAS float*)C.lds;
    LAS int* lcnt = (LAS int*)(C.lds + 65536);
    if (MODE != 0) {
        for (int k = C.tid; k < D; k += NTHR) { const f32x4 a = *(const f32x4*)(w8 + (size_t)k * w8ld), b = *(const f32x4*)(w8 + (size_t)k * w8ld + 4);
            wT[0 * D + k] = a[0]; wT[1 * D + k] = a[1]; wT[2 * D + k] = a[2]; wT[3 * D + k] = a[3]; wT[4 * D + k] = b[0]; wT[5 * D + k] = b[1]; wT[6 * D + k] = b[2]; wT[7 * D + k] = b[3]; }
        if (MODE == 2 && C.tid < 8) lcnt[C.tid] = 0;
        __syncthreads();
    }
    const int rows_per_wg = T / C.nwg;
    const int lane = C.lane;
    for (int rl = C.wave; rl < rows_per_wg; rl += NWAVES) {
        const int t = C.wg * rows_per_wg + rl;
        const f32x4* xr = (const f32x4*)(xin + (size_t)t * D) + lane; const u32x2* xb = (const u32x2*)((const bf16_t*)xin + (size_t)t * D) + lane;
        f32x4 v[8]; float ss = 0.f;
#pragma unroll
        for (int j = 0; j < 8; ++j) { if (MODE == 2) { const u32x2 z = xb[64 * j]; v[j] = (f32x4){bflo(z.x), bfhi(z.x), bflo(z.y), bfhi(z.y)}; } else v[j] = (MODE == 1) ? __builtin_nontemporal_load(xr + 64 * j) : xr[64 * j]; ss += (v[j][0] * v[j][0] + v[j][1] * v[j][1]) + (v[j][2] * v[j][2] + v[j][3] * v[j][3]); }
        const float rstd = rsqrtf(wave_sum(ss) * (1.f / D) + EPS);
#pragma unroll
        for (int j = 0; j < 8; ++j) { const f32x4 g = *((const f32x4*)gain + lane + 64 * j); v[j] = v[j] * rstd * g; if (Q8) { v[j][0] = q8f(v[j][0], 1.f, 1.f); v[j][1] = q8f(v[j][1], 1.f, 1.f); v[j][2] = q8f(v[j][2], 1.f, 1.f); v[j][3] = q8f(v[j][3], 1.f, 1.f); } }
        if (MODE == 2) { unsigned* o4 = (unsigned*)((unsigned char*)hout + (size_t)t * D) + lane;
#pragma unroll
            for (int j = 0; j < 8; ++j) o4[64 * j] = pk4_fp8(v[j][0], v[j][1], v[j][2], v[j][3]);
        } else { u32x2* o8 = (u32x2*)(hout + (size_t)t * D) + lane;
#pragma unroll
            for (int j = 0; j < 8; ++j) o8[64 * j] = (u32x2){cvt_pk_bf16(v[j][0], v[j][1]), cvt_pk_bf16(v[j][2], v[j][3])}; }
        if (MODE != 0) {
            float dot[8];
#pragma unroll
            for (int q = 0; q < 8; ++q) { float s = 0.f;
#pragma unroll
                for (int j = 0; j < 8; ++j) { const f32x4 w = *(const LAS f32x4*)(wT + q * D + 256 * j + 4 * lane); s += (v[j][0] * w[0] + v[j][1] * w[1]) + (v[j][2] * w[2] + v[j][3] * w[3]); }
                dot[q] = wave_sum(s); }
            if (MODE == 1) {
                if (lane < 4) { float gi = 0.f, gf = 0.f;
#pragma unroll
                    for (int q = 0; q < 4; ++q) { if (lane == q) { gi = dot[q]; gf = dot[4 + q]; } }
                    gi += C.b_gates[lane]; gf += C.b_gates[4 + lane];
                    const float lf = fminf(gf, 0.f) - log1pf(__expf(-fabsf(gf)));
                    ((float*)(C.ws + WS_GI))[t * 4 + lane] = gi; ((float*)(C.ws + WS_GF))[t * 4 + lane] = lf; }
            } else {
                int e1 = 0; float v1 = dot[0];
#pragma unroll
                for (int q = 1; q < 8; ++q) if (dot[q] > v1) { v1 = dot[q]; e1 = q; }
                int e2 = -1; float v2 = -3.0e38f;
#pragma unroll
                for (int q = 0; q < 8; ++q) if (q != e1 && dot[q] > v2) { v2 = dot[q]; e2 = q; }
                const float w2 = 1.f / (1.f + __expf(v1 - v2)), w1 = 1.f - w2;
                if (lane == 0) { ((int*)(C.ws + WS_RTE))[2 * t] = e1; ((int*)(C.ws + WS_RTE))[2 * t + 1] = e2; ((float*)(C.ws + WS_RTW))[2 * t] = w1; ((float*)(C.ws + WS_RTW))[2 * t + 1] = w2;
                    atomicAdd((int*)(lcnt + e1), 1); atomicAdd((int*)(lcnt + e2), 1); }
            }
        }
    }
    if (MODE == 2) { __syncthreads(); if (C.tid < 8) ((int*)(C.ws + WS_CNT))[C.wg * 8 + C.tid] = lcnt[C.tid]; }
    __syncthreads();
}
__device__ __forceinline__ int crow(int r, int hi) { return (r & 3) + 8 * (r >> 2) + 4 * hi; }
__device__ __forceinline__ f32x16 mfma32(bf16x8 a, bf16x8 b, f32x16 c) { return __builtin_amdgcn_mfma_f32_32x32x16_bf16(a, b, c, 0, 0, 0); }
#define PK4(P, B_, OUT) do { unsigned a0_ = cvt_pk_bf16(P[B_ + 0], P[B_ + 1]), a1_ = cvt_pk_bf16(P[B_ + 2], P[B_ + 3]);                 \
        unsigned b0_ = cvt_pk_bf16(P[B_ + 4], P[B_ + 5]), b1_ = cvt_pk_bf16(P[B_ + 6], P[B_ + 7]);                                      \
        auto r0_ = __builtin_amdgcn_permlane32_swap(a0_, b0_, false, false); auto r1_ = __builtin_amdgcn_permlane32_swap(a1_, b1_, false, false); \
        u32x4 w_ = {r0_[0], r1_[0], r0_[1], r1_[1]}; OUT = *reinterpret_cast<bf16x8*>(&w_); } while (0)
__device__ __forceinline__ float half_swap_add(float v) { auto rr = __builtin_amdgcn_permlane32_swap(__float_as_uint(v), __float_as_uint(v), false, false); return __uint_as_float(rr[0]) + __uint_as_float(rr[1]); }
__device__ __forceinline__ float half_swap_max(float v) { auto rr = __builtin_amdgcn_permlane32_swap(__float_as_uint(v), __float_as_uint(v), false, false); return fmaxf(__uint_as_float(rr[0]), __uint_as_float(rr[1])); }
__device__ __forceinline__ float ret_log2gamma(int h) { return log2f(1.f - exp2f(-5.f - (float)h)); }

__device__ __forceinline__ void mlstm_scalar_scan(const Ctx& C, int bh) {
    const int b = bh >> 2, h = bh & 3, lane = C.lane, tid = C.tid;
    const float* gi = (const float*)(C.ws + WS_GI); const float* gf = (const float*)(C.ws + WS_GF);
    float* bcw = (float*)(C.ws + WS_BC); float* wl = (float*)(C.ws + WS_WL); float* mprev = (float*)(C.ws + WS_MPREV); float* decv = (float*)(C.ws + WS_DEC);
    constexpr int P = LM + 1;
    LAS float* fl = (LAS float*)C.lds; LAS float* il = fl + NCM * P;
#pragma unroll
    for (int j = 0; j < 8; ++j) { const int pos = tid + 512 * j, t = b * SEQ + pos; fl[(pos / LM) * P + (pos % LM)] = gf[t * 4 + h]; il[(pos / LM) * P + (pos % LM)] = gi[t * 4 + h]; }
    __syncthreads();
    if (C.wave == 0) {
        const int ck = lane < NCM ? lane : NCM - 1;
        const LAS float* fr_ = fl + ck * P; const LAS float* ir_ = il + ck * P;
        float bc = 0.f, mxp = -__builtin_inff();
        for (int l = 0; l < LM; ++l) { bc += fr_[l]; mxp = fmaxf(mxp, ir_[l] - bc); }
        const float g = bc, mx = g + mxp;
        float m = -__builtin_inff(), mp_l = 0.f, mn_l = 0.f;
        for (int k = 0; k < NCM; ++k) { const float gk = __builtin_bit_cast(float, __builtin_amdgcn_readlane(__builtin_bit_cast(int, g), k)), mxk = __builtin_bit_cast(float, __builtin_amdgcn_readlane(__builtin_bit_cast(int, mx), k));
            const float mp = m; m = fmaxf(gk + m, mxk); if (lane == k) { mp_l = mp; mn_l = m; } }
        if (lane < NCM) { mprev[bh * 64 + lane] = mp_l; decv[bh * 64 + lane] = (mp_l == -__builtin_inff()) ? 0.f : __expf(g + mp_l - mn_l);
            LAS float* fw = fl + lane * P; LAS float* iw = il + lane * P;
            bc = 0.f;
            for (int l = 0; l < LM; ++l) { bc += fw[l]; const float w = __expf(g - bc + iw[l] - mn_l); fw[l] = bc; iw[l] = w; } }
    }
    __syncthreads();
#pragma unroll
    for (int j = 0; j < 8; ++j) { const int pos = tid + 512 * j, t = b * SEQ + pos; bcw[t * 4 + h] = fl[(pos / LM) * P + (pos % LM)]; wl[t * 4 + h] = il[(pos / LM) * P + (pos % LM)]; }
    __syncthreads();
}

constexpr int CONVTAB_OFF = 143360;
__device__ __forceinline__ void conv_taps_to_lds(const Ctx& C, int h, int tid) {
    LAS float* tab = (LAS float*)(C.lds + CONVTAB_OFF);
#pragma unroll
    for (int i = 0; i < 4; ++i) { const int idx = tid + 512 * i, which = idx >> 10, tap = (idx >> 8) & 3, c = idx & 255; tab[idx] = C.conv_w[tap * 2048 + which * 1024 + h * 256 + c]; }
}
__device__ __forceinline__ void conv8_silu(const bf16_t* zc, int t, int s, const LAS float* wt, float sc, float (&y)[8]) {
#pragma unroll
    for (int i = 0; i < 8; ++i) y[i] = 0.f;
#pragma unroll
    for (int tap = 0; tap < 4; ++tap) if (s - 3 + tap >= 0) { const u32x4 z = *(const u32x4*)(zc + (size_t)(t - 3 + tap) * 8192);
        const f32x4 w0 = *(const LAS f32x4*)(wt + tap * 256), w1 = *(const LAS f32x4*)(wt + tap * 256 + 4);
        y[0] += bflo(z.x) * w0[0]; y[1] += bfhi(z.x) * w0[1]; y[2] += bflo(z.y) * w0[2]; y[3] += bfhi(z.y) * w0[3];
        y[4] += bflo(z.z) * w1[0]; y[5] += bfhi(z.z) * w1[1]; y[6] += bflo(z.w) * w1[2]; y[7] += bfhi(z.w) * w1[3]; }
#pragma unroll
    for (int i = 0; i < 8; ++i) y[i] = silu_f(y[i]) * sc;
}

template <bool RET>
__device__ __forceinline__ void mixer_contrib_unit(const Ctx& C, int bh, int k) {
    constexpr int L = RET ? LR : LM, NC = RET ? NCR : NCM, NHALF = L / 64, PITCH = 72;
    const int b = bh >> 2, h = bh & 3, t0 = b * SEQ + k * L;
    int lane_ = C.lane; asm volatile("" : "+v"(lane_));
    const int lane = lane_, wave = C.wave, tid = wave * 64 + lane, c32 = lane & 31, hi = lane >> 5;
    const bf16_t* ksrc = (const bf16_t*)(C.ws + WS_Z) + (RET ? 5120 : 1024) + h * 256;
    const bf16_t* vsrc = (const bf16_t*)(C.ws + WS_Z) + (RET ? 6144 : 2048) + h * 256;
    bf16_t* UT = (bf16_t*)(C.ws + (RET ? WS_STR : WS_STM)) + ((size_t)bh * NC + k) * 65536;
    LAS bf16_t* vT = (LAS bf16_t*)C.lds; LAS bf16_t* kT = (LAS bf16_t*)(C.lds + 36864);
    const float* wl = (const float*)(C.ws + WS_WL);
    const float lg2 = ret_log2gamma(h);
    f32x16 acc[8];
#pragma unroll
    for (int i = 0; i < 8; ++i) acc[i] = f32x16{};
    float unacc = 0.f;
    if (!RET) { conv_taps_to_lds(C, h, tid); __syncthreads(); }
    for (int hf = 0; hf < NHALF; ++hf) {
#pragma unroll
        for (int i = 0; i < 4; ++i) { const int c = tid + 512 * i, l = c & 63, c8 = c >> 6, lt = hf * 64 + l, t = t0 + lt;
            const u32x4 vz = *(const u32x4*)(vsrc + (size_t)t * 8192 + 8 * c8);
            const float w = RET ? __builtin_amdgcn_exp2f(lg2 * (float)(L - 1 - lt)) : wl[t * 4 + h];
            unsigned k0, k1, k2, k3;
            if (RET) { const u32x4 kz = *(const u32x4*)(ksrc + (size_t)t * 8192 + 8 * c8);
                k0 = cvt_pk_bf16(bflo(kz.x) * w, bfhi(kz.x) * w); k1 = cvt_pk_bf16(bflo(kz.y) * w, bfhi(kz.y) * w); k2 = cvt_pk_bf16(bflo(kz.z) * w, bfhi(kz.z) * w); k3 = cvt_pk_bf16(bflo(kz.w) * w, bfhi(kz.w) * w); }
            else { float y[8]; conv8_silu(ksrc + 8 * c8, t, t & (SEQ - 1), (const LAS float*)(C.lds + CONVTAB_OFF) + 1024 + 8 * c8, 0.0625f * w, y);
                k0 = cvt_pk_bf16(y[0], y[1]); k1 = cvt_pk_bf16(y[2], y[3]); k2 = cvt_pk_bf16(y[4], y[5]); k3 = cvt_pk_bf16(y[6], y[7]); }
            LAS bf16_t* kd = kT + (8 * c8) * PITCH + l; LAS bf16_t* vd = vT + (8 * c8) * PITCH + l;
            kd[0 * PITCH] = (bf16_t)(k0 & 0xffff); kd[1 * PITCH] = (bf16_t)(k0 >> 16); kd[2 * PITCH] = (bf16_t)(k1 & 0xffff); kd[3 * PITCH] = (bf16_t)(k1 >> 16);
            kd[4 * PITCH] = (bf16_t)(k2 & 0xffff); kd[5 * PITCH] = (bf16_t)(k2 >> 16); kd[6 * PITCH] = (bf16_t)(k3 & 0xffff); kd[7 * PITCH] = (bf16_t)(k3 >> 16);
            vd[0 * PITCH] = (bf16_t)(vz.x & 0xffff); vd[1 * PITCH] = (bf16_t)(vz.x >> 16); vd[2 * PITCH] = (bf16_t)(vz.y & 0xffff); vd[3 * PITCH] = (bf16_t)(vz.y >> 16);
            vd[4 * PITCH] = (bf16_t)(vz.z & 0xffff); vd[5 * PITCH] = (bf16_t)(vz.z >> 16); vd[6 * PITCH] = (bf16_t)(vz.w & 0xffff); vd[7 * PITCH] = (bf16_t)(vz.w >> 16); }
        __syncthreads();
#pragma unroll
        for (int ks = 0; ks < 4; ++ks) {
            const bf16x8 af = *(const LAS bf16x8*)(vT + (32 * wave + c32) * PITCH + 16 * ks + 8 * hi);
#pragma unroll
            for (int db = 0; db < 8; ++db) { const bf16x8 bfr = *(const LAS bf16x8*)(kT + (32 * db + c32) * PITCH + 16 * ks + 8 * hi); acc[db] = mfma32(af, bfr, acc[db]); }
        }
        if (!RET && tid < 256) {
#pragma unroll
            for (int q = 0; q < 8; ++q) { const u32x4 z = *(const LAS u32x4*)(kT + tid * PITCH + 8 * q);
                unacc += (bflo(z.x) + bfhi(z.x)) + (bflo(z.y) + bfhi(z.y)) + (bflo(z.z) + bfhi(z.z)) + (bflo(z.w) + bfhi(z.w)); } }
        __syncthreads();
    }
    LAS unsigned char* Wl = C.lds + wave * 16384;
#pragma unroll
    for (int db = 0; db < 8; ++db)
#pragma unroll
        for (int r = 0; r < 16; r += 2) { const float send = (lane & 1) ? acc[db][r] : acc[db][r + 1]; const float recv = __shfl_xor(send, 1);
            const unsigned val = (lane & 1) ? cvt_pk_bf16(recv, acc[db][r + 1]) : cvt_pk_bf16(acc[db][r], recv);
            *(LAS unsigned*)(Wl + crow(r + (lane & 1), hi) * 512 + (32 * db + (c32 & ~1)) * 2) = val; if (r == 14) __builtin_amdgcn_sched_barrier(0); }
    LDS_WAIT();
#pragma unroll
    for (int j = 0; j < 16; ++j) { const int idx = lane + 64 * j, row = idx >> 5, ch = idx & 31;
        *(u32x4*)(UT + (size_t)(32 * wave + row) * 256 + 8 * ch) = *(const LAS u32x4*)(Wl + row * 512 + ch * 16); }
    if (!RET && tid < 256) ((float*)(C.ws + WS_UN))[((size_t)bh * NCM + k) * 256 + tid] = unacc;
    __syncthreads();
}
__device__ __forceinline__ void phase_contrib(const Ctx& C) {
    constexpr int NU = 8 * NCM + 8 * NCR;
    for (int u = C.wg; u < NU; u += C.nwg) {
        if (u < 8 * NCM) mixer_contrib_unit<false>(C, u / NCM, u % NCM); else mixer_contrib_unit<true>(C, (u - 8 * NCM) / NCR, (u - 8 * NCM) % NCR);
    }
}

__device__ __forceinline__ void phase_scan(const Ctx& C) {
    const int gt = C.wg * NTHR + C.tid, NGT = C.nwg * NTHR;
    const float* decv = (const float*)(C.ws + WS_DEC);
    for (int it = gt; it < 2 * 65536; it += NGT) {
        const bool ret = it >= 65536; const int r = it & 65535, bh = r >> 13, c = r & 8191;
        const int nc = ret ? NCR : NCM;
        bf16_t* base = (bf16_t*)(C.ws + (ret ? WS_STR : WS_STM)) + (size_t)bh * nc * 65536 + c * 8;
        const float cdec = exp2f(ret_log2gamma(bh & 3) * (float)LR);
        float run[8];
#pragma unroll
        for (int i = 0; i < 8; ++i) run[i] = 0.f;
#pragma unroll 4
        for (int k = 0; k < nc; ++k) {
            u32x4* p = (u32x4*)(base + (size_t)k * 65536); const u32x4 u = *p;
            *p = (u32x4){cvt_pk_bf16(run[0], run[1]), cvt_pk_bf16(run[2], run[3]), cvt_pk_bf16(run[4], run[5]), cvt_pk_bf16(run[6], run[7])};
            const float dec = ret ? cdec : decv[bh * 64 + k];
            run[0] = run[0] * dec + bflo(u.x); run[1] = run[1] * dec + bfhi(u.x); run[2] = run[2] * dec + bflo(u.y); run[3] = run[3] * dec + bfhi(u.y);
            run[4] = run[4] * dec + bflo(u.z); run[5] = run[5] * dec + bfhi(u.z); run[6] = run[6] * dec + bflo(u.w); run[7] = run[7] * dec + bfhi(u.w);
        }
    }
    for (int it = gt; it < 8 * 256; it += NGT) { const int bh = it >> 8, d = it & 255; float* un = (float*)(C.ws + WS_UN) + (size_t)bh * NCM * 256 + d; float u[NCM], dc[NCM];
#pragma unroll
        for (int k = 0; k < NCM; ++k) { u[k] = un[k * 256]; dc[k] = decv[bh * 64 + k]; }
        float run = 0.f;
#pragma unroll
        for (int k = 0; k < NCM; ++k) { const float uk = u[k]; u[k] = run; run = run * dc[k] + uk; }
#pragma unroll
        for (int k = 0; k < NCM; ++k) un[k * 256] = u[k]; }
}

template <bool RET>
__device__ __forceinline__ void mixer_out_unit(const Ctx& C, int bh, int k) {
    constexpr int L = RET ? LR : LM, NLB = L / 32, NEG = 8 / NLB, NEB = 8 / NEG, NC = RET ? NCR : NCM, PITCH = L + 8, KP = 264;
    const int b = bh >> 2, h = bh & 3, t0 = b * SEQ + k * L;
    int lane_ = C.lane; asm volatile("" : "+v"(lane_));
    const int lane = lane_, wave = C.wave, tid = wave * 64 + lane, c32 = lane & 31, hi = lane >> 5;
    const int lb = wave % NLB, eg = wave / NLB;
    const bf16_t* Z = (const bf16_t*)(C.ws + WS_Z);
    const bf16_t* qsrc = Z + (RET ? 4096 : 0) + h * 256;
    const bf16_t* ksrc = Z + (RET ? 5120 : 1024) + h * 256;
    const bf16_t* vsrc = Z + (RET ? 6144 : 2048) + h * 256;
    const bf16_t* gsrc = Z + (RET ? 7168 : 3072) + h * 256;
    const bf16_t* ST = (const bf16_t*)(C.ws + (RET ? WS_STR : WS_STM)) + ((size_t)bh * NC + k) * 65536;
    const float* gain = (RET ? C.g_ro : C.g_mo) + h * 256;
    bf16_t* MIX = (bf16_t*)(C.ws + WS_MIX) + (RET ? 1024 : 0) + h * 256;
    LAS bf16_t* Kl = (LAS bf16_t*)C.lds;
    constexpr int KBYTES = L * KP * 2, TAB = KBYTES + 256 * PITCH * 2;
    LAS bf16_t* vT = (LAS bf16_t*)(C.lds + KBYTES);
    LAS float* a_s = (LAS float*)(C.lds + TAB);
    LAS float* nprev = a_s + 128;
    LAS float* rowtab = nprev + 256;
    const int lrow = 32 * lb + c32;
    bf16x8 qr[16], sf[16];
    if (RET) {
#pragma unroll
        for (int ks = 0; ks < 16; ++ks) qr[ks] = *(const bf16x8*)(qsrc + (size_t)(t0 + lrow) * 8192 + 16 * ks + 8 * hi);
    } else conv_taps_to_lds(C, h, tid);
#pragma unroll
    for (int ks = 0; ks < 16; ++ks) sf[ks] = *(const bf16x8*)(ST + (size_t)(eg * NEB * 32 + c32) * 256 + 16 * ks + 8 * hi);
    if (RET) {
#pragma unroll
        for (int i = 0; i < L / 16; ++i) { const int c = tid + 512 * i, row = c >> 5, ch = c & 31;
            *(LAS u32x4*)(Kl + row * KP + 8 * ch) = *(const u32x4*)(ksrc + (size_t)(t0 + row) * 8192 + 8 * ch); }
    } else {
        __syncthreads();
        const LAS float* taps = (const LAS float*)(C.lds + CONVTAB_OFF);
#pragma unroll
        for (int i = 0; i < L / 16; ++i) { const int c = tid + 512 * i, row = c >> 5, ch = c & 31, t = t0 + row; float y[8];
            conv8_silu(qsrc + 8 * ch, t, t & (SEQ - 1), taps + 8 * ch, 1.f, y);
            *(LAS u32x4*)(Kl + row * KP + 8 * ch) = (u32x4){cvt_pk_bf16(y[0], y[1]), cvt_pk_bf16(y[2], y[3]), cvt_pk_bf16(y[4], y[5]), cvt_pk_bf16(y[6], y[7])}; }
        __syncthreads();
#pragma unroll
        for (int ks = 0; ks < 16; ++ks) qr[ks] = *(const LAS bf16x8*)(Kl + lrow * KP + 16 * ks + 8 * hi);
        __syncthreads();
#pragma unroll
        for (int i = 0; i < L / 16; ++i) { const int c = tid + 512 * i, row = c >> 5, ch = c & 31, t = t0 + row; float y[8];
            conv8_silu(ksrc + 8 * ch, t, t & (SEQ - 1), taps + 1024 + 8 * ch, 0.0625f, y);
            *(LAS u32x4*)(Kl + row * KP + 8 * ch) = (u32x4){cvt_pk_bf16(y[0], y[1]), cvt_pk_bf16(y[2], y[3]), cvt_pk_bf16(y[4], y[5]), cvt_pk_bf16(y[6], y[7])}; }
    }
#pragma unroll
    for (int i = 0; i < L / 16; ++i) { const int c = tid + 512 * i, l = c & (L - 1), c8 = c / L;
        const u32x4 vz = *(const u32x4*)(vsrc + (size_t)(t0 + l) * 8192 + 8 * c8); LAS bf16_t* vd = vT + (8 * c8) * PITCH + l;
        vd[0 * PITCH] = (bf16_t)(vz.x & 0xffff); vd[1 * PITCH] = (bf16_t)(vz.x >> 16); vd[2 * PITCH] = (bf16_t)(vz.y & 0xffff); vd[3 * PITCH] = (bf16_t)(vz.y >> 16);
        vd[4 * PITCH] = (bf16_t)(vz.z & 0xffff); vd[5 * PITCH] = (bf16_t)(vz.z >> 16); vd[6 * PITCH] = (bf16_t)(vz.w & 0xffff); vd[7 * PITCH] = (bf16_t)(vz.w >> 16); }
    float mprev = 0.f;
    if (!RET) {
        if (tid < L) a_s[tid] = ((const float*)(C.ws + WS_GI))[(t0 + tid) * 4 + h] - ((const float*)(C.ws + WS_BC))[(t0 + tid) * 4 + h];
        if (tid < 256) nprev[tid] = ((const float*)(C.ws + WS_UN))[((size_t)bh * NCM + k) * 256 + tid];
        mprev = ((const float*)(C.ws + WS_MPREV))[bh * 64 + k];
    }
    __syncthreads();
    float rowf, rowd, M = 0.f, bl = 0.f, dsum = 0.f;
    const float lg2 = ret_log2gamma(h);
    if (!RET) {
        float pm = -__builtin_inff();
#pragma unroll 8
        for (int s4 = 0; s4 < L; s4 += 4) { const f32x4 a = *(const LAS f32x4*)(a_s + s4);
            const float NI = -__builtin_inff();
            pm = fmaxf(pm, (s4 <= lrow) ? a[0] : NI); pm = fmaxf(pm, (s4 + 1 <= lrow) ? a[1] : NI); pm = fmaxf(pm, (s4 + 2 <= lrow) ? a[2] : NI); pm = fmaxf(pm, (s4 + 3 <= lrow) ? a[3] : NI); }
        M = fmaxf(pm, mprev);
        bl = ((const float*)(C.ws + WS_BC))[(t0 + lrow) * 4 + h];
    }
    bf16x8 pa[2 * NLB];
#pragma unroll
    for (int sb = 0; sb < NLB; ++sb) {
        f32x16 p = f32x16{};
        if (sb <= lb) {
#pragma unroll
            for (int ks = 0; ks < 16; ++ks) { const bf16x8 kf = *(const LAS bf16x8*)(Kl + (32 * sb + c32) * KP + 16 * ks + 8 * hi); p = mfma32(kf, qr[ks], p); }
#pragma unroll
            for (int g = 0; g < 4; ++g) {
                f32x4 av = (f32x4){0.f, 0.f, 0.f, 0.f}; if (!RET) av = *(const LAS f32x4*)(a_s + 32 * sb + 8 * g + 4 * hi);
#pragma unroll
                for (int j = 0; j < 4; ++j) { const int r = 4 * g + j, s = 32 * sb + crow(r, hi);
                    if (!RET) { const float e = __expf(av[j] - M); const float dm = (s <= lrow) ? e : 0.f; p[r] *= dm; dsum += p[r]; }
                    else p[r] = (s <= lrow) ? p[r] * __builtin_amdgcn_exp2f(lg2 * (float)(lrow - s)) : 0.f; } }
        }
        PK4(p, 0, pa[2 * sb]); PK4(p, 8, pa[2 * sb + 1]);
        __builtin_amdgcn_sched_barrier(0);
    }
    if (!RET) {
        const float inter = (mprev == -__builtin_inff()) ? 0.f : __expf(mprev - M);
        dsum = half_swap_add(dsum);
        float qn = 0.f;
#pragma unroll
        for (int ks = 0; ks < 16; ++ks) { const u32x4 qz = *reinterpret_cast<const u32x4*>(&qr[ks]); const LAS float* np = nprev + 16 * ks + 8 * hi;
            qn += (bflo(qz.x) * np[0] + bfhi(qz.x) * np[1]) + (bflo(qz.y) * np[2] + bfhi(qz.y) * np[3]) + (bflo(qz.z) * np[4] + bfhi(qz.z) * np[5]) + (bflo(qz.w) * np[6] + bfhi(qz.w) * np[7]); }
        qn = half_swap_add(qn);
        const float den = dsum + inter * qn;
        rowf = inter; rowd = 1.f / fmaxf(fabsf(den), __expf(-bl - M));
    } else { rowf = exp2f(lg2 * (float)(lrow + 1)); rowd = 1.f; }
    LAS float* rt = rowtab + wave * 64;
    if (hi == 0) { rt[c32] = rowf; rt[32 + c32] = rowd; }
    __syncthreads();
#pragma unroll
    for (int eb = 0; eb < NEB; ++eb) {
        const int e0 = (eg * NEB + eb) * 32;
        f32x16 n1 = f32x16{}, n2 = f32x16{};
#pragma unroll
        for (int ks = 0; ks < 16; ++ks) { n2 = mfma32(qr[ks], sf[ks], n2);
            if (eb + 1 < NEB) sf[ks] = *(const bf16x8*)(ST + (size_t)(e0 + 32 + c32) * 256 + 16 * ks + 8 * hi); }
#pragma unroll
        for (int sb = 0; sb < NLB; ++sb) if (sb <= lb) {
#pragma unroll
            for (int kk = 0; kk < 2; ++kk) { const bf16x8 vf = *(const LAS bf16x8*)(vT + (e0 + c32) * PITCH + 32 * sb + 16 * kk + 8 * hi); n1 = mfma32(pa[2 * sb + kk], vf, n1); } }
#pragma unroll
        for (int r = 0; r < 16; ++r) { const int rl = crow(r, hi); Kl[(32 * lb + rl) * KP + e0 + c32] = f2bf((n1[r] + rt[rl] * n2[r]) * rt[32 + rl]); }
        __builtin_amdgcn_sched_barrier(0);
    }
    __syncthreads();
#pragma unroll
    for (int l8 = 0; l8 < L / NWAVES; l8 += 8) {
        f32x4 v[8]; u32x2 gz[8];
#pragma unroll
        for (int j = 0; j < 8; ++j) { const int l = wave + NWAVES * (l8 + j), t = t0 + l; const u32x2 hz = *(const LAS u32x2*)(Kl + l * KP + 4 * lane); v[j] = (f32x4){bflo(hz.x), bfhi(hz.x), bflo(hz.y), bfhi(hz.y)};
            gz[j] = *(const u32x2*)(gsrc + (size_t)t * 8192 + 4 * lane); }
        const f32x4 gn = *(const f32x4*)(gain + 4 * lane);
#pragma unroll
        for (int j = 0; j < 8; ++j) { const int t = t0 + wave + NWAVES * (l8 + j);
            const float g0 = bflo(gz[j].x), g1 = bfhi(gz[j].x), g2 = bflo(gz[j].y), g3 = bfhi(gz[j].y); f32x4 x = v[j];
            if (!RET) { x[0] *= sigmoid_f(g0); x[1] *= sigmoid_f(g1); x[2] *= sigmoid_f(g2); x[3] *= sigmoid_f(g3); }
            const float rstd = rsqrtf(wave_sum((x[0] * x[0] + x[1] * x[1]) + (x[2] * x[2] + x[3] * x[3])) * (1.f / 256.f) + EPS);
            x = x * rstd * gn;
            if (RET) { x[0] *= silu_f(g0); x[1] *= silu_f(g1); x[2] *= silu_f(g2); x[3] *= silu_f(g3); }
            *(u32x2*)(MIX + (size_t)t * 2048 + 4 * lane) = (u32x2){cvt_pk_bf16(x[0], x[1]), cvt_pk_bf16(x[2], x[3])}; }
    }
    __syncthreads();
}
__device__ __forceinline__ void phase_mixout(const Ctx& C) {
    constexpr int NU = 8 * NCM + 8 * NCR;
    for (int u = C.wg; u < NU; u += C.nwg) {
#if !defined(MIX_ONLY) || MIX_ONLY == 0
        if (u < 8 * NCM) mixer_out_unit<false>(C, u / NCM, u % NCM);
#endif
#if !defined(MIX_ONLY) || MIX_ONLY == 1
        if (u >= 8 * NCM) mixer_out_unit<true>(C, (u - 8 * NCM) / NCR, (u - 8 * NCM) % NCR);
#endif
    }
}
__device__ __forceinline__ void phase_latent_norm(const Ctx& C) {
    const float* cq = (const float*)(C.ws + WS_CQKV); bf16_t* out = (bf16_t*)(C.ws + WS_CQKVN); bf16_t* kr = (bf16_t*)(C.ws + WS_KR);
    const f32x2* ropeM = (const f32x2*)(C.ws + WS_ROPEM);
    const int gw = C.wg * NWAVES + C.wave, NGW = C.nwg * NWAVES, lane = C.lane;
    for (int t = gw; t < T; t += NGW) {
        const float* row = cq + (size_t)t * NDQKV;
        const f32x4 a0 = *(const f32x4*)(row + 8 * lane), a1 = *(const f32x4*)(row + 8 * lane + 4);
        const f32x4 b0 = *(const f32x4*)(row + 512 + 8 * lane), b1 = *(const f32x4*)(row + 512 + 8 * lane + 4);
        const float kv = row[1024 + lane];
        const float sa = wave_sum((a0[0] * a0[0] + a0[1] * a0[1]) + (a0[2] * a0[2] + a0[3] * a0[3]) + (a1[0] * a1[0] + a1[1] * a1[1]) + (a1[2] * a1[2] + a1[3] * a1[3]));
        const float sb = wave_sum((b0[0] * b0[0] + b0[1] * b0[1]) + (b0[2] * b0[2] + b0[3] * b0[3]) + (b1[0] * b1[0] + b1[1] * b1[1]) + (b1[2] * b1[2] + b1[3] * b1[3]));
        const float sk = wave_sum(kv * kv);
        const float ra = rsqrtf(sa * (1.f / 512.f) + EPS), rb = rsqrtf(sb * (1.f / 512.f) + EPS), rk = rsqrtf(sk * (1.f / 64.f) + EPS);
        const f32x4 ga0 = *(const f32x4*)(C.g_cq + 8 * lane), ga1 = *(const f32x4*)(C.g_cq + 8 * lane + 4), gb0 = *(const f32x4*)(C.g_ckv + 8 * lane), gb1 = *(const f32x4*)(C.g_ckv + 8 * lane + 4);
        const f32x4 ya0 = a0 * ra * ga0, ya1 = a1 * ra * ga1, yb0 = b0 * rb * gb0, yb1 = b1 * rb * gb1;
        *(u32x4*)(out + (size_t)t * 1024 + 8 * lane) = (u32x4){cvt_pk_bf16(ya0[0], ya0[1]), cvt_pk_bf16(ya0[2], ya0[3]), cvt_pk_bf16(ya1[0], ya1[1]), cvt_pk_bf16(ya1[2], ya1[3])};
        *(u32x4*)(out + (size_t)t * 1024 + 512 + 8 * lane) = (u32x4){cvt_pk_bf16(yb0[0], yb0[1]), cvt_pk_bf16(yb0[2], yb0[3]), cvt_pk_bf16(yb1[0], yb1[1]), cvt_pk_bf16(yb1[2], yb1[3])};
        const float y = kv * rk * C.g_kr[lane]; const float partner = __shfl_xor(y, 32); const f32x2 cs = ropeM[(size_t)t * 32 + (lane & 31)];
        const float o = (lane < 32) ? (y * cs[0] - partner * cs[1]) : (y * cs[0] + partner * cs[1]);
        kr[(size_t)t * 64 + lane] = f2bf(o);
    }
}

__device__ __forceinline__ void unpack8(const u32x4 z, float (&f)[8]) { f[0] = bflo(z.x); f[1] = bfhi(z.x); f[2] = bflo(z.y); f[3] = bfhi(z.y); f[4] = bflo(z.z); f[5] = bfhi(z.z); f[6] = bflo(z.w); f[7] = bfhi(z.w); }
__device__ __forceinline__ u32x4 pack8f(const float (&f)[8]) { return (u32x4){cvt_pk_bf16(f[0], f[1]), cvt_pk_bf16(f[2], f[3]), cvt_pk_bf16(f[4], f[5]), cvt_pk_bf16(f[6], f[7])}; }
__device__ __forceinline__ float sum8sq(const float (&f)[8]) { return (f[0] * f[0] + f[1] * f[1]) + (f[2] * f[2] + f[3] * f[3]) + (f[4] * f[4] + f[5] * f[5]) + (f[6] * f[6] + f[7] * f[7]); }
__device__ __forceinline__ float xor4_dpp(float v, bool upper) { const float a = dpp_mov<0x104>(v), b = dpp_mov<0x114>(v); return upper ? b : a; }
__device__ __forceinline__ float red8(float v) { v += dpp_mov<0xB1>(v); v += dpp_mov<0x4E>(v); v += dpp_mov<0x141>(v); return v; }
constexpr size_t WS_KRB = WS_KA;
__device__ __forceinline__ void phase_kr_prep(const Ctx& C) {
    if (C.wg * NTHR >= T * 8) return;
    const float* kr = (const float*)(C.ws + WS_KR); bf16_t* KRB = (bf16_t*)(C.ws + WS_KRB); const f32x2* ropeM = (const f32x2*)(C.ws + WS_ROPEM);
    for (int g = C.wg * NTHR + C.tid; g < T * 8; g += C.nwg * NTHR) { const int t = g >> 3, sub = g & 7;
        const f32x4 kra = *(const f32x4*)(kr + (size_t)t * 64 + 8 * sub), krb = *(const f32x4*)(kr + (size_t)t * 64 + 8 * sub + 4);
        float kk[8] = {kra[0], kra[1], kra[2], kra[3], krb[0], krb[1], krb[2], krb[3]}; const float rkr = rsqrtf(red8(sum8sq(kk)) * (1.f / 64.f) + EPS); float ko[8];
#pragma unroll
        for (int i = 0; i < 8; ++i) kk[i] *= rkr * C.g_kr[8 * sub + i];
#pragma unroll
        for (int i = 0; i < 8; ++i) { const float partner = xor4_dpp(kk[i], sub >= 4); const f32x2 cs = ropeM[(size_t)t * 32 + 8 * (sub & 3) + i];
            ko[i] = (sub < 4) ? (kk[i] * cs[0] - partner * cs[1]) : (kk[i] * cs[0] + partner * cs[1]); }
        *(u32x4*)(KRB + (size_t)t * 64 + 8 * sub) = pack8f(ko); }
}
__device__ __forceinline__ void phase_qkv_heads(const Ctx& C) {
    const bf16_t* R = (const bf16_t*)(C.ws + WS_QKVR); const float* kr = (const float*)(C.ws + WS_KR);
    bf16_t* KRB = (bf16_t*)(C.ws + WS_KRB); bf16_t* VT = (bf16_t*)(C.ws + WS_VT);
    const f32x2* ropeM = (const f32x2*)(C.ws + WS_ROPEM);
    LAS bf16_t* vt = (LAS bf16_t*)C.lds;
    const int tid = C.tid, sl = tid >> 3, sub = tid & 7;
    for (int u = C.wg; u < NBATCH * MLA_H * (SEQ / 64); u += C.nwg) {
        const int sblk = u & 63, h = (u >> 6) & 15, b = u >> 10;
        const int s = sblk * 64 + sl, t = b * SEQ + s;
        const bf16_t* kvrow = R + (size_t)t * 7168 + 3072 + h * 256;
        const u32x4 zv0 = *(const u32x4*)(kvrow + 128 + 16 * sub), zv1 = *(const u32x4*)(kvrow + 128 + 16 * sub + 8);
        if (h == 0) {
            const f32x4 kra = *(const f32x4*)(kr + (size_t)t * 64 + 8 * sub), krb = *(const f32x4*)(kr + (size_t)t * 64 + 8 * sub + 4);
            float kk[8] = {kra[0], kra[1], kra[2], kra[3], krb[0], krb[1], krb[2], krb[3]}; const float rkr = rsqrtf(red8(sum8sq(kk)) * (1.f / 64.f) + EPS); float ko[8];
#pragma unroll
            for (int i = 0; i < 8; ++i) kk[i] *= rkr * C.g_kr[8 * sub + i];
#pragma unroll
            for (int i = 0; i < 8; ++i) { const float partner = xor4_dpp(kk[i], sub >= 4); const f32x2 cs = ropeM[(size_t)t * 32 + 8 * (sub & 3) + i];
                ko[i] = (sub < 4) ? (kk[i] * cs[0] - partner * cs[1]) : (kk[i] * cs[0] + partner * cs[1]); }
            *(u32x4*)(KRB + (size_t)t * 64 + 8 * sub) = pack8f(ko);
        }
        { const unsigned w[8] = {zv0.x, zv0.y, zv0.z, zv0.w, zv1.x, zv1.y, zv1.z, zv1.w};
#pragma unroll
          for (int i = 0; i < 8; ++i) { vt[(16 * sub + 2 * i) * 72 + sl] = (bf16_t)(w[i] & 0xffff); vt[(16 * sub + 2 * i + 1) * 72 + sl] = (bf16_t)(w[i] >> 16); } }
        __syncthreads();
        { const int d = tid >> 2, q4 = tid & 3; const LAS bf16_t* src = vt + d * 72 + 16 * q4;
          bf16_t* dst = VT + (((size_t)b * MLA_H + h) * VH + d) * SEQ + sblk * 64 + 16 * q4;
          *(u32x4*)dst = *(const LAS u32x4*)src; *(u32x4*)(dst + 8) = *(const LAS u32x4*)(src + 8); }
        __syncthreads();
    }
}

constexpr int ATT_KB = 25600, ATT_VB = 18432, ATT_VOFF = 2 * ATT_KB, ATT_ALOFF = ATT_VOFF + 3 * ATT_VB;
__device__ __forceinline__ void attn_block(const Ctx& C, int b, int h, int qb) {
    int lane_ = C.lane; asm volatile("" : "+v"(lane_));
    const int lane = lane_, wave = C.wave, tid = wave * 64 + lane, c32 = lane & 31, hi = lane >> 5;
    const bf16_t* Qg = (const bf16_t*)(C.ws + WS_QKVR) + (size_t)b * SEQ * 7168 + h * 192;
    const bf16_t* Kg = (const bf16_t*)(C.ws + WS_QKVR) + (size_t)b * SEQ * 7168 + 3072 + h * 256;
    const bf16_t* KRg = (const bf16_t*)(C.ws + WS_KRB) + (size_t)b * SEQ * 64;
    const bf16_t* Vg = (const bf16_t*)(C.ws + WS_VT) + (((size_t)b * MLA_H + h) * VH) * SEQ;
    bf16_t* Og = (bf16_t*)(C.ws + WS_AO) + (size_t)b * SEQ * 2048 + h * 128;
    LAS float* al = (LAS float*)(C.lds + ATT_ALOFF) + wave * 32;
    const int q0 = qb * 256, qw = q0 + 32 * wave, qpos = qw + c32;
        const int srow = tid >> 3, ssub = tid & 7;
    u32x4 sk[3], sv[2];
#define ATT_LOAD(k0_) do { const bf16_t* kp_ = Kg + (size_t)((k0_) + srow) * 7168 + 8 * ssub; const bf16_t* vp_ = Vg + (size_t)srow * SEQ + (k0_) + 8 * ssub; \
        sk[0] = *(const u32x4*)kp_; sk[1] = *(const u32x4*)(kp_ + 64); sk[2] = *(const u32x4*)(KRg + (size_t)((k0_) + srow) * 64 + 8 * ssub); sv[0] = *(const u32x4*)vp_; sv[1] = *(const u32x4*)(vp_ + (size_t)64 * SEQ); } while (0)
#define ATT_WRITE(kb_, vb_) do { LAS bf16_t* Kw = (LAS bf16_t*)(C.lds + (kb_) * ATT_KB) + srow * 200 + 8 * ssub; LAS bf16_t* Vw = (LAS bf16_t*)(C.lds + ATT_VOFF + (vb_) * ATT_VB) + srow * 72 + 8 * ssub; \
        float ka_[8], kb_f[8]; unpack8(sk[0], ka_); unpack8(sk[1], kb_f); const float rk_ = rsqrtf(red8(sum8sq(ka_) + sum8sq(kb_f)) * (1.f / 128.f) + EPS); \
        _Pragma("unroll") for (int i_ = 0; i_ < 8; ++i_) { ka_[i_] *= rk_; kb_f[i_] *= rk_; } \
        *(LAS u32x4*)Kw = pack8f(ka_); *(LAS u32x4*)(Kw + 64) = pack8f(kb_f); *(LAS u32x4*)(Kw + 128) = sk[2]; *(LAS u32x4*)Vw = sv[0]; *(LAS u32x4*)(Vw + 64 * 72) = sv[1]; } while (0)
    bf16x8 qr[12];
    { constexpr float QSCALE = 0.07216878364870322f * 1.4426950408889634f;
      const bf16_t* qrow = Qg + (size_t)qpos * 7168; float ssn = 0.f, ssr = 0.f; u32x4 zq[12];
#pragma unroll
      for (int ks = 0; ks < 12; ++ks) zq[ks] = *(const u32x4*)(qrow + 16 * ks + 8 * hi);
#pragma unroll
      for (int ks = 0; ks < 12; ++ks) { float f[8]; unpack8(zq[ks], f); if (ks < 8) ssn += sum8sq(f); else ssr += sum8sq(f); }
      const float rq = rsqrtf(half_swap_add(ssn) * (1.f / 128.f) + EPS) * QSCALE, rr = rsqrtf(half_swap_add(ssr) * (1.f / 64.f) + EPS);
#pragma unroll
      for (int ks = 0; ks < 8; ++ks) { float f[8]; unpack8(zq[ks], f); const f32x4 ga = *(const f32x4*)(C.g_qn + 16 * ks + 8 * hi), gb = *(const f32x4*)(C.g_qn + 16 * ks + 8 * hi + 4), ka = *(const f32x4*)(C.g_kn + 16 * ks + 8 * hi), kb = *(const f32x4*)(C.g_kn + 16 * ks + 8 * hi + 4);
#pragma unroll
          for (int j = 0; j < 4; ++j) { f[j] *= rq * ga[j] * ka[j]; f[4 + j] *= rq * gb[j] * kb[j]; }
          const u32x4 w = pack8f(f); qr[ks] = *reinterpret_cast<const bf16x8*>(&w); }
      const int tq = b * SEQ + qpos;
#pragma unroll
      for (int pr = 0; pr < 2; ++pr) {
          float x1[8], x2[8], o1[8], o2[8]; unpack8(zq[8 + pr], x1); unpack8(zq[10 + pr], x2);
          const f32x4 g1a = *(const f32x4*)(C.g_qr + 16 * pr + 8 * hi), g1b = *(const f32x4*)(C.g_qr + 16 * pr + 8 * hi + 4), g2a = *(const f32x4*)(C.g_qr + 32 + 16 * pr + 8 * hi), g2b = *(const f32x4*)(C.g_qr + 32 + 16 * pr + 8 * hi + 4);
          const f32x4* csp = (const f32x4*)((const float*)(C.ws + WS_ROPEM) + ((size_t)tq * 32 + 16 * pr + 8 * hi) * 2);
#pragma unroll
          for (int j = 0; j < 8; ++j) { x1[j] *= rr * (j < 4 ? g1a[j] : g1b[j - 4]); x2[j] *= rr * (j < 4 ? g2a[j] : g2b[j - 4]); }
#pragma unroll
          for (int j2 = 0; j2 < 4; ++j2) { const f32x4 cs = csp[j2];
              o1[2 * j2] = (x1[2 * j2] * cs[0] - x2[2 * j2] * cs[1]) * QSCALE; o2[2 * j2] = (x2[2 * j2] * cs[0] + x1[2 * j2] * cs[1]) * QSCALE;
              o1[2 * j2 + 1] = (x1[2 * j2 + 1] * cs[2] - x2[2 * j2 + 1] * cs[3]) * QSCALE; o2[2 * j2 + 1] = (x2[2 * j2 + 1] * cs[2] + x1[2 * j2 + 1] * cs[3]) * QSCALE; }
          const u32x4 w1 = pack8f(o1), w2 = pack8f(o2); qr[8 + pr] = *reinterpret_cast<const bf16x8*>(&w1); qr[10 + pr] = *reinterpret_cast<const bf16x8*>(&w2); } }
    constexpr float THR2 = 10.f;
    float m_reg = -1e30f, l_reg = 0.f; f32x16 o[4]; bf16x8 pa0 = bf16x8{}, pa1 = bf16x8{}, pa2 = bf16x8{}, pa3 = bf16x8{};
#pragma unroll
    for (int d = 0; d < 4; ++d) o[d] = f32x16{};
#define ATT_RESC_PA(PA_, al_) do { u32x4 w_ = *reinterpret_cast<const u32x4*>(&(PA_)); \
        _Pragma("unroll") for (int i_ = 0; i_ < 4; ++i_) w_[i_] = cvt_pk_bf16(bflo(w_[i_]) * (al_), bfhi(w_[i_]) * (al_)); PA_ = *reinterpret_cast<const bf16x8*>(&w_); } while (0)
#define ATT_MAXCHK(P_, HASPA) do { float pm_ = fmaxf(P_[0], P_[1]); \
        _Pragma("unroll") for (int r = 2; r < 16; ++r) pm_ = fmaxf(pm_, P_[r]); \
        pm_ = half_swap_max(pm_); \
        if (!__all(pm_ - m_reg <= THR2)) { const float mn_ = fmaxf(m_reg, pm_); const float alpha_ = __builtin_amdgcn_exp2f(m_reg - mn_); m_reg = mn_; l_reg *= alpha_; \
            if (HASPA) { ATT_RESC_PA(pa0, alpha_); ATT_RESC_PA(pa1, alpha_); } \
            if (hi == 0) al[c32] = alpha_; LDS_WAIT(); \
            _Pragma("unroll") for (int d = 0; d < 4; ++d) _Pragma("unroll") for (int r = 0; r < 16; ++r) o[d][r] *= al[crow(r, hi)]; } } while (0)
    const int ntile = (q0 + 256) / 64;
    ATT_LOAD(0); ATT_WRITE(0, 0);
    __syncthreads();
    for (int kt = 0; kt < ntile; ++kt) {
        const int k0 = kt * 64;
        if (kt + 1 < ntile) ATT_LOAD(k0 + 64);
        if (k0 <= qw + 31) {
            const LAS bf16_t* Kl = (const LAS bf16_t*)(C.lds + (kt & 1) * ATT_KB) + c32 * 200 + 8 * hi;
            const LAS bf16_t* Vl = (const LAS bf16_t*)(C.lds + ATT_VOFF + (kt & 1) * ATT_VB) + c32 * 72 + 8 * hi;
            const bool diag = (k0 + 63 > qw);
            const float NEG = -__builtin_inff();
            f32x16 p0 = f32x16{}, p1 = f32x16{};
#pragma unroll
            for (int ks = 0; ks < 12; ++ks) p0 = mfma32(*(const LAS bf16x8*)(Kl + 16 * ks), qr[ks], p0);
            if (diag) {
#pragma unroll
                for (int r = 0; r < 16; ++r) if (k0 + crow(r, hi) > qpos) p0[r] = NEG; }
            ATT_MAXCHK(p0, false);
#pragma unroll
            for (int ks = 0; ks < 12; ++ks) p1 = mfma32(*(const LAS bf16x8*)(Kl + 32 * 200 + 16 * ks), qr[ks], p1);
            { float ps = 0.f;
#pragma unroll
              for (int r = 0; r < 16; ++r) { p0[r] = __builtin_amdgcn_exp2f(p0[r] - m_reg); ps += p0[r]; }
              l_reg += ps; }
            PK4(p0, 0, pa0); PK4(p0, 8, pa1);
            if (diag) {
#pragma unroll
                for (int r = 0; r < 16; ++r) if (k0 + 32 + crow(r, hi) > qpos) p1[r] = NEG; }
            ATT_MAXCHK(p1, true);
#pragma unroll
            for (int d = 0; d < 4; ++d) { o[d] = mfma32(pa0, *(const LAS bf16x8*)(Vl + (32 * d) * 72), o[d]); o[d] = mfma32(pa1, *(const LAS bf16x8*)(Vl + (32 * d) * 72 + 16), o[d]); }
            { float ps = 0.f;
#pragma unroll
              for (int r = 0; r < 16; ++r) { p1[r] = __builtin_amdgcn_exp2f(p1[r] - m_reg); ps += p1[r]; }
              l_reg += ps; }
            PK4(p1, 0, pa2); PK4(p1, 8, pa3);
#pragma unroll
            for (int d = 0; d < 4; ++d) { o[d] = mfma32(pa2, *(const LAS bf16x8*)(Vl + (32 * d) * 72 + 32), o[d]); o[d] = mfma32(pa3, *(const LAS bf16x8*)(Vl + (32 * d) * 72 + 48), o[d]); }
        }
        if (kt + 1 < ntile) ATT_WRITE((kt + 1) & 1, (kt + 1) & 1);
        __syncthreads();
    }
    l_reg = half_swap_add(l_reg);
    if (hi == 0) al[c32] = 1.f / l_reg;
    LDS_WAIT();
    { LAS bf16_t* ot = (LAS bf16_t*)(C.lds + wave * 8704);
#pragma unroll
      for (int r = 0; r < 16; ++r) { const float il = al[crow(r, hi)];
#pragma unroll
          for (int d = 0; d < 4; ++d) ot[crow(r, hi) * 136 + 32 * d + c32] = f2bf(o[d][r] * il); }
      LDS_WAIT();
#pragma unroll
      for (int i = 0; i < 8; ++i) { const int ch = i * 64 + lane, row = ch >> 4, c16 = ch & 15;
          *(u32x4*)(Og + (size_t)(qw + row) * 2048 + 8 * c16) = *(const LAS u32x4*)(ot + row * 136 + 8 * c16); } }
    LDS_WAIT();
    __syncthreads();
#undef ATT_MAXCHK
#undef ATT_RESC_PA
#undef ATT_LOAD
#undef ATT_WRITE
}
__device__ __forceinline__ void phase_attention(const Ctx& C) {
    const int grp = (C.wg >> 3) % 3;
    for (int p = C.wg; p < NBATCH * MLA_H * 8; p += C.nwg) {
        const int bh = p >> 3, j = p & 7;
#pragma unroll 1
        for (int slot = 0; slot < 3; ++slot) {
            if (slot == grp && p == C.wg) expert_weights_range(C, EXP_P1_END, EXP_N_ALL, C.wg, C.nwg);
            if (slot < 2) attn_block(C, bh >> 4, bh & 15, slot == 0 ? 15 - j : j);
        }
    }
}
__device__ __forceinline__ void phase_moe_scatter(const Ctx& C) {
    const int* cnt = (const int*)(C.ws + WS_CNT); const int* rte = (const int*)(C.ws + WS_RTE);
    int* rtrow = (int*)(C.ws + WS_RTROW); int* tab = (int*)(C.ws + WS_MOETAB);
    LAS int* sh = (LAS int*)C.lds;
    const int tid = C.tid, lane = C.lane, wave = C.wave, rows_per_wg = T / C.nwg;
    if (wave == 0) {
        int tot = 0, pre = 0;
        if (C.nwg == 256) { int cv[32];
#pragma unroll
            for (int j = 0; j < 32; ++j) cv[j] = cnt[((lane >> 3) + 8 * j) * 8 + (lane & 7)];
#pragma unroll
            for (int j = 0; j < 32; ++j) { const int w = (lane >> 3) + 8 * j; if (w < C.wg) pre += cv[j]; tot += cv[j]; }
        } else for (int w = lane >> 3; w < C.nwg; w += 8) { const int c = cnt[w * 8 + (lane & 7)]; if (w < C.wg) pre += c; tot += c; }
        tot += __shfl_xor(tot, 8); tot += __shfl_xor(tot, 16); tot += __shfl_xor(tot, 32);
        pre += __shfl_xor(pre, 8); pre += __shfl_xor(pre, 16); pre += __shfl_xor(pre, 32);
        int start = 0, nrt = 0;
        for (int e = 0; e < 8; ++e) { const int te = __shfl(tot, e); if (e < lane) start += (te + 255) & ~255; nrt += (te + 255) >> 8; }
        if (lane < 8) { sh[lane] = start + pre; sh[8 + lane] = tot; sh[16 + lane] = start; }
        if (C.wg == 0 && lane < 8) { tab[lane] = start >> 8; tab[8 + lane] = (tot + 255) >> 8; }
        if (C.wg == 0 && lane == 0) tab[16] = nrt;
    }
    __syncthreads();
    if (wave == 0) {
        const int tl = lane >> 1, t = C.wg * rows_per_wg + tl; const int e = (tl < rows_per_wg) ? rte[2 * t + (lane & 1)] : -1;
        int rank = 0;
#pragma unroll
        for (int q = 0; q < 8; ++q) { const unsigned long long mk = __ballot(e == q); if (e == q) rank = __popcll(mk & ((1ull << lane) - 1ull)); }
        const int row = (e >= 0) ? sh[e] + rank : 0;
        if (e >= 0) rtrow[2 * t + (lane & 1)] = row;
        sh[32 + lane] = row;
    }
    __syncthreads();
    int* rowtok = (int*)(C.ws + WS_ROWTOK);
    if (tid < 2 * rows_per_wg) rowtok[sh[32 + tid]] = C.wg * rows_per_wg + (tid >> 1);
    if (C.wg < 8) { const int tot = sh[8 + C.wg], start = sh[16 + C.wg], r0 = start + tot, r1 = start + ((tot + 255) & ~255);
        for (int r = r0 + tid; r < r1; r += NTHR) rowtok[r] = T; }
    if (C.wg == 8 && tid < 128) ((u32x4*)(C.ws + WS_H + (size_t)T * D))[tid] = (u32x4){0u, 0u, 0u, 0u};
    __syncthreads();
}
constexpr int MOE_TOKS_OFF = 131072;
__device__ __forceinline__ const LAS int* moe_build_list(const Ctx& C, int npn, bool with_toks, bool split = false) {
    LAS int* t = (LAS int*)(C.lds + LDSCTL_OFF + 64); LAS int* list = (LAS int*)(C.lds + LDSCTL_OFF + 160);
    if (C.tid < 17) t[C.tid] = __hip_atomic_load((const int*)(C.ws + WS_MOETAB) + C.tid, __ATOMIC_RELAXED, __HIP_MEMORY_SCOPE_AGENT);
    __syncthreads();
    if (C.tid < 32) { int w = pg8::moe_unit_word(t, npn, C.nwg, C.wg, C.tid);
        if (split) { const int nfull = (t[16] * npn) / C.nwg; if (C.tid >= nfull) w = -1;
            if (C.tid == 31) { const int left = t[16] * npn - nfull * C.nwg, x = C.wg & 7, m = (C.wg >> 3) & 7, l = x + 8 * m; w = (l < left) ? pg8::moe_unit_word(t, npn, C.nwg, l, nfull) : -1; } }
        list[C.tid] = w; }
    __syncthreads();
    if (with_toks) { LAS int* toks = (LAS int*)(C.lds + MOE_TOKS_OFF); const int* rowtok = (const int*)(C.ws + WS_ROWTOK);
        if (C.tid < 256) { int tv[16];
#pragma unroll
            for (int i = 0; i < 16; ++i) { const int w = list[i]; tv[i] = rowtok[((w < 0 ? 0 : w) & 255) * 256 + C.tid]; }
#pragma unroll
            for (int i = 0; i < 16; ++i) toks[i * 256 + C.tid] = tv[i] * D; }
        __syncthreads(); }
    return list;
}
__device__ __forceinline__ void phase_moe_combine(const Ctx& C) {
    const bf16_t* x3 = (const bf16_t*)(C.ws + WS_X1); const bf16_t* OE = (const bf16_t*)(C.ws + WS_OE);
    const int* rtrow = (const int*)(C.ws + WS_RTROW); const float* rtw = (const float*)(C.ws + WS_RTW);
    const int gw = C.wg * NWAVES + C.wave, NGW = C.nwg * NWAVES, lane = C.lane;
    for (int t = gw; t < T; t += NGW) {
        const int r1 = rtrow[2 * t], r2 = rtrow[2 * t + 1]; const float w1 = rtw[2 * t], w2 = rtw[2 * t + 1];
        const u32x4* a = (const u32x4*)(OE + (size_t)r1 * D); const u32x4* b = (const u32x4*)(OE + (size_t)r2 * D);
        const u32x4* xr = (const u32x4*)(x3 + (size_t)t * D); f32x4* orow = (f32x4*)(C.out + (size_t)t * D);
#pragma unroll
        for (int j = 0; j < 4; ++j) { const int c = lane + 64 * j; const u32x4 av = a[c], bv = b[c]; const u32x4 xz = xr[c]; const f32x4 x0 = {bflo(xz.x), bfhi(xz.x), bflo(xz.y), bfhi(xz.y)}, x1 = {bflo(xz.z), bfhi(xz.z), bflo(xz.w), bfhi(xz.w)};
            f32x4 o0, o1;
            o0[0] = x0[0] + w1 * bflo(av.x) + w2 * bflo(bv.x); o0[1] = x0[1] + w1 * bfhi(av.x) + w2 * bfhi(bv.x); o0[2] = x0[2] + w1 * bflo(av.y) + w2 * bflo(bv.y); o0[3] = x0[3] + w1 * bfhi(av.y) + w2 * bfhi(bv.y);
            o1[0] = x1[0] + w1 * bflo(av.z) + w2 * bflo(bv.z); o1[1] = x1[1] + w1 * bfhi(av.z) + w2 * bfhi(bv.z); o1[2] = x1[2] + w1 * bflo(av.w) + w2 * bflo(bv.w); o1[3] = x1[3] + w1 * bfhi(av.w) + w2 * bfhi(bv.w);
            orow[2 * c] = o0; orow[2 * c + 1] = o1; }
    }
}

constexpr int NPHASE = 18;
struct Args { const void* in[27]; float* out; unsigned char* ws; int ph_lo, ph_hi; };
static_assert(sizeof(Args) == 27 * 8 + 8 + 8 + 8, "Args has no padding");

__global__ void __launch_bounds__(NTHR, 2) fwd_kernel(Args args) {
    extern __shared__ __attribute__((aligned(16))) unsigned char lds_raw[];
    Ctx C;
    C.lds = (LAS unsigned char*)lds_raw;
    C.tid = threadIdx.x; C.lane = C.tid & 63; C.wave = __builtin_amdgcn_readfirstlane(C.tid >> 6);
    C.nwg = gridDim.x; C.wg = blockIdx.x;
    C.x = (const float*)args.in[0]; C.pos = (const int*)args.in[1]; C.g_mix = (const float*)args.in[2]; C.g_ffn = (const float*)args.in[3]; C.w_in = (const float*)args.in[4];
    C.conv_w = (const float*)args.in[5]; C.b_gates = (const float*)args.in[6]; C.g_mo = (const float*)args.in[7]; C.g_ro = (const float*)args.in[8]; C.w_mix_out = (const float*)args.in[9];
    C.ffn_gate = (const float*)args.in[10]; C.ffn_up = (const float*)args.in[11]; C.ffn_down = (const float*)args.in[12]; C.w_dqkv = (const float*)args.in[13]; C.g_cq = (const float*)args.in[14];
    C.g_ckv = (const float*)args.in[15]; C.w_uq = (const float*)args.in[16]; C.w_ukv = (const float*)args.in[17]; C.g_qn = (const float*)args.in[18]; C.g_qr = (const float*)args.in[19];
    C.g_kn = (const float*)args.in[20]; C.g_kr = (const float*)args.in[21]; C.w_o = (const float*)args.in[22]; C.w_router = (const float*)args.in[23]; C.we_gate = (const float*)args.in[24];
    C.we_up = (const float*)args.in[25]; C.we_down = (const float*)args.in[26];
    C.out = args.out; C.ws = args.ws;
    unsigned char* ws = args.ws;
    volatile LAS unsigned* MISC = (volatile LAS unsigned*)(C.lds + MISC_OFF);
    for (int u = C.tid; u < (LDS_BYTES - LDSCTL_OFF) / 4; u += NTHR) ((LAS unsigned*)(C.lds + LDSCTL_OFF))[u] = 0u;
    __syncthreads();
    const int lo = args.ph_lo, hi = args.ph_hi;
    unsigned* barw = (unsigned*)(ws + WS_CTL) + CW_BAR;
    XcdBarrier bar; bar.bar = barw; bar.x = 0; bar.st = nullptr;
    if (hi - lo > 1) bar = xcd_barrier_post(barw, MISC + 8);
#ifdef ONLY_PHASE
#define IN(k) ((k) == ONLY_PHASE && lo <= (k) && (k) < hi)
#else
#define IN(k) (lo <= (k) && (k) < hi)
#endif
#define SEAM(k) do { if (IN(k) && IN((k) + 1)) xcd_barrier(bar); } while (0)
#ifdef PROBE_DUP
#define REPS(k) (((k) == PROBE_DUP) ? 2 : 1)
#else
#define REPS(k) 1
#endif
    bf16_t* Hn = (bf16_t*)(ws + WS_H);
    float* X1 = (float*)(ws + WS_X1); float* X2 = (float*)(ws + WS_X2);

    float* RSQ_X1 = (float*)(ws + WS_RSQ_X1); float* RSQ_X2 = (float*)(ws + WS_RSQ_X2); float* RSQ_CQ = (float*)(ws + WS_RSQ_CQ); float* RSQ_CKV = (float*)(ws + WS_RSQ_CKV);
    if (IN(0)) for (int rep_ = 0; rep_ < REPS(0); ++rep_) { phase_prologue(C); __syncthreads(); phase_norm<1>(C, C.x, C.g_mix, Hn, C.w_in + 4096, IN_COLS); } SEAM(0);
    if (IN(1)) for (int rep_ = 0; rep_ < REPS(1); ++rep_) { if (C.wg < 8) mlstm_scalar_scan(C, C.wg);
        pg8::Gemm g{Hn, (const bf16_t*)(ws + WS_WIN), D, D, D}; pg8::StaticOrder S; S.init(T, 8192, C.nwg, C.wg);
        pg8::EpiZ E{(bf16_t*)(ws + WS_Z), 8192, (const float*)(ws + WS_ROPER)};
        const int grp = (C.wg >> 3) & 3;
        { pg8::RangeOrder R{S, 0, grp}; pg8::gemm_phase<pg8::EpiZ, pg8::RangeOrder>(C.lds, g, R, E); }
        dense_weights_to_bf16(C, DI_WIN, DI_TOTAL); expert_weights_range(C, EXP_N_ALL, EXP_N_TOTAL2, C.wg, C.nwg); expert_weights_range(C, EXP_TAIL_END, EXP_P1_END, C.wg, C.nwg);
        { pg8::RangeOrder R{S, grp, 1 << 30}; pg8::gemm_phase<pg8::EpiZ, pg8::RangeOrder>(C.lds, g, R, E); } } SEAM(1);
    if (IN(2)) for (int rep_ = 0; rep_ < REPS(2); ++rep_) { phase_contrib(C); } SEAM(2);
    if (IN(3)) for (int rep_ = 0; rep_ < REPS(3); ++rep_) { phase_scan(C); } SEAM(3);
    if (IN(4)) for (int rep_ = 0; rep_ < REPS(4); ++rep_) { phase_mixout(C); } SEAM(4);
    if (IN(5)) for (int rep_ = 0; rep_ < REPS(5); ++rep_) { pg8::Gemm g{(const bf16_t*)(ws + WS_MIX), (const bf16_t*)(ws + WS_WOUT), D, D, D}; pg8::StaticOrder S; S.init(T, D, C.nwg, C.wg);
        pg8::EpiResNorm<true, true> E{(bf16_t*)X1, D, C.x, Hn, C.g_ffn, RSQ_X1}; pg8::gemm_phase<pg8::EpiResNorm<true, true>, pg8::StaticOrder>(C.lds, g, S, E); } SEAM(5);
    if (IN(6)) for (int rep_ = 0; rep_ < REPS(6); ++rep_) { pg8::Gemm g{Hn, (const bf16_t*)(ws + WS_WGU), D / 2, D / 2, D / 2}; pg8::StaticOrder S; S.init(T, 2 * DFF, C.nwg, C.wg);
        pg8::EpiSwiGLUScaled8 E{ws + WS_ACT, DFF, RSQ_X1, 1.f / D, EPS}; pg8::gemm_phase<pg8::EpiSwiGLUScaled8, pg8::StaticOrder, true, true, true>(C.lds, g, S, E);
        if (C.nwg == 256 && C.wg >= 128) expert_weights_range(C, 0, EXP_TAIL7, C.wg - 128, 128); else if (C.nwg != 256) expert_weights_range(C, 0, EXP_TAIL7, C.wg, C.nwg); } SEAM(6);
    if (IN(7)) for (int rep_ = 0; rep_ < REPS(7); ++rep_) { pg8::Gemm g{(const bf16_t*)(ws + WS_ACT), (const bf16_t*)(ws + WS_WD), DFF / 2, DFF / 2, DFF / 2}; pg8::StaticOrder S; S.init(T, D, C.nwg, C.wg);
        pg8::EpiResNorm<false> E{(bf16_t*)X2, D, X1, Hn, C.g_mix + D, RSQ_X2}; pg8::gemm_phase<pg8::EpiResNorm<false>, pg8::StaticOrder, true, true, true>(C.lds, g, S, E); } SEAM(7);
    if (IN(8)) for (int rep_ = 0; rep_ < REPS(8); ++rep_) { pg8::Gemm g{Hn, (const bf16_t*)(ws + WS_WDQKV), D, D, D}; pg8::StaticOrder S; S.init(T, NDQKV, C.nwg, C.wg);
        pg8::EpiLatent E{(bf16_t*)(ws + WS_CQKVN), (float*)(ws + WS_KR), RSQ_X2, RSQ_CQ, RSQ_CKV, C.g_cq, C.g_ckv, 1.f / D, EPS}; pg8::gemm_phase<pg8::EpiLatent, pg8::StaticOrder>(C.lds, g, S, E);
        if (C.nwg == 256 && C.wg >= 160) expert_weights_range(C, EXP_TAIL7, EXP_TAIL7 + EXP_TAIL9, C.wg - 160, 96); else if (C.nwg != 256) expert_weights_range(C, EXP_TAIL7, EXP_TAIL7 + EXP_TAIL9, C.wg, C.nwg); } SEAM(8);
    if (IN(9)) for (int rep_ = 0; rep_ < REPS(9); ++rep_) { phase_kr_prep(C); pg8::Gemm g{(const bf16_t*)(ws + WS_CQKVN), (const bf16_t*)(ws + WS_WUQKV), 512, 1024, 512}; pg8::DualOrder S; S.init(T, 7168, C.nwg, C.wg);
        pg8::EpiBf16Dual E{(bf16_t*)(ws + WS_QKVR), 7168, RSQ_CQ, RSQ_CKV, 1.f / 512.f, EPS, (bf16_t*)(ws + WS_VT), SEQ}; pg8::gemm_phase<pg8::EpiBf16Dual, pg8::DualOrder>(C.lds, g, S, E);
        if (C.nwg == 256 && C.wg >= 128) expert_weights_range(C, EXP_TAIL7 + EXP_TAIL9, EXP_TAIL_END, C.wg - 128, 128); else if (C.nwg != 256) expert_weights_range(C, EXP_TAIL7 + EXP_TAIL9, EXP_TAIL_END, C.wg, C.nwg); } SEAM(9);
    if (IN(11)) for (int rep_ = 0; rep_ < REPS(11); ++rep_) { phase_attention(C); } SEAM(11);
    if (IN(12)) for (int rep_ = 0; rep_ < REPS(12); ++rep_) { pg8::Gemm g{(const bf16_t*)(ws + WS_AO), (const bf16_t*)(ws + WS_WO), D, D, D}; pg8::StaticOrder S; S.init(T, D, C.nwg, C.wg);
        pg8::EpiF32 E{(bf16_t*)X1, D, (const bf16_t*)X2}; pg8::gemm_phase<pg8::EpiF32, pg8::StaticOrder>(C.lds, g, S, E); } SEAM(12);
    if (IN(13)) for (int rep_ = 0; rep_ < REPS(13); ++rep_) { phase_norm<2>(C, X1, C.g_ffn + D, Hn, C.w_router, 8); } SEAM(13);
    if (IN(14)) for (int rep_ = 0; rep_ < REPS(14); ++rep_) { phase_moe_scatter(C); } SEAM(14);
    if (IN(15)) for (int rep_ = 0; rep_ < REPS(15); ++rep_) { const LAS int* list = moe_build_list(C, 2 * DFF / 256, true);
        pg8::Gemm g{(const bf16_t*)(ws + WS_H), (const bf16_t*)(ws + WS_WEGU), D / 2, D / 2, D / 2}; pg8::MoeOrder S{list, 2 * DFF / 256, (const LAS int*)(C.lds + MOE_TOKS_OFF)};
        pg8::EpiSwiGLU8 E{ws + WS_ACTE, DFF}; pg8::gemm_phase<pg8::EpiSwiGLU8, pg8::MoeOrder, true, true, true, true>(C.lds, g, S, E); } SEAM(15);
    if (IN(16)) for (int rep_ = 0; rep_ < REPS(16); ++rep_) { const bool split = (C.nwg == 256); const LAS int* list = moe_build_list(C, D / 256, false, split);
        pg8::Gemm g{(const bf16_t*)(ws + WS_ACTE), (const bf16_t*)(ws + WS_WED), DFF / 2, DFF / 2, DFF / 2}; pg8::MoeOrder S{list, D / 256, (const LAS int*)(C.lds + MOE_TOKS_OFF)};
        pg8::EpiBf16 E{(bf16_t*)(ws + WS_OE), D}; pg8::gemm_phase<pg8::EpiBf16, pg8::MoeOrder, true, true, true>(C.lds, g, S, E);
        if (split) {
            const int w = __builtin_amdgcn_readfirstlane(list[31]);
            if (w >= 0) { const int rt = w & 255, pnl = (w >> 8) & 255, e = w >> 16, sl = C.wg >> 6, l = (C.wg & 7) + 8 * ((C.wg >> 3) & 7);
                const int koff = sl < 2 ? sl * 1536 : 3072 + (sl - 2) * 1280, kt = sl < 2 ? 12 : 10;
                pg8::Gemm g2{(const bf16_t*)(ws + WS_ACTE + koff), (const bf16_t*)(ws + WS_WED + koff), kt * 64, DFF / 2, DFF / 2};
                pg8::OneUnit S2{pg8::Unit{rt, e * (D / 256) + pnl, pnl, 0}, true};
                pg8::EpiSplitK E2{(bf16_t*)(ws + WS_OE), D, (float*)(ws + WS_SPLITK) + (size_t)l * (3 * 32 * 512 * 4), (unsigned*)(ws + WS_CTL) + CW_SPLITK + 16 * l, sl};
                pg8::gemm_phase<pg8::EpiSplitK, pg8::OneUnit, true, true, true>(C.lds, g2, S2, E2); } } } SEAM(16);
    if (IN(17)) for (int rep_ = 0; rep_ < REPS(17); ++rep_) { phase_moe_combine(C); }
#undef IN
#undef SEAM
}

extern "C" void kernel_launch(void* const* d_in, const int* in_sizes, int n_in, void* d_out, int out_size, void* d_ws, size_t ws_size, hipStream_t stream) {
    static int grid = 0;
    if (grid == 0) {
        if (n_in != 27 || out_size != T * D || ws_size < WS_END) { fprintf(stderr, "kernel_launch: unexpected problem (n_in %d, out %d, ws %zu < %zu)\n", n_in, out_size, ws_size, (size_t)WS_END); grid = -1; return; }
        int dev = 0, cus = 0;
        if (hipGetDevice(&dev) != hipSuccess || hipDeviceGetAttribute(&cus, hipDeviceAttributeMultiprocessorCount, dev) != hipSuccess) { grid = -1; return; }
        if (hipFuncSetAttribute((const void*)fwd_kernel, hipFuncAttributeMaxDynamicSharedMemorySize, LDS_BYTES) != hipSuccess) { fprintf(stderr, "kernel_launch: hipFuncSetAttribute failed\n"); grid = -1; return; }
        int per_cu = 0;
        if (hipOccupancyMaxActiveBlocksPerMultiprocessor(&per_cu, (const void*)fwd_kernel, NTHR, LDS_BYTES) != hipSuccess || per_cu < 1) fprintf(stderr, "kernel_launch: occupancy query reports %d\n", per_cu);
        (void)hipGetLastError();
        grid = 256;
        if (cus < 256) { fprintf(stderr, "kernel_launch: device has %d CUs, need 256\n", cus); grid = -1; return; }
    }
    if (grid < 0) return;
    if (hipMemsetAsync((char*)d_ws + WS_CTL, 0, CTL_ZERO_BYTES, stream) != hipSuccess) return;
    Args a{};
    for (int i = 0; i < 27; ++i) a.in[i] = d_in[i];
    a.out = (float*)d_out; a.ws = (unsigned char*)d_ws;
#if MK_ONE_LAUNCH
    a.ph_lo = 0; a.ph_hi = NPHASE;
    hipLaunchKernelGGL(fwd_kernel, dim3(grid), dim3(NTHR), LDS_BYTES, stream, a);
#else
    for (int ph = 0; ph < NPHASE; ++ph) { a.ph_lo = ph; a.ph_hi = ph + 1; hipLaunchKernelGGL(fwd_kernel, dim3(grid), dim3(NTHR), LDS_BYTES, stream, a); }
#endif
}
```

```cpp
#include <hip/hip_runtime.h>
#include <cstdio>
#include <cstdint>

#ifndef MK_ONE_LAUNCH
#define MK_ONE_LAUNCH 1
#endif

#define LAS __attribute__((address_space(3)))
#define GAS __attribute__((address_space(1)))
typedef unsigned short bf16_t;
typedef short bf16x8 __attribute__((ext_vector_type(8)));
typedef float f32x2 __attribute__((ext_vector_type(2)));
typedef float f32x4 __attribute__((ext_vector_type(4)));
typedef float f32x16 __attribute__((ext_vector_type(16)));
typedef unsigned u32x4 __attribute__((ext_vector_type(4)));
typedef unsigned u32x2 __attribute__((ext_vector_type(2)));

constexpr int T = 8192, SEQ = 4096, NBATCH = 2, D = 2048, DFF = 5632;
constexpr int IN_COLS = 8200, NEXP = 8;
constexpr int HM = 4, DH = 256;
constexpr int LM = 128, NCM = SEQ / LM;
constexpr int LR = 128, NCR = SEQ / LR;
constexpr int MLA_H = 16, QLORA = 512, KVLORA = 512, NOPE = 128, ROPE = 64, VH = 128, QKD = NOPE + ROPE;
constexpr int NDQKV = 1280;
constexpr float EPS = 1e-6f;
constexpr int MOE_ROWS = 18432;
constexpr int MOE_MAXRT = 72;

constexpr size_t MiB = 1u << 20;
constexpr size_t WS_CTL = 0, CTL_ZERO_BYTES = 128 * 1024;
constexpr size_t WS_SMALL = 1 * MiB;
constexpr size_t WS_ROPER = WS_SMALL;
constexpr size_t WS_ROPEM = WS_ROPER + 8 * MiB;
constexpr size_t WS_GI    = WS_ROPEM + 2 * MiB;
constexpr size_t WS_GF    = WS_GI + 128 * 1024;
constexpr size_t WS_BC    = WS_GF + 128 * 1024;
constexpr size_t WS_WL    = WS_BC + 128 * 1024;
constexpr size_t WS_MPREV = WS_WL + 128 * 1024;
constexpr size_t WS_DEC   = WS_MPREV + 4096;
constexpr size_t WS_UN    = WS_DEC + 4096;
constexpr size_t WS_RTE   = WS_UN + 512 * 1024;
constexpr size_t WS_RTW   = WS_RTE + 64 * 1024;
constexpr size_t WS_RTROW = WS_RTW + 64 * 1024;
constexpr size_t WS_CNT   = WS_RTROW + 64 * 1024;
constexpr size_t WS_MOETAB = WS_CNT + 8192;
constexpr size_t WS_KR    = WS_MOETAB + 4096;
constexpr size_t WS_RSQ_X1 = WS_KR + 2 * MiB;
constexpr size_t WS_RSQ_X2 = WS_RSQ_X1 + 256 * 1024;
constexpr size_t WS_RSQ_CQ = WS_RSQ_X2 + 256 * 1024;
constexpr size_t WS_RSQ_CKV = WS_RSQ_CQ + 64 * 1024;
constexpr size_t WS_ROWTOK = WS_RSQ_CKV + 64 * 1024;
static_assert(WS_ROWTOK + 18432 * 4 <= 16 * MiB, "small tables");
constexpr size_t WS_WIN   = 16 * MiB;
constexpr size_t WS_WOUT  = WS_WIN + 32 * MiB;
constexpr size_t WS_WGU   = WS_WOUT + 8 * MiB;
constexpr size_t WS_WD    = WS_WGU + 44 * MiB;
constexpr size_t WS_WDQKV = WS_WD + 22 * MiB;
constexpr size_t WS_WUQKV = WS_WDQKV + 5 * MiB;
constexpr size_t WS_WO    = WS_WUQKV + 7 * MiB;
constexpr size_t WS_WEGU  = WS_WO + 8 * MiB;
constexpr size_t WS_WED   = WS_WEGU + 176 * MiB;
constexpr size_t WS_H     = WS_WED + 88 * MiB;
constexpr size_t WS_X1    = WS_H + 32 * MiB;
constexpr size_t WS_X2    = WS_X1 + 64 * MiB;
constexpr size_t WS_OV    = WS_X2 + 64 * MiB;
constexpr size_t WS_Z     = WS_OV;
constexpr size_t WS_QKC   = WS_Z + 128 * MiB;
constexpr size_t WS_STM   = WS_QKC + 64 * MiB;
constexpr size_t WS_STR   = WS_STM + 64 * MiB;
constexpr size_t WS_MIX   = WS_STR + 32 * MiB;
constexpr size_t WS_ACT   = WS_MIX + 32 * MiB;
constexpr size_t WS_L0END = WS_ACT + 88 * MiB;
constexpr size_t WS_CQKV  = WS_OV;
constexpr size_t WS_CQKVN = WS_CQKV + 40 * MiB;
constexpr size_t WS_QKVR  = WS_CQKVN + 16 * MiB;
constexpr size_t WS_QA    = WS_QKVR + 112 * MiB;
constexpr size_t WS_KA    = WS_QA + 48 * MiB;
constexpr size_t WS_VT    = WS_KA + 48 * MiB;
constexpr size_t WS_AO    = WS_VT + 32 * MiB;
constexpr size_t WS_L1AEND = WS_AO + 32 * MiB;
constexpr size_t WS_HPERM = WS_OV;
constexpr size_t WS_ACTE  = WS_HPERM + 36 * MiB;
constexpr size_t WS_OE    = WS_ACTE + 99 * MiB;
constexpr size_t WS_SPLITK = WS_OE + 72 * MiB;
constexpr size_t WS_L1BEND = WS_SPLITK + 48 * MiB;
constexpr size_t WS_END = (WS_L0END > WS_L1AEND ? (WS_L0END > WS_L1BEND ? WS_L0END : WS_L1BEND) : (WS_L1AEND > WS_L1BEND ? WS_L1AEND : WS_L1BEND));
static_assert(WS_END <= (size_t)1400 * MiB, "d_ws map must stay under the guaranteed workspace size");

constexpr int CW_TMO = 0;
constexpr int CW_BAR = 4096;
constexpr int CW_SPLITK = 16384;
constexpr int RING_BYTES = 131072;
constexpr int LDSCTL_OFF = 155648, MISC_OFF = LDSCTL_OFF + 320;
constexpr int LDS_BYTES = LDSCTL_OFF + 1024;
constexpr int NWAVES = 8, NTHR = 512;

__device__ __forceinline__ unsigned cvt_pk_bf16(float lo, float hi) { unsigned r; asm volatile("v_cvt_pk_bf16_f32 %0, %1, %2" : "=v"(r) : "v"(lo), "v"(hi)); return r; }
__device__ __forceinline__ bf16_t f2bf(float f) { return (bf16_t)(cvt_pk_bf16(f, 0.f) & 0xffffu); }
__device__ __forceinline__ float bf2f(bf16_t b) { return __uint_as_float(((unsigned)b) << 16); }
__device__ __forceinline__ float bflo(unsigned w) { return __uint_as_float(w << 16); }
__device__ __forceinline__ float bfhi(unsigned w) { return __uint_as_float(w & 0xffff0000u); }
template <int CTRL> __device__ __forceinline__ float dpp_mov(float v) { return __builtin_bit_cast(float, __builtin_amdgcn_update_dpp(0, __builtin_bit_cast(int, v), CTRL, 0xf, 0xf, true)); }
__device__ __forceinline__ float half32_add(float v) { auto rr = __builtin_amdgcn_permlane32_swap(__float_as_uint(v), __float_as_uint(v), false, false); return __uint_as_float(rr[0]) + __uint_as_float(rr[1]); }
__device__ __forceinline__ float half32_max(float v) { auto rr = __builtin_amdgcn_permlane32_swap(__float_as_uint(v), __float_as_uint(v), false, false); return fmaxf(__uint_as_float(rr[0]), __uint_as_float(rr[1])); }
__device__ __forceinline__ float row16_sum(float v) { v += dpp_mov<0xB1>(v); v += dpp_mov<0x4E>(v); v += dpp_mov<0x141>(v); v += dpp_mov<0x140>(v); return v; }
__device__ __forceinline__ float wave_sum(float v) { v = row16_sum(v); v += __shfl_xor(v, 16); return half32_add(v); }
__device__ __forceinline__ float wave_max(float v) {
    v = fmaxf(v, dpp_mov<0xB1>(v)); v = fmaxf(v, dpp_mov<0x4E>(v)); v = fmaxf(v, dpp_mov<0x141>(v)); v = fmaxf(v, dpp_mov<0x140>(v));
    v = fmaxf(v, __shfl_xor(v, 16)); return half32_max(v);
}
__device__ __forceinline__ float silu_f(float x) { return x * __builtin_amdgcn_rcpf(1.f + __expf(-x)); }
__device__ __forceinline__ float sigmoid_f(float x) { return __builtin_amdgcn_rcpf(1.f + __expf(-x)); }
__device__ __forceinline__ float q8f(float x, float sc, float isc) { const int w = __builtin_amdgcn_cvt_pk_fp8_f32(x * sc, 0.f, 0, false); return __builtin_amdgcn_cvt_f32_fp8(w, 0) * isc; }
typedef int i32x8 __attribute__((ext_vector_type(8)));
typedef int i32x4 __attribute__((ext_vector_type(4)));
__device__ __forceinline__ unsigned pk4_fp8(float a, float b, float c, float d) { int w = __builtin_amdgcn_cvt_pk_fp8_f32(a, b, 0, false); w = __builtin_amdgcn_cvt_pk_fp8_f32(c, d, w, true); return (unsigned)w; }
constexpr float W8_SCALE = 64.f;
#ifndef FP8_EMU
#define FP8_EMU 0
#endif
#define LDS_WAIT() asm volatile("s_waitcnt lgkmcnt(0)" ::: "memory")
#define VM_WAIT() asm volatile("s_waitcnt vmcnt(0)" ::: "memory")
namespace pg8 {
#define PG8_LAS __attribute__((address_space(3)))
constexpr int BM = 256, BK = 64, HALF = 128, HTB = HALF * BK * 2, STAGE_BYTES = 8 * HTB, NXCD = 8, WGM = 8;

__host__ __device__ __forceinline__ int lds_byte(int r, int c) { const int st = (r >> 4) * 2 + (c >> 5), rr = r & 15, cc = c & 31, ob = rr * 64 + cc * 2; return st * 1024 + (ob ^ (((ob >> 9) & 1) << 5)); }
__host__ __device__ __forceinline__ void stage_rc(int b, int& R, int& C) { const int st = b / 1024, sb = b % 1024, swz = sb ^ (((sb >> 9) & 1) << 5); R = (st >> 1) * 16 + swz / 64; C = (st & 1) * 32 + (swz % 64) / 2; }
__host__ __device__ __forceinline__ int perm32(int rho) { const int n = rho >> 4, i = rho & 15; return 8 * (i >> 2) + 4 * n + (i & 3); }

struct Unit { int pm, pn, pc, aoff; };
struct Gemm { const bf16_t* A; const bf16_t* Bt; int K, lda, ldb; };

struct StaticOrder {
    int nM, nN, nwg, G, c;
    __host__ __device__ void init(int M, int N, int G_, int c_) { nM = M / BM; nN = N / BM; nwg = nM * nN; G = G_; c = c_; }
    __host__ __device__ bool next(int i, Unit& u) const {
        const long L = (long)i * G + c; if (L >= nwg) return false;
        int wgid = (int)L; { const int q = nwg / NXCD, r = nwg % NXCD, xcd = wgid % NXCD, off = wgid / NXCD; wgid = (xcd < r ? xcd * (q + 1) : r * (q + 1) + (xcd - r) * q) + off; }
        const int nig = WGM * nN, gid = wgid / nig, fm = gid * WGM, gsz = (nM - fm) < WGM ? (nM - fm) : WGM;
        u.pm = fm + ((wgid % nig) % gsz); u.pn = (wgid % nig) / gsz; u.pc = u.pn; u.aoff = 0; return true;
    }
};
struct RangeOrder { StaticOrder S; int lo, hi;
    __device__ __forceinline__ bool next(int i, Unit& u) const { return (lo + i < hi) && S.next(lo + i, u); } };
struct DualOrder : StaticOrder {
    __device__ bool next(int i, Unit& u) const { if (!StaticOrder::next(i, u)) return false; u.aoff = (u.pn >= 12) ? 512 * 2 : 0; return true; }
};
__device__ __forceinline__ int moe_unit_word(const PG8_LAS int* tab, int npn, int G, int c, int i) {
    const int nu = tab[16] * npn; const long L = (long)i * G + c; if (L >= nu) return -1;
    int id = (int)L; { const int q = nu / NXCD, r = nu % NXCD, xcd = id % NXCD, off = id / NXCD; id = (xcd < r ? xcd * (q + 1) : r * (q + 1) + (xcd - r) * q) + off; }
    int e = 0, base = 0;
    for (int j = 0; j < 7; ++j) { const int n = tab[8 + e] * npn; if (id >= base + n) { base += n; ++e; } }
    int cnt = tab[8 + e]; if (cnt < 1) cnt = 1;
    const int rr = id - base; const int pnl = rr / cnt, rt = tab[e] + rr % cnt;
    return rt | (pnl << 8) | (e << 16);
}
struct MoeOrder {
    const PG8_LAS int* list; int npn; const PG8_LAS int* toks;
    __device__ __forceinline__ int rowoff(int i, int r) const { return toks[i * 256 + r]; }
    __device__ __forceinline__ bool next(int i, Unit& u) const {
        const int w = __builtin_amdgcn_readfirstlane(list[i]); if (w < 0) return false;
        const int rt = w & 255, pnl = (w >> 8) & 255, e = w >> 16;
        u.pm = rt; u.pn = e * npn + pnl; u.pc = pnl; u.aoff = 0; return true;
    }
};

struct EpiBf16 {
    static constexpr bool PERM = true, AFTER_DRAIN = false; static constexpr int NSTORES = 16;
    bf16_t* O; int ldc;
    __device__ __forceinline__ void operator()(const f32x4 (&acc)[2][2][4][2], const Unit& u, int wr, int wc, int fr, int fq) const {
        const int row0 = u.pm * BM + wr * 64 + fr, col0 = u.pc * BM + wc * 32 + 8 * fq;
#pragma unroll
        for (int ai = 0; ai < 2; ++ai)
#pragma unroll
            for (int m = 0; m < 4; ++m) { bf16_t* rowp = O + (size_t)(row0 + ai * HALF + m * 16) * ldc + col0;
#pragma unroll
                for (int bj = 0; bj < 2; ++bj) { const f32x4 v0 = acc[ai][bj][m][0], v1 = acc[ai][bj][m][1];
                    u32x4 w; w.x = cvt_pk_bf16(v0[0], v0[1]); w.y = cvt_pk_bf16(v0[2], v0[3]); w.z = cvt_pk_bf16(v1[0], v1[1]); w.w = cvt_pk_bf16(v1[2], v1[3]);
                    *(u32x4*)(rowp + bj * HALF) = w; } }
    }
};
struct EpiZ {
    static constexpr bool PERM = true, AFTER_DRAIN = false; static constexpr int NSTORES = 16;
    bf16_t* O; int ldc; const float* rope;
    __device__ __forceinline__ void operator()(const f32x4 (&acc)[2][2][4][2], const Unit& u, int wr, int wc, int fr, int fq) const {
        const int row0 = u.pm * BM + wr * 64 + fr, col0 = u.pc * BM + wc * 32 + 8 * fq;
        const bool rot = (u.pc >= 16) && (u.pc < 24); const float sc = (u.pc >= 20) ? 0.0625f : 1.f;
#pragma unroll
        for (int ai = 0; ai < 2; ++ai)
#pragma unroll
            for (int m = 0; m < 4; ++m) { const int row = row0 + ai * HALF + m * 16; bf16_t* rowp = O + (size_t)row * ldc + col0;
                f32x4 a0 = acc[ai][0][m][0], a1 = acc[ai][0][m][1], b0 = acc[ai][1][m][0], b1 = acc[ai][1][m][1];
                if (rot) { const f32x4* cp = (const f32x4*)(rope + ((size_t)row * 128 + wc * 32 + 8 * fq) * 2);
                    const f32x4 c0 = cp[0], c1 = cp[1], c2 = cp[2], c3 = cp[3];
                    const f32x4 C0 = {c0[0], c0[2], c1[0], c1[2]}, S0 = {c0[1], c0[3], c1[1], c1[3]}, C1 = {c2[0], c2[2], c3[0], c3[2]}, S1 = {c2[1], c2[3], c3[1], c3[3]};
                    const f32x4 y0 = (a0 * C0 - b0 * S0) * sc, z0 = (b0 * C0 + a0 * S0) * sc, y1 = (a1 * C1 - b1 * S1) * sc, z1 = (b1 * C1 + a1 * S1) * sc;
                    a0 = y0; b0 = z0; a1 = y1; b1 = z1; }
                u32x4 w; w.x = cvt_pk_bf16(a0[0], a0[1]); w.y = cvt_pk_bf16(a0[2], a0[3]); w.z = cvt_pk_bf16(a1[0], a1[1]); w.w = cvt_pk_bf16(a1[2], a1[3]);
                *(u32x4*)rowp = w;
                w.x = cvt_pk_bf16(b0[0], b0[1]); w.y = cvt_pk_bf16(b0[2], b0[3]); w.z = cvt_pk_bf16(b1[0], b1[1]); w.w = cvt_pk_bf16(b1[2], b1[3]);
                *(u32x4*)(rowp + HALF) = w; }
    }
};
template <bool Q8 = false> struct EpiSwiGLU {
    static constexpr bool PERM = true, AFTER_DRAIN = false; static constexpr int NSTORES = 8;
    bf16_t* O; int ldc;
    __device__ __forceinline__ void operator()(const f32x4 (&acc)[2][2][4][2], const Unit& u, int wr, int wc, int fr, int fq) const {
        const int row0 = u.pm * BM + wr * 64 + fr, col0 = u.pc * HALF + wc * 32 + 8 * fq;
#pragma unroll
        for (int ai = 0; ai < 2; ++ai)
#pragma unroll
            for (int m = 0; m < 4; ++m) { bf16_t* rowp = O + (size_t)(row0 + ai * HALF + m * 16) * ldc + col0;
                float o[8];
#pragma unroll
                for (int n = 0; n < 2; ++n)
#pragma unroll
                    for (int j = 0; j < 4; ++j) { const float g = acc[ai][0][m][n][j], up = acc[ai][1][m][n][j]; float ov = g * up * __builtin_amdgcn_rcpf(1.f + __expf(-g)); if (Q8) ov = q8f(ov, 1.f, 1.f); o[n * 4 + j] = ov; }
                u32x4 w; w.x = cvt_pk_bf16(o[0], o[1]); w.y = cvt_pk_bf16(o[2], o[3]); w.z = cvt_pk_bf16(o[4], o[5]); w.w = cvt_pk_bf16(o[6], o[7]);
                *(u32x4*)rowp = w; }
    }
};
struct EpiSwiGLU8 {
    static constexpr bool PERM = true, AFTER_DRAIN = false; static constexpr int NSTORES = 8;
    unsigned char* O; int ldc;
    __device__ __forceinline__ void operator()(const f32x4 (&acc)[2][2][4][2], const Unit& u, int wr, int wc, int fr, int fq) const {
        const int row0 = u.pm * BM + wr * 64 + fr, col0 = u.pc * HALF + wc * 32 + 8 * fq;
#pragma unroll
        for (int ai = 0; ai < 2; ++ai)
#pragma unroll
            for (int m = 0; m < 4; ++m) { unsigned char* rowp = O + (size_t)(row0 + ai * HALF + m * 16) * ldc + col0;
                float o[8];
#pragma unroll
                for (int n = 0; n < 2; ++n)
#pragma unroll
                    for (int j = 0; j < 4; ++j) { const float g = acc[ai][0][m][n][j], up = acc[ai][1][m][n][j]; o[n * 4 + j] = g * up * __builtin_amdgcn_rcpf(1.f + __expf(-g)); }
                *(u32x2*)rowp = (u32x2){pk4_fp8(o[0], o[1], o[2], o[3]), pk4_fp8(o[4], o[5], o[6], o[7])}; }
    }
};
struct EpiF32 {
    static constexpr bool PERM = true, AFTER_DRAIN = false; static constexpr int NSTORES = 16;
    bf16_t* C; int ldc; const bf16_t* res;
    __device__ __forceinline__ void operator()(const f32x4 (&acc)[2][2][4][2], const Unit& u, int wr, int wc, int fr, int fq) const {
        const int row0 = u.pm * BM + wr * 64 + fr, col0 = u.pc * BM + wc * 32 + 8 * fq;
#pragma unroll
        for (int ai = 0; ai < 2; ++ai)
#pragma unroll
            for (int m = 0; m < 4; ++m) { const size_t off = (size_t)(row0 + ai * HALF + m * 16) * ldc + col0;
#pragma unroll
                for (int bj = 0; bj < 2; ++bj) { f32x4 v0 = acc[ai][bj][m][0], v1 = acc[ai][bj][m][1]; const u32x4 rz = *(const u32x4*)(res + off + bj * HALF);
                    v0[0] += bflo(rz.x); v0[1] += bfhi(rz.x); v0[2] += bflo(rz.y); v0[3] += bfhi(rz.y); v1[0] += bflo(rz.z); v1[1] += bfhi(rz.z); v1[2] += bflo(rz.w); v1[3] += bfhi(rz.w);
                    *(u32x4*)(C + off + bj * HALF) = (u32x4){cvt_pk_bf16(v0[0], v0[1]), cvt_pk_bf16(v0[2], v0[3]), cvt_pk_bf16(v1[0], v1[1]), cvt_pk_bf16(v1[2], v1[3])}; } }
    }
};

__device__ __forceinline__ float fq_reduce(float s) { s += __shfl_xor(s, 16); return half32_add(s); }
__device__ __forceinline__ float slot_sum8(const float* p) { const f32x4 a = *(const f32x4*)p, b = *(const f32x4*)(p + 4); return ((a[0] + a[1]) + (a[2] + a[3])) + ((b[0] + b[1]) + (b[2] + b[3])); }
__device__ __forceinline__ void rowsq_publish(const float (&ss)[2][4], PG8_LAS unsigned char* lds, int pm, int wr, int wc, int fr, int fq, float* slot, int nslot, int sidx, bool active) {
    PG8_LAS float* P = (PG8_LAS float*)lds;
#pragma unroll
    for (int ai = 0; ai < 2; ++ai)
#pragma unroll
        for (int m = 0; m < 4; ++m) if (fq == 0) P[(ai * HALF + wr * 64 + m * 16 + fr) * 4 + wc] = ss[ai][m];
    asm volatile("s_waitcnt lgkmcnt(0)" ::: "memory"); __builtin_amdgcn_s_barrier(); asm volatile("" ::: "memory");
    const int row = threadIdx.x;
    if (row < 256 && active) { const f32x4 q = *(const PG8_LAS f32x4*)(P + row * 4); slot[(size_t)(pm * BM + row) * nslot + sidx] = (q[0] + q[1]) + (q[2] + q[3]); }
    asm volatile("s_waitcnt lgkmcnt(0)" ::: "memory"); __builtin_amdgcn_s_barrier(); asm volatile("" ::: "memory");
}
template <bool H8 = false, bool RF32 = false> struct EpiResNorm {
    static constexpr bool PERM = true, AFTER_DRAIN = true; static constexpr int NSTORES = 0;
    bf16_t* C; int ldc; const void* res; bf16_t* H; const float* gain; float* slot;
    __device__ __forceinline__ void fused(const f32x4 (&acc)[2][2][4][2], const Unit& u, int wr, int wc, int fr, int fq, PG8_LAS unsigned char* lds) const {
        const int row0 = u.pm * BM + wr * 64 + fr, col0 = u.pc * BM + wc * 32 + 8 * fq;
        f32x4 gv[2][2]; float ss[2][4];
#pragma unroll
        for (int bj = 0; bj < 2; ++bj)
#pragma unroll
            for (int n = 0; n < 2; ++n) gv[bj][n] = *(const f32x4*)(gain + col0 + bj * HALF + n * 4);
#pragma unroll
        for (int ai = 0; ai < 2; ++ai)
#pragma unroll
            for (int m = 0; m < 4; ++m) { const int row = row0 + ai * HALF + m * 16; const size_t off = (size_t)row * ldc + col0; float s = 0.f;
#pragma unroll
                for (int bj = 0; bj < 2; ++bj) { f32x4 v0 = acc[ai][bj][m][0], v1 = acc[ai][bj][m][1];
                    if (RF32) { v0 += *(const f32x4*)((const float*)res + off + bj * HALF); v1 += *(const f32x4*)((const float*)res + off + bj * HALF + 4); }
                    else { const u32x4 rz = *(const u32x4*)((const bf16_t*)res + off + bj * HALF);
                        v0[0] += bflo(rz.x); v0[1] += bfhi(rz.x); v0[2] += bflo(rz.y); v0[3] += bfhi(rz.y); v1[0] += bflo(rz.z); v1[1] += bfhi(rz.z); v1[2] += bflo(rz.w); v1[3] += bfhi(rz.w); }
                    *(u32x4*)(C + off + bj * HALF) = (u32x4){cvt_pk_bf16(v0[0], v0[1]), cvt_pk_bf16(v0[2], v0[3]), cvt_pk_bf16(v1[0], v1[1]), cvt_pk_bf16(v1[2], v1[3])};
                    s += ((v0[0] * v0[0] + v0[1] * v0[1]) + (v0[2] * v0[2] + v0[3] * v0[3])) + ((v1[0] * v1[0] + v1[1] * v1[1]) + (v1[2] * v1[2] + v1[3] * v1[3]));
                    const f32x4 h0 = v0 * gv[bj][0], h1 = v1 * gv[bj][1];
                    if (H8) *(u32x2*)((unsigned char*)H + off + bj * HALF) = (u32x2){pk4_fp8(h0[0], h0[1], h0[2], h0[3]), pk4_fp8(h1[0], h1[1], h1[2], h1[3])};
                    else *(u32x4*)(H + off + bj * HALF) = (u32x4){cvt_pk_bf16(h0[0], h0[1]), cvt_pk_bf16(h0[2], h0[3]), cvt_pk_bf16(h1[0], h1[1]), cvt_pk_bf16(h1[2], h1[3])}; }
                ss[ai][m] = fq_reduce(s); }
        rowsq_publish(ss, lds, u.pm, wr, wc, fr, fq, slot, 8, u.pc, true);
    }
};
struct EpiSwiGLUScaled {
    static constexpr bool PERM = true, AFTER_DRAIN = false; static constexpr int NSTORES = 8;
    bf16_t* O; int ldc; const float* slot; float inv_n, eps;
    __device__ __forceinline__ void operator()(const f32x4 (&acc)[2][2][4][2], const Unit& u, int wr, int wc, int fr, int fq) const {
        const int row0 = u.pm * BM + wr * 64 + fr, col0 = u.pc * HALF + wc * 32 + 8 * fq;
#pragma unroll
        for (int ai = 0; ai < 2; ++ai)
#pragma unroll
            for (int m = 0; m < 4; ++m) { const int row = row0 + ai * HALF + m * 16; bf16_t* rowp = O + (size_t)row * ldc + col0;
                const float rs = rsqrtf(slot_sum8(slot + (size_t)row * 8) * inv_n + eps); float o[8];
#pragma unroll
                for (int n = 0; n < 2; ++n)
#pragma unroll
                    for (int j = 0; j < 4; ++j) { const float g = acc[ai][0][m][n][j] * rs, up = acc[ai][1][m][n][j] * rs; o[n * 4 + j] = g * up * __builtin_amdgcn_rcpf(1.f + __expf(-g)); }
                u32x4 w; w.x = cvt_pk_bf16(o[0], o[1]); w.y = cvt_pk_bf16(o[2], o[3]); w.z = cvt_pk_bf16(o[4], o[5]); w.w = cvt_pk_bf16(o[6], o[7]);
                *(u32x4*)rowp = w; }
    }
};
struct EpiSwiGLUScaled8 {
    static constexpr bool PERM = true, AFTER_DRAIN = false; static constexpr int NSTORES = 8;
    unsigned char* O; int ldc; const float* slot; float inv_n, eps;
    __device__ __forceinline__ void operator()(const f32x4 (&acc)[2][2][4][2], const Unit& u, int wr, int wc, int fr, int fq) const {
        const int row0 = u.pm * BM + wr * 64 + fr, col0 = u.pc * HALF + wc * 32 + 8 * fq;
#pragma unroll
        for (int ai = 0; ai < 2; ++ai)
#pragma unroll
            for (int m = 0; m < 4; ++m) { const int row = row0 + ai * HALF + m * 16; unsigned char* rowp = O + (size_t)row * ldc + col0;
                const float rs = rsqrtf(slot_sum8(slot + (size_t)row * 8) * inv_n + eps); float o[8];
#pragma unroll
                for (int n = 0; n < 2; ++n)
#pragma unroll
                    for (int j = 0; j < 4; ++j) { const float g = acc[ai][0][m][n][j] * rs, up = acc[ai][1][m][n][j] * rs; o[n * 4 + j] = g * up * __builtin_amdgcn_rcpf(1.f + __expf(-g)); }
                *(u32x2*)rowp = (u32x2){pk4_fp8(o[0], o[1], o[2], o[3]), pk4_fp8(o[4], o[5], o[6], o[7])}; }
    }
};
struct EpiLatent {
    static constexpr bool PERM = false, AFTER_DRAIN = true; static constexpr int NSTORES = 0;
    bf16_t* O; float* kr; const float* slot_x; float* slot_cq; float* slot_ckv; const float* g_cq; const float* g_ckv; float inv_n, eps;
    __device__ __forceinline__ void fused(const f32x4 (&acc)[2][2][4][2], const Unit& u, int wr, int wc, int fr, int fq, PG8_LAS unsigned char* lds) const {
        const int row0 = u.pm * BM + wr * 64 + fr, ct = wc * 32 + 4 * fq;
        const bool lat = u.pc < 4;
        const float* gain = (u.pc < 2 ? g_cq + u.pc * BM : g_ckv + (u.pc - 2) * BM);
        f32x4 gv[2][2]; float ss[2][4];
#pragma unroll
        for (int bj = 0; bj < 2; ++bj)
#pragma unroll
            for (int n = 0; n < 2; ++n) gv[bj][n] = lat ? *(const f32x4*)(gain + ct + bj * HALF + n * 16) : (f32x4){0.f, 0.f, 0.f, 0.f};
#pragma unroll
        for (int ai = 0; ai < 2; ++ai)
#pragma unroll
            for (int m = 0; m < 4; ++m) { const int row = row0 + ai * HALF + m * 16; const float rs = rsqrtf(slot_sum8(slot_x + (size_t)row * 8) * inv_n + eps); float s = 0.f;
                if (lat) {
#pragma unroll
                    for (int bj = 0; bj < 2; ++bj)
#pragma unroll
                        for (int n = 0; n < 2; ++n) { const f32x4 v = acc[ai][bj][m][n] * rs; s += (v[0] * v[0] + v[1] * v[1]) + (v[2] * v[2] + v[3] * v[3]); const f32x4 h = v * gv[bj][n];
                            *(u32x2*)(O + (size_t)row * 1024 + u.pc * BM + ct + bj * HALF + n * 16) = (u32x2){cvt_pk_bf16(h[0], h[1]), cvt_pk_bf16(h[2], h[3])}; }
                } else {
#pragma unroll
                    for (int n = 0; n < 2; ++n) { const int c = ct + n * 16; if (c < 64) *(f32x4*)(kr + (size_t)row * 64 + c) = acc[ai][0][m][n] * rs; }
                }
                ss[ai][m] = fq_reduce(s); }
        rowsq_publish(ss, lds, u.pm, wr, wc, fr, fq, (u.pc < 2 ? slot_cq : slot_ckv), 2, u.pc & 1, lat);
    }
};
static_assert(SEQ == 4096, "EpiBf16Dual splits the row index with a shift");
struct EpiBf16Dual {
    static constexpr bool PERM = true, AFTER_DRAIN = false; static constexpr int NSTORES = 16;
    bf16_t* O; int ldc; const float* slot_cq; const float* slot_ckv; float inv_n, eps; bf16_t* VT; int seq;
    __device__ __forceinline__ void operator()(const f32x4 (&acc)[2][2][4][2], const Unit& u, int wr, int wc, int fr, int fq) const {
        const int row0 = u.pm * BM + wr * 64 + fr, col0 = u.pc * BM + wc * 32 + 8 * fq; const bool kv = (u.pn >= 12); const float* sl = kv ? slot_ckv : slot_cq;
        const bool odd = fr & 1;
#pragma unroll
        for (int ai = 0; ai < 2; ++ai)
#pragma unroll
            for (int m = 0; m < 4; ++m) { const int row = row0 + ai * HALF + m * 16; bf16_t* rowp = O + (size_t)row * ldc + col0; const f32x2 sq = *(const f32x2*)(sl + (size_t)row * 2); const float rs = rsqrtf((sq[0] + sq[1]) * inv_n + eps);
                { const f32x4 v0 = acc[ai][0][m][0] * rs, v1 = acc[ai][0][m][1] * rs;
                  u32x4 w; w.x = cvt_pk_bf16(v0[0], v0[1]); w.y = cvt_pk_bf16(v0[2], v0[3]); w.z = cvt_pk_bf16(v1[0], v1[1]); w.w = cvt_pk_bf16(v1[2], v1[3]);
                  *(u32x4*)rowp = w; }
                const f32x4 v0 = acc[ai][1][m][0] * rs, v1 = acc[ai][1][m][1] * rs;
                if (!kv) { u32x4 w; w.x = cvt_pk_bf16(v0[0], v0[1]); w.y = cvt_pk_bf16(v0[2], v0[3]); w.z = cvt_pk_bf16(v1[0], v1[1]); w.w = cvt_pk_bf16(v1[2], v1[3]);
                    *(u32x4*)(rowp + HALF) = w; }
                else { const int bq = row >> 12, sq_ = row & 4095, hd = u.pn - 12;
                    bf16_t* vt = VT + (((size_t)bq * 16 + hd) * 128 + wc * 32 + 8 * fq) * seq + (sq_ & ~1);
                    const float val[8] = {v0[0], v0[1], v0[2], v0[3], v1[0], v1[1], v1[2], v1[3]};
#pragma unroll
                    for (int i = 0; i < 8; i += 2) { const float send = odd ? val[i] : val[i + 1];
                        const float recv = __builtin_bit_cast(float, __builtin_amdgcn_update_dpp(0, __builtin_bit_cast(int, send), 0xB1, 0xf, 0xf, true));
                        const unsigned pr = odd ? cvt_pk_bf16(recv, val[i + 1]) : cvt_pk_bf16(val[i], recv);
                        *(unsigned*)(vt + (size_t)(i + (odd ? 1 : 0)) * seq) = pr; } } }
    }
};

struct OneUnit { Unit u; bool on;
    __device__ __forceinline__ bool next(int i, Unit& o) const { if (i != 0 || !on) return false; o = u; return true; }
    __device__ __forceinline__ int rowoff(int, int) const { return 0; } };
struct EpiSplitK {
    static constexpr bool PERM = true, AFTER_DRAIN = true; static constexpr int NSTORES = 16;
    bf16_t* O; int ldc; float* part; unsigned* flag; int slice;
    __device__ __forceinline__ void fused(const f32x4 (&acc)[2][2][4][2], const Unit& u, int wr, int wc, int fr, int fq, PG8_LAS unsigned char* lds) const {
        const int tid = threadIdx.x;
        if (slice != 0) {
            f32x4* p = (f32x4*)part + (size_t)(slice - 1) * (32 * 512) + tid;
#pragma unroll
            for (int ai = 0; ai < 2; ++ai)
#pragma unroll
                for (int bj = 0; bj < 2; ++bj)
#pragma unroll
                    for (int m = 0; m < 4; ++m)
#pragma unroll
                        for (int n = 0; n < 2; ++n) p[(((ai * 2 + bj) * 4 + m) * 2 + n) * 512] = acc[ai][bj][m][n];
            asm volatile("s_waitcnt vmcnt(0)" ::: "memory");
            __syncthreads();
            if (tid == 0) { __builtin_amdgcn_fence(__ATOMIC_RELEASE, "agent"); asm volatile("s_waitcnt vmcnt(0)" ::: "memory"); (void)__hip_atomic_fetch_add(flag, 1u, __ATOMIC_RELAXED, __HIP_MEMORY_SCOPE_AGENT); }
        } else {
            if (tid == 0) { unsigned sp = 0; while (__hip_atomic_load(flag, __ATOMIC_RELAXED, __HIP_MEMORY_SCOPE_AGENT) < 3u) { __builtin_amdgcn_s_sleep(1); if (++sp > (1u << 22)) break; }
                __builtin_amdgcn_fence(__ATOMIC_ACQUIRE, "agent"); asm volatile("s_waitcnt vmcnt(0)" ::: "memory"); }
            __syncthreads();
            const f32x4* p = (const f32x4*)part + tid;
            const int row0 = u.pm * BM + wr * 64 + fr, col0 = u.pc * BM + wc * 32 + 8 * fq;
#pragma unroll
            for (int ai = 0; ai < 2; ++ai)
#pragma unroll
                for (int m = 0; m < 4; ++m) { bf16_t* rowp = O + (size_t)(row0 + ai * HALF + m * 16) * ldc + col0;
#pragma unroll
                    for (int bj = 0; bj < 2; ++bj) { const int j0 = ((ai * 2 + bj) * 4 + m) * 2;
                        const f32x4 v0 = ((acc[ai][bj][m][0] + p[j0 * 512]) + p[(32 + j0) * 512]) + p[(64 + j0) * 512], v1 = ((acc[ai][bj][m][1] + p[(j0 + 1) * 512]) + p[(33 + j0) * 512]) + p[(65 + j0) * 512];
                        u32x4 w; w.x = cvt_pk_bf16(v0[0], v0[1]); w.y = cvt_pk_bf16(v0[2], v0[3]); w.z = cvt_pk_bf16(v1[0], v1[1]); w.w = cvt_pk_bf16(v1[2], v1[3]);
                        *(u32x4*)(rowp + bj * HALF) = w; } }
        }
    }
};

template <class Epi, class Sched, bool ALIGN_EPI = true, bool SP2 = true, bool FP8 = false, bool GATHER = false>
__device__ __forceinline__ void gemm_phase(PG8_LAS unsigned char* lds, const Gemm g, const Sched& S, const Epi& E) {
    const int tid = threadIdx.x, wid = __builtin_amdgcn_readfirstlane(tid >> 6), lane = tid & 63, wr = wid >> 2, wc = wid & 3, fr = lane & 15, fq = lane >> 4;
    const int K = g.K, nt = K / BK;
    unsigned voffA[2], voffB[2];
#pragma unroll
    for (int i = 0; i < 2; ++i) { int R, C; stage_rc(tid * 16 + i * 8192, R, C); const int Rb = Epi::PERM ? ((R & ~31) + perm32(R & 31)) : R;
        voffA[i] = (unsigned)(R * g.lda + C) * 2u; voffB[i] = (unsigned)(Rb * g.ldb + C) * 2u; }
    unsigned vAc[2][2] = {{0u, 0u}, {0u, 0u}}; unsigned (&vAn)[2][2] = vAc; int Rg0 = 0, Cg2 = 0;
    if constexpr (GATHER) { static_assert(SP2, "gather: SP2 form only"); int C0; stage_rc(tid * 16, Rg0, C0); Cg2 = 2 * C0; }
#define PG8_GOFF(dst, ui_) do { _Pragma("unroll") for (int h_ = 0; h_ < 2; ++h_) _Pragma("unroll") for (int i_ = 0; i_ < 2; ++i_) dst[h_][i_] = (unsigned)(S.rowoff(ui_, h_ * HALF + 64 * i_ + Rg0) + Cg2); } while (0)
#define PG8_STAGE_A(bufoff, gbase, h, nx) do { if constexpr (GATHER) { unsigned v_[2] = {(nx) ? vAn[h][0] : vAc[h][0], (nx) ? vAn[h][1] : vAc[h][1]}; PG8_STAGE(bufoff, gbase, v_); } \
        else PG8_STAGE(bufoff, (gbase) + (h) * hstepA, voffA); } while (0)
    const size_t kstep = (size_t)(BK * 2);
    const size_t hstepA = (size_t)HALF * g.lda * 2, hstepB = (size_t)HALF * g.ldb * 2;
    const size_t tstepA = 2 * hstepA, tstepB = 2 * hstepB;
    const unsigned ldsw = (unsigned)wid * 1024u;
    const int aoff = lds_byte(wr * 64 + fr, fq * 8), boff = lds_byte(wc * 32 + fr, fq * 8);
#define PG8_SA(b, h) (((b) * 2 + (h)) * HTB)
#define PG8_SB(b, h) ((4 + (b) * 2 + (h)) * HTB)
#define PG8_STAGE(bufoff, gbase, voff) do { _Pragma("unroll") for (int _i = 0; _i < 2; ++_i) \
        __builtin_amdgcn_global_load_lds((const unsigned*)((const char*)(gbase) + (voff)[_i]), (PG8_LAS unsigned*)(lds + (bufoff) + ldsw + _i * 8192), 16, 0, 0); } while (0)
#define PG8_LDA(dst, b, h) do { _Pragma("unroll") for (int m = 0; m < 4; ++m) { \
        if constexpr (FP8) { dst##8[m].lo = *(const PG8_LAS i32x4*)(lds + PG8_SA(b, h) + aoff + m * 2048); dst##8[m].hi = *(const PG8_LAS i32x4*)(lds + PG8_SA(b, h) + aoff + m * 2048 + 1024); } \
        else { _Pragma("unroll") for (int k = 0; k < 2; ++k) dst[m][k] = *(const PG8_LAS bf16x8*)(lds + PG8_SA(b, h) + aoff + m * 2048 + k * 1024); } } } while (0)
#define PG8_LDB(dst, b, h) do { _Pragma("unroll") for (int n = 0; n < 2; ++n) { \
        if constexpr (FP8) { dst##8[n].lo = *(const PG8_LAS i32x4*)(lds + PG8_SB(b, h) + boff + n * 2048); dst##8[n].hi = *(const PG8_LAS i32x4*)(lds + PG8_SB(b, h) + boff + n * 2048 + 1024); } \
        else { _Pragma("unroll") for (int k = 0; k < 2; ++k) dst[n][k] = *(const PG8_LAS bf16x8*)(lds + PG8_SB(b, h) + boff + n * 2048 + k * 1024); } } } while (0)
#define PG8_MMA(ai, bj, At, Bt) do { __builtin_amdgcn_s_setprio(1); \
        if constexpr (FP8) { _Pragma("unroll") for (int m = 0; m < 4; ++m) _Pragma("unroll") for (int n = 0; n < 2; ++n) \
            asm volatile("v_mfma_scale_f32_16x16x128_f8f6f4 %0, %1, %2, %0, %3, %4 op_sel_hi:[0,0,0]" : "+v"(acc[ai][bj][m][n]) : "v"(Bt##8[n]), "v"(At##8[m]), "v"(sclW), "v"(sclX)); } \
        else { _Pragma("unroll") for (int m = 0; m < 4; ++m) _Pragma("unroll") for (int n = 0; n < 2; ++n) _Pragma("unroll") for (int k = 0; k < 2; ++k) \
            acc[ai][bj][m][n] = __builtin_amdgcn_mfma_f32_16x16x32_bf16(Bt[n][k], At[m][k], acc[ai][bj][m][n], 0, 0, 0); } \
          \
        __builtin_amdgcn_s_setprio(0); } while (0)
#define PG8_WAIT_V(n) asm volatile("s_waitcnt vmcnt(" #n ")" ::: "memory")
#define PG8_WAIT_L(n) asm volatile("s_waitcnt lgkmcnt(" #n ")" ::: "memory")
#define PG8_WAIT_V8R(relax_) do { if (relax_) asm volatile("s_waitcnt vmcnt(%0)" :: "i"(8 + Epi::NSTORES) : "memory"); else asm volatile("s_waitcnt vmcnt(8)" ::: "memory"); } while (0)
#define PG8_BAR __builtin_amdgcn_s_barrier()
#define PG8_SCHED __builtin_amdgcn_sched_barrier(0)
    Unit cur, nxt; int ui = 0;
    if (!S.next(0, cur)) return;
    f32x4 acc[2][2][4][2];
#pragma unroll
    for (int a = 0; a < 2; ++a)
#pragma unroll
        for (int b = 0; b < 2; ++b)
#pragma unroll
            for (int m = 0; m < 4; ++m)
#pragma unroll
                for (int n = 0; n < 2; ++n) acc[a][b][m][n] = (f32x4){0.f, 0.f, 0.f, 0.f};
    const int sclW = 0x79797979, sclX = 0x7f7f7f7f;
    bf16x8 At[4][2], B0[2][2], B1[2][2]; i32x8 At8[4], B08[2], B18[2];
    const char* cA = (const char*)g.A + (GATHER ? (size_t)0 : (size_t)cur.pm * tstepA) + cur.aoff; const char* cB = (const char*)g.Bt + (size_t)cur.pn * tstepB;
    if constexpr (GATHER) PG8_GOFF(vAc, 0);
    if constexpr (SP2) {
        PG8_STAGE(PG8_SB(0, 0), cB, voffB); PG8_STAGE(PG8_SB(0, 1), cB + hstepB, voffB); PG8_STAGE_A(PG8_SA(0, 0), cA, 0, false); PG8_STAGE_A(PG8_SA(0, 1), cA, 1, false);
        if (wr == 1) PG8_BAR;
        PG8_WAIT_V(2); PG8_BAR;
        PG8_STAGE(PG8_SB(1, 0), cB + kstep, voffB); PG8_STAGE_A(PG8_SA(1, 0), cA + kstep, 0, false); PG8_STAGE(PG8_SB(1, 1), cB + hstepB + kstep, voffB);
        PG8_WAIT_V(6); PG8_BAR;
    } else {
        PG8_STAGE(PG8_SB(0, 0), cB, voffB); PG8_STAGE(PG8_SA(0, 0), cA, voffA); PG8_STAGE(PG8_SB(0, 1), cB + hstepB, voffB); PG8_STAGE(PG8_SA(0, 1), cA + hstepA, voffA);
        if (wr == 1) PG8_BAR;
        PG8_WAIT_V(4); PG8_BAR;
        PG8_STAGE(PG8_SB(1, 0), cB + kstep, voffB); PG8_STAGE(PG8_SA(1, 0), cA + kstep, voffA); PG8_STAGE(PG8_SB(1, 1), cB + hstepB + kstep, voffB);
        PG8_WAIT_V(6); PG8_BAR;
    }
    for (;;) {
        const bool has_next = S.next(ui + 1, nxt);
        const char* nA = has_next ? (const char*)g.A + (GATHER ? (size_t)0 : (size_t)nxt.pm * tstepA) + nxt.aoff : cA;
        const char* nB = has_next ? (const char*)g.Bt + (size_t)nxt.pn * tstepB : cB;
        for (int t = 0; t < nt; t += 2) {
            const bool last = (t == nt - 2);
            const char* a1 = cA + (size_t)(t + 1) * kstep;
            const char* a2 = last ? nA : cA + (size_t)(t + 2) * kstep; const char* b2 = last ? nB : cB + (size_t)(t + 2) * kstep;
            const char* a3 = a2 + kstep; const char* b3 = b2 + kstep;
            if constexpr (SP2) {
            unsigned vAn[2][2] = {{vAc[0][0], vAc[0][1]}, {vAc[1][0], vAc[1][1]}};
            if constexpr (GATHER) { if (last && has_next) PG8_GOFF(vAn, ui + 1); }
            constexpr bool relax = false;
            PG8_LDB(B0, 0, 0); PG8_LDB(B1, 0, 1); PG8_SCHED; PG8_LDA(At, 0, 0); PG8_STAGE_A(PG8_SA(1, 1), a1, 1, false);
            PG8_WAIT_V8R(relax); PG8_WAIT_L(0); PG8_BAR; PG8_MMA(0, 0, At, B0); PG8_MMA(0, 1, At, B1); PG8_BAR; PG8_SCHED;
            PG8_LDA(At, 0, 1); PG8_STAGE(PG8_SB(0, 0), b2, voffB); PG8_STAGE(PG8_SB(0, 1), b2 + hstepB, voffB); PG8_STAGE_A(PG8_SA(0, 0), a2, 0, last);
            PG8_WAIT_V8R(relax); PG8_WAIT_L(0); PG8_BAR; PG8_MMA(1, 0, At, B0); PG8_MMA(1, 1, At, B1); PG8_BAR; PG8_SCHED;
            PG8_LDB(B0, 1, 0); PG8_LDB(B1, 1, 1); PG8_SCHED; PG8_LDA(At, 1, 0); PG8_STAGE_A(PG8_SA(0, 1), a2, 1, last);
            PG8_WAIT_V(8); PG8_WAIT_L(0); PG8_BAR; PG8_MMA(0, 0, At, B0); PG8_MMA(0, 1, At, B1); PG8_BAR; PG8_SCHED;
            PG8_LDA(At, 1, 1); PG8_STAGE(PG8_SB(1, 0), b3, voffB); PG8_STAGE(PG8_SB(1, 1), b3 + hstepB, voffB); PG8_STAGE_A(PG8_SA(1, 0), a3, 0, last);
            PG8_WAIT_V(8); PG8_WAIT_L(0); PG8_BAR; PG8_MMA(1, 0, At, B0); PG8_MMA(1, 1, At, B1); PG8_BAR; PG8_SCHED;
            } else {
            PG8_LDB(B0, 0, 0); PG8_SCHED; PG8_LDA(At, 0, 0); PG8_STAGE(PG8_SA(1, 1), a1 + hstepA, voffA);
            PG8_WAIT_L(8); PG8_BAR; PG8_WAIT_L(0); PG8_MMA(0, 0, At, B0); PG8_BAR; PG8_SCHED;
            PG8_LDB(B1, 0, 1); PG8_STAGE(PG8_SB(0, 0), b2, voffB);
            PG8_BAR; PG8_WAIT_L(0); PG8_MMA(0, 1, At, B1); PG8_BAR;
            PG8_LDA(At, 0, 1); PG8_STAGE(PG8_SA(0, 0), a2, voffA);
            PG8_BAR; PG8_WAIT_L(0); PG8_MMA(1, 0, At, B0); PG8_BAR; PG8_SCHED;
            PG8_STAGE(PG8_SB(0, 1), b2 + hstepB, voffB);
            PG8_WAIT_V(6); PG8_BAR; PG8_MMA(1, 1, At, B1); PG8_BAR;
            PG8_LDB(B0, 1, 0); PG8_SCHED; PG8_LDA(At, 1, 0); PG8_STAGE(PG8_SA(0, 1), a2 + hstepA, voffA);
            PG8_WAIT_L(8); PG8_BAR; PG8_WAIT_L(0); PG8_MMA(0, 0, At, B0); PG8_BAR; PG8_SCHED;
            PG8_LDB(B1, 1, 1); PG8_STAGE(PG8_SB(1, 0), b3, voffB);
            PG8_BAR; PG8_WAIT_L(0); PG8_MMA(0, 1, At, B1); PG8_BAR;
            PG8_LDA(At, 1, 1); PG8_STAGE(PG8_SA(1, 0), a3, voffA);
            PG8_BAR; PG8_WAIT_L(0); PG8_MMA(1, 0, At, B0); PG8_BAR; PG8_SCHED;
            PG8_STAGE(PG8_SB(1, 1), b3 + hstepB, voffB);
            PG8_WAIT_V(6); PG8_BAR; PG8_MMA(1, 1, At, B1); PG8_BAR;
            }
        }
        if constexpr (ALIGN_EPI) { if (wr == 0) PG8_BAR; }
        asm volatile("s_nop 15\n\ts_nop 15" ::: "memory");
        if constexpr (!Epi::AFTER_DRAIN) E(acc, cur, wr, wc, fr, fq);
        if (!has_next) break;
#pragma unroll
        for (int a = 0; a < 2; ++a)
#pragma unroll
            for (int b = 0; b < 2; ++b)
#pragma unroll
                for (int m = 0; m < 4; ++m)
#pragma unroll
                    for (int n = 0; n < 2; ++n) acc[a][b][m][n] = (f32x4){0.f, 0.f, 0.f, 0.f};
        cur = nxt; cA = nA; cB = nB; ++ui;
        if constexpr (GATHER) PG8_GOFF(vAc, ui);
        if constexpr (ALIGN_EPI) { if (wr == 1) PG8_BAR; }
    }
    PG8_WAIT_V(0);
    if constexpr (!ALIGN_EPI) { if (wr == 0) PG8_BAR; }
    PG8_BAR;
    if constexpr (Epi::AFTER_DRAIN) E.fused(acc, cur, wr, wc, fr, fq, lds);
#undef PG8_SA
#undef PG8_SB
#undef PG8_STAGE
#undef PG8_LDA
#undef PG8_LDB
#undef PG8_MMA
#undef PG8_WAIT_V
#undef PG8_WAIT_L
#undef PG8_GOFF
#undef PG8_STAGE_A
#undef PG8_WAIT_V8R
#undef PG8_BAR
#undef PG8_SCHED
}
}
#define XB_TMO      128
#define XB_XCNT(j)  (256  + 64 * (j))
#define XB_XSUB(j)  (1280 + 64 * (j))
#define XB_XGEN(j)  (2304 + 64 * (j))
#define XB_TOP      3328
#define XB_TOPGEN   3392
#define XCD_BAR_WORDS 3456
#define XB_SPIN_CAP (1u << 18)

__device__ __forceinline__ unsigned xb_ld(unsigned* p)              { return __hip_atomic_load(p, __ATOMIC_RELAXED, __HIP_MEMORY_SCOPE_AGENT); }
__device__ __forceinline__ unsigned xb_add(unsigned* p, unsigned v) { return __hip_atomic_fetch_add(p, v, __ATOMIC_RELAXED, __HIP_MEMORY_SCOPE_AGENT); }
__device__ __forceinline__ unsigned xb_xcc_id() { return (unsigned)__builtin_amdgcn_s_getreg((3 << 11) | 20) & 0xFu; }
#define XB_SPIN(cond, bar) do { unsigned _sp = 0; while (cond) { __builtin_amdgcn_s_sleep(1); \
    if ((++_sp & 255u) == 0u) { if (xb_ld(&(bar)[XB_TMO])) break; if (_sp > XB_SPIN_CAP) { atomicAdd(&(bar)[XB_TMO], 1u); break; } } } } while (0)

struct XcdBarrier { unsigned* bar; unsigned x; volatile LAS unsigned* st; };

__device__ __forceinline__ XcdBarrier xcd_barrier_post(unsigned* bar, volatile LAS unsigned* st) {
    XcdBarrier b; b.bar = bar; b.x = xb_xcc_id(); b.st = st;
    if (threadIdx.x == 0) (void)xb_add(&bar[XB_XCNT(b.x)], 1u);
    return b;
}
__device__ __forceinline__ void xcd_barrier_complete(unsigned* bar, unsigned x, unsigned& nloc, unsigned& nx) {
    const unsigned G = gridDim.x * gridDim.y * gridDim.z;
    unsigned sum, cnt, mine, sp = 0u;
    for (;;) {
        sum = 0u; cnt = 0u; mine = 0u;
#pragma unroll
        for (unsigned j = 0; j < 16; ++j) { const unsigned c = xb_ld(&bar[XB_XCNT(j)]); sum += c; cnt += (c > 0u) ? 1u : 0u; mine = (j == x) ? c : mine; }
        if (sum == G) break;
        __builtin_amdgcn_s_sleep(1);
        if ((++sp & 255u) == 0u) { if (xb_ld(&bar[XB_TMO])) break; if (sp > XB_SPIN_CAP) { atomicAdd(&bar[XB_TMO], 1u); break; } }
    }
    nloc = mine > 0u ? mine : 1u; nx = cnt > 0u ? cnt : 1u;
}
__device__ __forceinline__ void xcd_barrier(const XcdBarrier& b) {
    asm volatile("s_waitcnt vmcnt(0)" ::: "memory");
    __syncthreads();
    if (threadIdx.x == 0) {
        unsigned* bar = b.bar;
        __builtin_amdgcn_s_waitcnt(0);
        unsigned nloc = b.st[0], nx = b.st[1];
        if (nloc == 0u) { xcd_barrier_complete(bar, b.x, nloc, nx); b.st[0] = nloc; b.st[1] = nx; }
        const unsigned old = xb_add(&bar[XB_XSUB(b.x)], 1u);
        const unsigned gen = old / nloc;
        if (old + 1u == (gen + 1u) * nloc) {
            __builtin_amdgcn_fence(__ATOMIC_RELEASE, "agent");
            asm volatile("s_waitcnt vmcnt(0)" ::: "memory");
            (void)xb_add(&bar[XB_TOP], 1u);
        }
        { const unsigned target = (gen + 1u) * nx; XB_SPIN(xb_ld(&bar[XB_TOP]) < target, bar); }
        __builtin_amdgcn_fence(__ATOMIC_ACQUIRE, "agent");
        asm volatile("s_waitcnt vmcnt(0)" ::: "memory");
    }
    __syncthreads();
}

struct Ctx {
    LAS unsigned char* lds;
    int tid, lane, wave, wg, nwg;
    const float *x; const int* pos;
    const float *g_mix, *g_ffn, *w_in, *conv_w, *b_gates, *g_mo, *g_ro, *w_mix_out, *ffn_gate, *ffn_up, *ffn_down;
    const float *w_dqkv, *g_cq, *g_ckv, *w_uq, *w_ukv, *g_qn, *g_qr, *g_kn, *g_kr, *w_o, *w_router, *we_gate, *we_up, *we_down;
    float* out; unsigned char* ws;
};

template <bool Q8 = false>
__device__ __forceinline__ void transpose_item(const float* src, int lds_, bf16_t* dst, int ldd, LAS float* scr, int lane) {
    f32x4 v[8]; const int l8 = lane & 7, kr = lane >> 3;
#pragma unroll
    for (int i = 0; i < 8; ++i) v[i] = *(const f32x4*)(src + (size_t)(kr + 8 * i) * lds_ + 4 * l8);
#pragma unroll
    for (int i = 0; i < 8; ++i) { LAS float* d = scr + (kr + 8 * i) * 33 + 4 * l8; d[0] = v[i][0]; d[1] = v[i][1]; d[2] = v[i][2]; d[3] = v[i][3]; }
    LDS_WAIT(); asm volatile("" ::: "memory");
    const int c = lane & 7;
#pragma unroll
    for (int j = 0; j < 4; ++j) { const int n = (lane >> 3) + 8 * j; const LAS float* s = scr + (8 * c) * 33 + n;
        u32x4 o; o.x = cvt_pk_bf16(s[0 * 33], s[1 * 33]); o.y = cvt_pk_bf16(s[2 * 33], s[3 * 33]); o.z = cvt_pk_bf16(s[4 * 33], s[5 * 33]); o.w = cvt_pk_bf16(s[6 * 33], s[7 * 33]);
        *(u32x4*)(dst + (size_t)n * ldd + 8 * c) = o; }
    LDS_WAIT(); asm volatile("" ::: "memory");
}
template <bool Q8 = false>
__device__ __forceinline__ void tr_plain(const float* W, int K, int N, bf16_t* WT, int r, LAS float* scr, int lane) {
    const int nblk = N / 32, kb = r / nblk, nb = r % nblk;
    transpose_item<Q8>(W + (size_t)(64 * kb) * N + 32 * nb, N, WT + (size_t)(32 * nb) * K + 64 * kb, K, scr, lane);
}
template <bool Q8 = false>
__device__ __forceinline__ void tr_gu(const float* Wg, const float* Wu, bf16_t* WT, int r, LAS float* scr, int lane) {
    constexpr int nblk = (2 * DFF) / 32; const int kb = r / nblk, nb = r % nblk, n0 = 32 * nb, j = n0 >> 8, within = n0 & 255;
    const float* src = (within < 128 ? Wg : Wu) + (size_t)(64 * kb) * DFF + 128 * j + (within & 127);
    transpose_item<Q8>(src, DFF, WT + (size_t)n0 * D + 64 * kb, D, scr, lane);
}
__device__ __forceinline__ void transpose_item8(const float* src, int lds_, unsigned char* dst, int ldd, LAS float* scr, int lane) {
    f32x4 v[2][8]; const int l8 = lane & 7, kr = lane >> 3;
#pragma unroll
    for (int hf = 0; hf < 2; ++hf)
#pragma unroll
        for (int i = 0; i < 8; ++i) v[hf][i] = *(const f32x4*)(src + (size_t)(64 * hf + kr + 8 * i) * lds_ + 4 * l8);
#pragma unroll
    for (int hf = 0; hf < 2; ++hf) {
#pragma unroll
        for (int i = 0; i < 8; ++i) { LAS float* d = scr + (kr + 8 * i) * 33 + 4 * l8; d[0] = v[hf][i][0]; d[1] = v[hf][i][1]; d[2] = v[hf][i][2]; d[3] = v[hf][i][3]; }
        LDS_WAIT(); asm volatile("" ::: "memory");
        const int n = lane >> 1, hh = lane & 1; const LAS float* sp = scr + (32 * hh) * 33 + n; unsigned w[8];
#pragma unroll
        for (int q = 0; q < 8; ++q) w[q] = pk4_fp8(sp[(4 * q) * 33] * W8_SCALE, sp[(4 * q + 1) * 33] * W8_SCALE, sp[(4 * q + 2) * 33] * W8_SCALE, sp[(4 * q + 3) * 33] * W8_SCALE);
        unsigned char* d = dst + (size_t)n * ldd + 64 * hf + 32 * hh;
        *(u32x4*)d = (u32x4){w[0], w[1], w[2], w[3]}; *(u32x4*)(d + 16) = (u32x4){w[4], w[5], w[6], w[7]};
        LDS_WAIT(); asm volatile("" ::: "memory");
    }
}
__device__ __forceinline__ void zero_item(bf16_t* dst, int ldd, int lane) {
#pragma unroll
    for (int j = 0; j < 4; ++j) { const int n = (lane >> 3) + 8 * j; *(u32x4*)(dst + (size_t)n * ldd + 8 * (lane & 7)) = (u32x4){0u, 0u, 0u, 0u}; }
}

constexpr int I_WIN = 32 * 256, I_WOUT = 32 * 64, I_WGU = 32 * 352, I_WD = 88 * 64, I_WDQKV = 32 * 40, I_WUQ = 8 * 96, I_WUKV = 8 * 128, I_WO = 32 * 64;
constexpr int I_DENSE = I_WIN + I_WOUT + I_WGU + I_WD + I_WDQKV + I_WUQ + I_WUKV + I_WO;
constexpr int I_EGU8 = 16 * 352, I_ED8 = 44 * 64;
constexpr int I_EXP = I_EGU8 + I_ED8;
constexpr int I_TOTAL = I_DENSE + NEXP * I_EXP;

__device__ __forceinline__ void weight_item(const Ctx& C, int it, LAS float* scr) {
    int r = it; unsigned char* ws = C.ws; const int lane = C.lane;
    if (r < I_WIN) { constexpr int nblk = 256; const int kb = r / nblk, nb = r % nblk, n0 = 32 * nb, sc = n0 + (n0 >= 4096 ? 8 : 0);
        transpose_item(C.w_in + (size_t)(64 * kb) * IN_COLS + sc, IN_COLS, (bf16_t*)(ws + WS_WIN) + (size_t)n0 * D + 64 * kb, D, scr, lane); return; } r -= I_WIN;
    if (r < I_WOUT) { tr_plain(C.w_mix_out, D, D, (bf16_t*)(ws + WS_WOUT), r, scr, lane); return; } r -= I_WOUT;
    if (r < I_WGU) { tr_gu<(FP8_EMU >= 2)>(C.ffn_gate, C.ffn_up, (bf16_t*)(ws + WS_WGU), r, scr, lane); return; } r -= I_WGU;
    if (r < I_WD) { tr_plain<(FP8_EMU >= 2)>(C.ffn_down, DFF, D, (bf16_t*)(ws + WS_WD), r, scr, lane); return; } r -= I_WD;
    if (r < I_WDQKV) { constexpr int nblk = 40; const int kb = r / nblk, nb = r % nblk; bf16_t* dst = (bf16_t*)(ws + WS_WDQKV) + (size_t)(32 * nb) * D + 64 * kb;
        if (nb < 34) transpose_item(C.w_dqkv + (size_t)(64 * kb) * 1088 + 32 * nb, 1088, dst, D, scr, lane); else zero_item(dst, D, lane); return; } r -= I_WDQKV;
    if (r < I_WUQ) { tr_plain(C.w_uq, 512, 3072, (bf16_t*)(ws + WS_WUQKV), r, scr, lane); return; } r -= I_WUQ;
    if (r < I_WUKV) { tr_plain(C.w_ukv, 512, 4096, (bf16_t*)(ws + WS_WUQKV) + (size_t)3072 * 512, r, scr, lane); return; } r -= I_WUKV;
    if (r < I_WO) { tr_plain(C.w_o, D, D, (bf16_t*)(ws + WS_WO), r, scr, lane); return; } r -= I_WO;
    const int e = r / I_EXP; r -= e * I_EXP;
    if (r < I_EGU8) { constexpr int nblk = 352; const int kb = r / nblk, nb = r % nblk, n0 = 32 * nb, j = n0 >> 8, within = n0 & 255;
        const float* src = (within < 128 ? C.we_gate : C.we_up) + (size_t)e * D * DFF + (size_t)(128 * kb) * DFF + 128 * j + (within & 127);
        transpose_item8(src, DFF, ws + WS_WEGU + ((size_t)e * 2 * DFF + n0) * D + 128 * kb, D, scr, lane); return; } r -= I_EGU8;
    { constexpr int nblk = 64; const int kb = r / nblk, nb = r % nblk;
        transpose_item8(C.we_down + (size_t)e * DFF * D + (size_t)(128 * kb) * D + 32 * nb, D, ws + WS_WED + ((size_t)e * D + 32 * nb) * DFF + 128 * kb, DFF, scr, lane); }
}

constexpr int EXP_ITEMS_GU = 16 * 44, EXP_ITEMS_D = 44 * 8, EXP_ITEMS = EXP_ITEMS_GU + EXP_ITEMS_D;
struct ExpItem { const float* p; unsigned char* dst; int ld, ldd; };
constexpr int EXP_N_GU = NEXP * EXP_ITEMS_GU, EXP_N_ALL = NEXP * EXP_ITEMS, EXP_N_FFN = EXP_ITEMS_GU, EXP_N_TOTAL = EXP_N_ALL + EXP_N_FFN, EXP_N_FD = EXP_ITEMS_D, EXP_N_TOTAL2 = EXP_N_TOTAL + EXP_N_FD;
__device__ __forceinline__ ExpItem exp_item(const Ctx& C, int it) {
    ExpItem I; const int w = C.wave, l = C.lane;
    if (it < EXP_N_GU) { const int e = it / EXP_ITEMS_GU, r = it - e * EXP_ITEMS_GU; const int kb = r / 44, j = r - kb * 44, within = 4 * l;
        I.p = (within < 128 ? C.we_gate : C.we_up) + (size_t)e * D * DFF + (size_t)(128 * kb + 16 * w) * DFF + 128 * j + (within & 127); I.ld = DFF;
        I.dst = C.ws + WS_WEGU + ((size_t)e * 2 * DFF + 256 * j) * D + 128 * kb; I.ldd = D; }
    else if (it >= EXP_N_TOTAL) { const int r = it - EXP_N_TOTAL; const int kb = r >> 3, nb = r & 7;
        I.p = C.ffn_down + (size_t)(128 * kb + 16 * w) * D + 256 * nb + 4 * l; I.ld = D;
        I.dst = C.ws + WS_WD + (size_t)(256 * nb) * DFF + 128 * kb; I.ldd = DFF; }
    else if (it >= EXP_N_ALL) { const int r = it - EXP_N_ALL; const int kb = r / 44, j = r - kb * 44, within = 4 * l;
        I.p = (within < 128 ? C.ffn_gate : C.ffn_up) + (size_t)(128 * kb + 16 * w) * DFF + 128 * j + (within & 127); I.ld = DFF;
        I.dst = C.ws + WS_WGU + (size_t)(256 * j) * D + 128 * kb; I.ldd = D; }
    else { const int q = it - EXP_N_GU, e = q / EXP_ITEMS_D, r = q - e * EXP_ITEMS_D; const int kb = r >> 3, nb = r & 7;
        I.p = C.we_down + (size_t)e * DFF * D + (size_t)(128 * kb + 16 * w) * D + 256 * nb + 4 * l; I.ld = D;
        I.dst = C.ws + WS_WED + ((size_t)e * D + 256 * nb) * DFF + 128 * kb; I.ldd = DFF; }
    return I;
}
#define EXP_LOAD(V, I) do { _Pragma("unroll") for (int i_ = 0; i_ < 16; ++i_) V[i_] = __builtin_nontemporal_load((const f32x4*)((I).p + (size_t)i_ * (I).ld)); } while (0)
#define EXP_PROC(V, I, BUF) do { LAS unsigned* buf_ = (LAS unsigned*)(C.lds + (BUF) * 32768); const int w_ = C.wave, l_ = C.lane; \
        _Pragma("unroll") for (int i_ = 0; i_ < 16; ++i_) buf_[(16 * w_ + i_) * 64 + (l_ ^ (w_ << 3))] = pk4_fp8(V[i_][0] * W8_SCALE, V[i_][1] * W8_SCALE, V[i_][2] * W8_SCALE, V[i_][3] * W8_SCALE); \
        __syncthreads(); \
        const int kq_ = C.tid & 7, g_ = C.tid >> 3; unsigned d_[16]; \
        _Pragma("unroll") for (int j_ = 0; j_ < 16; ++j_) d_[j_] = buf_[(16 * kq_ + j_) * 64 + (g_ ^ (kq_ << 3))]; \
        _Pragma("unroll") for (int i_ = 0; i_ < 4; ++i_) { u32x4 o_; \
            _Pragma("unroll") for (int b_ = 0; b_ < 4; ++b_) o_[b_] = ((d_[4 * b_] >> (8 * i_)) & 0xffu) | (((d_[4 * b_ + 1] >> (8 * i_)) & 0xffu) << 8) | (((d_[4 * b_ + 2] >> (8 * i_)) & 0xffu) << 16) | (((d_[4 * b_ + 3] >> (8 * i_)) & 0xffu) << 24); \
            __builtin_nontemporal_store(o_, (u32x4*)((I).dst + (size_t)(4 * g_ + i_) * (I).ldd + 16 * kq_)); } } while (0)
#ifndef EXP_N7
#define EXP_N7 6
#endif
#ifndef EXP_N9
#define EXP_N9 8
#endif
#ifndef EXP_N10
#define EXP_N10 2
#endif
constexpr int EXP_P1_END = 2560;
constexpr int EXP_TAIL7 = 128 * EXP_N7, EXP_TAIL9 = 96 * EXP_N9, EXP_TAIL10 = 128 * EXP_N10, EXP_TAIL_END = EXP_TAIL7 + EXP_TAIL9 + EXP_TAIL10;
static_assert(EXP_TAIL_END <= EXP_N_GU, "tail items are gate/up items");
__device__ __forceinline__ void expert_weights_range(const Ctx& C, int lo, int hi, int rank, int nranks) {
    f32x4 va[16], vb[16]; ExpItem Ia, Ib;
    int it = lo + rank; asm volatile("" : "+s"(it));
    if (it < hi) { Ia = exp_item(C, it); EXP_LOAD(va, Ia); }
    while (it < hi) {
        const int itb = it + nranks;
        if (itb < hi) { Ib = exp_item(C, itb); EXP_LOAD(vb, Ib); }
        EXP_PROC(va, Ia, 0);
        if (itb >= hi) break;
        const int ita = itb + nranks;
        if (ita < hi) { Ia = exp_item(C, ita); EXP_LOAD(va, Ia); }
        EXP_PROC(vb, Ib, 1);
        it = ita;
    }
    __syncthreads();
}
#undef EXP_LOAD
#undef EXP_PROC

struct DenItem { const float* p; bf16_t* dst; int ld, ldd; int valid; int q8; };
constexpr int DI_WIN = 32 * 32, DI_WOUT = 32 * 8, DI_GU = 32 * 44, DI_WD = 0  , DI_DQKV = 32 * 5, DI_UQ = 8 * 12, DI_UKV = 8 * 16, DI_WO = 32 * 8;
constexpr int DI_TOTAL = DI_WIN + DI_WOUT + DI_WD + DI_DQKV + DI_UQ + DI_UKV + DI_WO;
__device__ __forceinline__ DenItem den_item(const Ctx& C, int it) {
    DenItem I; I.valid = 1; I.q8 = 0; int r = it; const int w = C.wave, l = C.lane; unsigned char* ws = C.ws;
    if (r < DI_WIN) { const int kb = r >> 5, nb = r & 31, n0 = 256 * nb; I.ld = IN_COLS; I.p = C.w_in + (size_t)(64 * kb + 8 * w) * IN_COLS + n0 + (n0 >= 4096 ? 8 : 0) + 4 * l; I.dst = (bf16_t*)(ws + WS_WIN) + (size_t)n0 * D + 64 * kb; I.ldd = D; return I; } r -= DI_WIN;
    if (r < DI_WOUT) { const int kb = r >> 3, nb = r & 7; I.ld = D; I.p = C.w_mix_out + (size_t)(64 * kb + 8 * w) * D + 256 * nb + 4 * l; I.dst = (bf16_t*)(ws + WS_WOUT) + (size_t)(256 * nb) * D + 64 * kb; I.ldd = D; return I; } r -= DI_WOUT;
    if (r < DI_WD) { const int kb = r >> 3, nb = r & 7; I.ld = D; I.p = C.ffn_down + (size_t)(64 * kb + 8 * w) * D + 256 * nb + 4 * l; I.dst = (bf16_t*)(ws + WS_WD) + (size_t)(256 * nb) * DFF + 64 * kb; I.ldd = DFF; return I; } r -= DI_WD;
    if (r < DI_DQKV) { const int kb = r / 5, nb = r - kb * 5; I.ld = 1088; I.valid = (256 * nb + 4 * l) < 1088; I.p = C.w_dqkv + (size_t)(64 * kb + 8 * w) * 1088 + (I.valid ? 256 * nb + 4 * l : 0); I.dst = (bf16_t*)(ws + WS_WDQKV) + (size_t)(256 * nb) * D + 64 * kb; I.ldd = D; return I; } r -= DI_DQKV;
    if (r < DI_UQ) { const int kb = r / 12, nb = r - kb * 12; I.ld = 3072; I.p = C.w_uq + (size_t)(64 * kb + 8 * w) * 3072 + 256 * nb + 4 * l; I.dst = (bf16_t*)(ws + WS_WUQKV) + (size_t)(256 * nb) * 512 + 64 * kb; I.ldd = 512; return I; } r -= DI_UQ;
    if (r < DI_UKV) { const int kb = r >> 4, nb = r & 15; I.ld = 4096; I.p = C.w_ukv + (size_t)(64 * kb + 8 * w) * 4096 + 256 * nb + 4 * l; I.dst = (bf16_t*)(ws + WS_WUQKV) + (size_t)(3072 + 256 * nb) * 512 + 64 * kb; I.ldd = 512; return I; } r -= DI_UKV;
    { const int kb = r >> 3, nb = r & 7; I.ld = D; I.p = C.w_o + (size_t)(64 * kb + 8 * w) * D + 256 * nb + 4 * l; I.dst = (bf16_t*)(ws + WS_WO) + (size_t)(256 * nb) * D + 64 * kb; I.ldd = D; return I; }
}
#define DEN_LOAD(V, I) do { _Pragma("unroll") for (int i_ = 0; i_ < 8; ++i_) V[i_] = (I).valid ? __builtin_nontemporal_load((const f32x4*)((I).p + (size_t)i_ * (I).ld)) : (f32x4){0.f, 0.f, 0.f, 0.f}; } while (0)
#define DEN_PROC(V, I, BUF) do { LAS unsigned* buf_ = (LAS unsigned*)(C.lds + (BUF) * 32768); const int w_ = C.wave, l_ = C.lane; \
        _Pragma("unroll") for (int i_ = 0; i_ < 8; ++i_) { const f32x4 x_ = V[i_]; \
            *(LAS u32x2*)(buf_ + (8 * w_ + i_) * 128 + ((2 * l_) ^ (8 * w_))) = (u32x2){cvt_pk_bf16(x_[0], x_[1]), cvt_pk_bf16(x_[2], x_[3])}; } \
        __syncthreads(); \
        const int c_ = C.tid & 7, g0_ = C.tid >> 3; \
        _Pragma("unroll") for (int ps_ = 0; ps_ < 2; ++ps_) { const int g_ = g0_ + 64 * ps_; unsigned d_[8]; \
            _Pragma("unroll") for (int j_ = 0; j_ < 8; ++j_) d_[j_] = buf_[(8 * c_ + j_) * 128 + (g_ ^ (8 * c_))]; \
            u32x4 o0_, o1_; \
            _Pragma("unroll") for (int j_ = 0; j_ < 4; ++j_) { o0_[j_] = (d_[2 * j_] & 0xffffu) | (d_[2 * j_ + 1] << 16); o1_[j_] = (d_[2 * j_] >> 16) | (d_[2 * j_ + 1] & 0xffff0000u); } \
            __builtin_nontemporal_store(o0_, (u32x4*)((I).dst + (size_t)(2 * g_) * (I).ldd + 8 * c_)); __builtin_nontemporal_store(o1_, (u32x4*)((I).dst + (size_t)(2 * g_ + 1) * (I).ldd + 8 * c_)); } } while (0)
__device__ __forceinline__ void dense_weights_to_bf16(const Ctx& C, int lo, int N) {
    f32x4 va[8], vb[8]; DenItem Ia, Ib;
    int it = lo + C.wg; asm volatile("" : "+s"(it));
    if (it < N) { Ia = den_item(C, it); DEN_LOAD(va, Ia); }
    while (it < N) {
        const int itb = it + C.nwg;
        if (itb < N) { Ib = den_item(C, itb); DEN_LOAD(vb, Ib); }
        DEN_PROC(va, Ia, 0);
        if (itb >= N) break;
        const int ita = itb + C.nwg;
        if (ita < N) { Ia = den_item(C, ita); DEN_LOAD(va, Ia); }
        DEN_PROC(vb, Ib, 1);
        it = ita;
    }
    __syncthreads();
}
#undef DEN_LOAD
#undef DEN_PROC

__device__ __forceinline__ f32x2 rope_cs(float a) {
    const float k = rintf(a * 0.15915494309189535f);
    float r = fmaf(-k, 6.2831854820251465f, a); r = fmaf(-k, -1.7484555e-7f, r);
    const float tr = r * 0.15915494309189535f;
    return (f32x2){__builtin_amdgcn_cosf(tr), __builtin_amdgcn_sinf(tr)};
}
__device__ __forceinline__ void phase_prologue(const Ctx& C) {
    LAS float* scr = (LAS float*)(C.lds + C.wave * 16384);
    const int gw = C.wg * NWAVES + C.wave, NGW = C.nwg * NWAVES;
    dense_weights_to_bf16(C, 0, DI_WIN);
    const int gt = C.wg * NTHR + C.tid, NGT = C.nwg * NTHR;
    f32x2* rr = (f32x2*)(C.ws + WS_ROPER); f32x2* rm = (f32x2*)(C.ws + WS_ROPEM);
    for (int i = gt; i < T * 128; i += NGT) { const int t = i >> 7, j = i & 127; const float inv = exp2f(-(float)j * (13.287712379549449f / 128.f)); const float a = (float)C.pos[t] * inv; rr[i] = rope_cs(a); }
    for (int i = gt; i < T * 32; i += NGT) { const int t = i >> 5, j = i & 31; const float inv = exp2f(-(float)j * (13.287712379549449f / 32.f)); const float a = (float)C.pos[t] * inv; rm[i] = rope_cs(a); }
}

template <int MODE, bool Q8 = false>
__device__ __forceinline__ void phase_norm(const Ctx& C, const float* xin, const float* gain, bf16_t* hout, const float* w8, int w8ld) {
    LAS float* wT = (LAS float*)C.lds;
    LAS int* lcnt = (LAS int*)(C.lds + 65536);
    if (MODE != 0) {
        for (int k = C.tid; k < D; k += NTHR) { const f32x4 a = *(const f32x4*)(w8 + (size_t)k * w8ld), b = *(const f32x4*)(w8 + (size_t)k * w8ld + 4);
            wT[0 * D + k] = a[0]; wT[1 * D + k] = a[1]; wT[2 * D + k] = a[2]; wT[3 * D + k] = a[3]; wT[4 * D + k] = b[0]; wT[5 * D + k] = b[1]; wT[6 * D + k] = b[2]; wT[7 * D + k] = b[3]; }
        if (MODE == 2 && C.tid < 8) lcnt[C.tid] = 0;
        __syncthreads();
    }
    const int rows_per_wg = T / C.nwg;
    const int lane = C.lane;
    for (int rl = C.wave; rl < rows_per_wg; rl += NWAVES) {
        const int t = C.wg * rows_per_wg + rl;
        const f32x4* xr = (const f32x4*)(xin + (size_t)t * D) + lane; const u32x2* xb = (const u32x2*)((const bf16_t*)xin + (size_t)t * D) + lane;
        f32x4 v[8]; float ss = 0.f;
#pragma unroll
        for (int j = 0; j < 8; ++j) { if (MODE == 2) { const u32x2 z = xb[64 * j]; v[j] = (f32x4){bflo(z.x), bfhi(z.x), bflo(z.y), bfhi(z.y)}; } else v[j] = (MODE == 1) ? __builtin_nontemporal_load(xr + 64 * j) : xr[64 * j]; ss += (v[j][0] * v[j][0] + v[j][1] * v[j][1]) + (v[j][2] * v[j][2] + v[j][3] * v[j][3]); }
        const float rstd = rsqrtf(wave_sum(ss) * (1.f / D) + EPS);
#pragma unroll
        for (int j = 0; j < 8; ++j) { const f32x4 g = *((const f32x4*)gain + lane + 64 * j); v[j] = v[j] * rstd * g; if (Q8) { v[j][0] = q8f(v[j][0], 1.f, 1.f); v[j][1] = q8f(v[j][1], 1.f, 1.f); v[j][2] = q8f(v[j][2], 1.f, 1.f); v[j][3] = q8f(v[j][3], 1.f, 1.f); } }
        if (MODE == 2) { unsigned* o4 = (unsigned*)((unsigned char*)hout + (size_t)t * D) + lane;
#pragma unroll
            for (int j = 0; j < 8; ++j) o4[64 * j] = pk4_fp8(v[j][0], v[j][1], v[j][2], v[j][3]);
        } else { u32x2* o8 = (u32x2*)(hout + (size_t)t * D) + lane;
#pragma unroll
            for (int j = 0; j < 8; ++j) o8[64 * j] = (u32x2){cvt_pk_bf16(v[j][0], v[j][1]), cvt_pk_bf16(v[j][2], v[j][3])}; }
        if (MODE != 0) {
            float dot[8];
#pragma unroll
            for (int q = 0; q < 8; ++q) { float s = 0.f;
#pragma unroll
                for (int j = 0; j < 8; ++j) { const f32x4 w = *(const LAS f32x4*)(wT + q * D + 256 * j + 4 * lane); s += (v[j][0] * w[0] + v[j][1] * w[1]) + (v[j][2] * w[2] + v[j][3] * w[3]); }
                dot[q] = wave_sum(s); }
            if (MODE == 1) {
                if (lane < 4) { float gi = 0.f, gf = 0.f;
#pragma unroll
                    for (int q = 0; q < 4; ++q) { if (lane == q) { gi = dot[q]; gf = dot[4 + q]; } }
                    gi += C.b_gates[lane]; gf += C.b_gates[4 + lane];
                    const float lf = fminf(gf, 0.f) - log1pf(__expf(-fabsf(gf)));
                    ((float*)(C.ws + WS_GI))[t * 4 + lane] = gi; ((float*)(C.ws + WS_GF))[t * 4 + lane] = lf; }
            } else {
                int e1 = 0; float v1 = dot[0];
#pragma unroll
                for (int q = 1; q < 8; ++q) if (dot[q] > v1) { v1 = dot[q]; e1 = q; }
                int e2 = -1; float v2 = -3.0e38f;
#pragma unroll
                for (int q = 0; q < 8; ++q) if (q != e1 && dot[q] > v2) { v2 = dot[q]; e2 = q; }
                const float w2 = 1.f / (1.f + __expf(v1 - v2)), w1 = 1.f - w2;
                if (lane == 0) { ((int*)(C.ws + WS_RTE))[2 * t] = e1; ((int*)(C.ws + WS_RTE))[2 * t + 1] = e2; ((float*)(C.ws + WS_RTW))[2 * t] = w1; ((float*)(C.ws + WS_RTW))[2 * t + 1] = w2;
                    atomicAdd((int*)(lcnt + e1), 1); atomicAdd((int*)(lcnt + e2), 1); }
            }
        }
    }
    if (MODE == 2) { __syncthreads(); if (C.tid < 8) ((int*)(C.ws + WS_CNT))[C.wg * 8 + C.tid] = lcnt[C.tid]; }
    __syncthreads();
}
__device__ __forceinline__ int crow(int r, int hi) { return (r & 3) + 8 * (r >> 2) + 4 * hi; }
__device__ __forceinline__ f32x16 mfma32(bf16x8 a, bf16x8 b, f32x16 c) { return __builtin_amdgcn_mfma_f32_32x32x16_bf16(a, b, c, 0, 0, 0); }
#define PK4(P, B_, OUT) do { unsigned a0_ = cvt_pk_bf16(P[B_ + 0], P[B_ + 1]), a1_ = cvt_pk_bf16(P[B_ + 2], P[B_ + 3]);                 \
        unsigned b0_ = cvt_pk_bf16(P[B_ + 4], P[B_ + 5]), b1_ = cvt_pk_bf16(P[B_ + 6], P[B_ + 7]);                                      \
        auto r0_ = __builtin_amdgcn_permlane32_swap(a0_, b0_, false, false); auto r1_ = __builtin_amdgcn_permlane32_swap(a1_, b1_, false, false); \
        u32x4 w_ = {r0_[0], r1_[0], r0_[1], r1_[1]}; OUT = *reinterpret_cast<bf16x8*>(&w_); } while (0)
__device__ __forceinline__ float half_swap_add(float v) { auto rr = __builtin_amdgcn_permlane32_swap(__float_as_uint(v), __float_as_uint(v), false, false); return __uint_as_float(rr[0]) + __uint_as_float(rr[1]); }
__device__ __forceinline__ float half_swap_max(float v) { auto rr = __builtin_amdgcn_permlane32_swap(__float_as_uint(v), __float_as_uint(v), false, false); return fmaxf(__uint_as_float(rr[0]), __uint_as_float(rr[1])); }
__device__ __forceinline__ float ret_log2gamma(int h) { return log2f(1.f - exp2f(-5.f - (float)h)); }

__device__ __forceinline__ void mlstm_scalar_scan(const Ctx& C, int bh) {
    const int b = bh >> 2, h = bh & 3, lane = C.lane, tid = C.tid;
    const float* gi = (const float*)(C.ws + WS_GI); const float* gf = (const float*)(C.ws + WS_GF);
    float* bcw = (float*)(C.ws + WS_BC); float* wl = (float*)(C.ws + WS_WL); float* mprev = (float*)(C.ws + WS_MPREV); float* decv = (float*)(C.ws + WS_DEC);
    constexpr int P = LM + 1;
    LAS float* fl = (LAS float*)C.lds; LAS float* il = fl + NCM * P;
#pragma unroll
    for (int j = 0; j < 8; ++j) { const int pos = tid + 512 * j, t = b * SEQ + pos; fl[(pos / LM) * P + (pos % LM)] = gf[t * 4 + h]; il[(pos / LM) * P + (pos % LM)] = gi[t * 4 + h]; }
    __syncthreads();
    if (C.wave == 0) {
        const int ck = lane < NCM ? lane : NCM - 1;
        const LAS float* fr_ = fl + ck * P; const LAS float* ir_ = il + ck * P;
        float bc = 0.f, mxp = -__builtin_inff();
        for (int l = 0; l < LM; ++l) { bc += fr_[l]; mxp = fmaxf(mxp, ir_[l] - bc); }
        const float g = bc, mx = g + mxp;
        float m = -__builtin_inff(), mp_l = 0.f, mn_l = 0.f;
        for (int k = 0; k < NCM; ++k) { const float gk = __builtin_bit_cast(float, __builtin_amdgcn_readlane(__builtin_bit_cast(int, g), k)), mxk = __builtin_bit_cast(float, __builtin_amdgcn_readlane(__builtin_bit_cast(int, mx), k));
            const float mp = m; m = fmaxf(gk + m, mxk); if (lane == k) { mp_l = mp; mn_l = m; } }
        if (lane < NCM) { mprev[bh * 64 + lane] = mp_l; decv[bh * 64 + lane] = (mp_l == -__builtin_inff()) ? 0.f : __expf(g + mp_l - mn_l);
            LAS float* fw = fl + lane * P; LAS float* iw = il + lane * P;
            bc = 0.f;
            for (int l = 0; l < LM; ++l) { bc += fw[l]; const float w = __expf(g - bc + iw[l] - mn_l); fw[l] = bc; iw[l] = w; } }
    }
    __syncthreads();
#pragma unroll
    for (int j = 0; j < 8; ++j) { const int pos = tid + 512 * j, t = b * SEQ + pos; bcw[t * 4 + h] = fl[(pos / LM) * P + (pos % LM)]; wl[t * 4 + h] = il[(pos / LM) * P + (pos % LM)]; }
    __syncthreads();
}

constexpr int CONVTAB_OFF = 143360;
__device__ __forceinline__ void conv_taps_to_lds(const Ctx& C, int h, int tid) {
    LAS float* tab = (LAS float*)(C.lds + CONVTAB_OFF);
#pragma unroll
    for (int i = 0; i < 4; ++i) { const int idx = tid + 512 * i, which = idx >> 10, tap = (idx >> 8) & 3, c = idx & 255; tab[idx] = C.conv_w[tap * 2048 + which * 1024 + h * 256 + c]; }
}
__device__ __forceinline__ void conv8_silu(const bf16_t* zc, int t, int s, const LAS float* wt, float sc, float (&y)[8]) {
#pragma unroll
    for (int i = 0; i < 8; ++i) y[i] = 0.f;
#pragma unroll
    for (int tap = 0; tap < 4; ++tap) if (s - 3 + tap >= 0) { const u32x4 z = *(const u32x4*)(zc + (size_t)(t - 3 + tap) * 8192);
        const f32x4 w0 = *(const LAS f32x4*)(wt + tap * 256), w1 = *(const LAS f32x4*)(wt + tap * 256 + 4);
        y[0] += bflo(z.x) * w0[0]; y[1] += bfhi(z.x) * w0[1]; y[2] += bflo(z.y) * w0[2]; y[3] += bfhi(z.y) * w0[3];
        y[4] += bflo(z.z) * w1[0]; y[5] += bfhi(z.z) * w1[1]; y[6] += bflo(z.w) * w1[2]; y[7] += bfhi(z.w) * w1[3]; }
#pragma unroll
    for (int i = 0; i < 8; ++i) y[i] = silu_f(y[i]) * sc;
}

template <bool RET>
__device__ __forceinline__ void mixer_contrib_unit(const Ctx& C, int bh, int k) {
    constexpr int L = RET ? LR : LM, NC = RET ? NCR : NCM, NHALF = L / 64, PITCH = 72;
    const int b = bh >> 2, h = bh & 3, t0 = b * SEQ + k * L;
    int lane_ = C.lane; asm volatile("" : "+v"(lane_));
    const int lane = lane_, wave = C.wave, tid = wave * 64 + lane, c32 = lane & 31, hi = lane >> 5;
    const bf16_t* ksrc = (const bf16_t*)(C.ws + WS_Z) + (RET ? 5120 : 1024) + h * 256;
    const bf16_t* vsrc = (const bf16_t*)(C.ws + WS_Z) + (RET ? 6144 : 2048) + h * 256;
    bf16_t* UT = (bf16_t*)(C.ws + (RET ? WS_STR : WS_STM)) + ((size_t)bh * NC + k) * 65536;
    LAS bf16_t* vT = (LAS bf16_t*)C.lds; LAS bf16_t* kT = (LAS bf16_t*)(C.lds + 36864);
    const float* wl = (const float*)(C.ws + WS_WL);
    const float lg2 = ret_log2gamma(h);
    f32x16 acc[8];
#pragma unroll
    for (int i = 0; i < 8; ++i) acc[i] = f32x16{};
    float unacc = 0.f;
    if (!RET) { conv_taps_to_lds(C, h, tid); __syncthreads(); }
    for (int hf = 0; hf < NHALF; ++hf) {
#pragma unroll
        for (int i = 0; i < 4; ++i) { const int c = tid + 512 * i, l = c & 63, c8 = c >> 6, lt = hf * 64 + l, t = t0 + lt;
            const u32x4 vz = *(const u32x4*)(vsrc + (size_t)t * 8192 + 8 * c8);
            const float w = RET ? __builtin_amdgcn_exp2f(lg2 * (float)(L - 1 - lt)) : wl[t * 4 + h];
            unsigned k0, k1, k2, k3;
            if (RET) { const u32x4 kz = *(const u32x4*)(ksrc + (size_t)t * 8192 + 8 * c8);
                k0 = cvt_pk_bf16(bflo(kz.x) * w, bfhi(kz.x) * w); k1 = cvt_pk_bf16(bflo(kz.y) * w, bfhi(kz.y) * w); k2 = cvt_pk_bf16(bflo(kz.z) * w, bfhi(kz.z) * w); k3 = cvt_pk_bf16(bflo(kz.w) * w, bfhi(kz.w) * w); }
            else { float y[8]; conv8_silu(ksrc + 8 * c8, t, t & (SEQ - 1), (const LAS float*)(C.lds + CONVTAB_OFF) + 1024 + 8 * c8, 0.0625f * w, y);
                k0 = cvt_pk_bf16(y[0], y[1]); k1 = cvt_pk_bf16(y[2], y[3]); k2 = cvt_pk_bf16(y[4], y[5]); k3 = cvt_pk_bf16(y[6], y[7]); }
            LAS bf16_t* kd = kT + (8 * c8) * PITCH + l; LAS bf16_t* vd = vT + (8 * c8) * PITCH + l;
            kd[0 * PITCH] = (bf16_t)(k0 & 0xffff); kd[1 * PITCH] = (bf16_t)(k0 >> 16); kd[2 * PITCH] = (bf16_t)(k1 & 0xffff); kd[3 * PITCH] = (bf16_t)(k1 >> 16);
            kd[4 * PITCH] = (bf16_t)(k2 & 0xffff); kd[5 * PITCH] = (bf16_t)(k2 >> 16); kd[6 * PITCH] = (bf16_t)(k3 & 0xffff); kd[7 * PITCH] = (bf16_t)(k3 >> 16);
            vd[0 * PITCH] = (bf16_t)(vz.x & 0xffff); vd[1 * PITCH] = (bf16_t)(vz.x >> 16); vd[2 * PITCH] = (bf16_t)(vz.y & 0xffff); vd[3 * PITCH] = (bf16_t)(vz.y >> 16);
            vd[4 * PITCH] = (bf16_t)(vz.z & 0xffff); vd[5 * PITCH] = (bf16_t)(vz.z >> 16); vd[6 * PITCH] = (bf16_t)(vz.w & 0xffff); vd[7 * PITCH] = (bf16_t)(vz.w >> 16); }
        __syncthreads();
#pragma unroll
        for (int ks = 0; ks < 4; ++ks) {
            const bf16x8 af = *(const LAS bf16x8*)(vT + (32 * wave + c32) * PITCH + 16 * ks + 8 * hi);
#pragma unroll
            for (int db = 0; db < 8; ++db) { const bf16x8 bfr = *(const LAS bf16x8*)(kT + (32 * db + c32) * PITCH + 16 * ks + 8 * hi); acc[db] = mfma32(af, bfr, acc[db]); }
        }
        if (!RET && tid < 256) {
#pragma unroll
            for (int q = 0; q < 8; ++q) { const u32x4 z = *(const LAS u32x4*)(kT + tid * PITCH + 8 * q);
                unacc += (bflo(z.x) + bfhi(z.x)) + (bflo(z.y) + bfhi(z.y)) + (bflo(z.z) + bfhi(z.z)) + (bflo(z.w) + bfhi(z.w)); } }
        __syncthreads();
    }
    LAS unsigned char* Wl = C.lds + wave * 16384;
#pragma unroll
    for (int db = 0; db < 8; ++db)
#pragma unroll
        for (int r = 0; r < 16; r += 2) { const float send = (lane & 1) ? acc[db][r] : acc[db][r + 1]; const float recv = __shfl_xor(send, 1);
            const unsigned val = (lane & 1) ? cvt_pk_bf16(recv, acc[db][r + 1]) : cvt_pk_bf16(acc[db][r], recv);
            *(LAS unsigned*)(Wl + crow(r + (lane & 1), hi) * 512 + (32 * db + (c32 & ~1)) * 2) = val; if (r == 14) __builtin_amdgcn_sched_barrier(0); }
    LDS_WAIT();
#pragma unroll
    for (int j = 0; j < 16; ++j) { const int idx = lane + 64 * j, row = idx >> 5, ch = idx & 31;
        *(u32x4*)(UT + (size_t)(32 * wave + row) * 256 + 8 * ch) = *(const LAS u32x4*)(Wl + row * 512 + ch * 16); }
    if (!RET && tid < 256) ((float*)(C.ws + WS_UN))[((size_t)bh * NCM + k) * 256 + tid] = unacc;
    __syncthreads();
}
__device__ __forceinline__ void phase_contrib(const Ctx& C) {
    constexpr int NU = 8 * NCM + 8 * NCR;
    for (int u = C.wg; u < NU; u += C.nwg) {
        if (u < 8 * NCM) mixer_contrib_unit<false>(C, u / NCM, u % NCM); else mixer_contrib_unit<true>(C, (u - 8 * NCM) / NCR, (u - 8 * NCM) % NCR);
    }
}

__device__ __forceinline__ void phase_scan(const Ctx& C) {
    const int gt = C.wg * NTHR + C.tid, NGT = C.nwg * NTHR;
    const float* decv = (const float*)(C.ws + WS_DEC);
    for (int it = gt; it < 2 * 65536; it += NGT) {
        const bool ret = it >= 65536; const int r = it & 65535, bh = r >> 13, c = r & 8191;
        const int nc = ret ? NCR : NCM;
        bf16_t* base = (bf16_t*)(C.ws + (ret ? WS_STR : WS_STM)) + (size_t)bh * nc * 65536 + c * 8;
        const float cdec = exp2f(ret_log2gamma(bh & 3) * (float)LR);
        float run[8];
#pragma unroll
        for (int i = 0; i < 8; ++i) run[i] = 0.f;
#pragma unroll 4
        for (int k = 0; k < nc; ++k) {
            u32x4* p = (u32x4*)(base + (size_t)k * 65536); const u32x4 u = *p;
            *p = (u32x4){cvt_pk_bf16(run[0], run[1]), cvt_pk_bf16(run[2], run[3]), cvt_pk_bf16(run[4], run[5]), cvt_pk_bf16(run[6], run[7])};
            const float dec = ret ? cdec : decv[bh * 64 + k];
            run[0] = run[0] * dec + bflo(u.x); run[1] = run[1] * dec + bfhi(u.x); run[2] = run[2] * dec + bflo(u.y); run[3] = run[3] * dec + bfhi(u.y);
            run[4] = run[4] * dec + bflo(u.z); run[5] = run[5] * dec + bfhi(u.z); run[6] = run[6] * dec + bflo(u.w); run[7] = run[7] * dec + bfhi(u.w);
        }
    }
    for (int it = gt; it < 8 * 256; it += NGT) { const int bh = it >> 8, d = it & 255; float* un = (float*)(C.ws + WS_UN) + (size_t)bh * NCM * 256 + d; float u[NCM], dc[NCM];
#pragma unroll
        for (int k = 0; k < NCM; ++k) { u[k] = un[k * 256]; dc[k] = decv[bh * 64 + k]; }
        float run = 0.f;
#pragma unroll
        for (int k = 0; k < NCM; ++k) { const float uk = u[k]; u[k] = run; run = run * dc[k] + uk; }
#pragma unroll
        for (int k = 0; k < NCM; ++k) un[k * 256] = u[k]; }
}

template <bool RET>
__device__ __forceinline__ void mixer_out_unit(const Ctx& C, int bh, int k) {
    constexpr int L = RET ? LR : LM, NLB = L / 32, NEG = 8 / NLB, NEB = 8 / NEG, NC = RET ? NCR : NCM, PITCH = L + 8, KP = 264;
    const int b = bh >> 2, h = bh & 3, t0 = b * SEQ + k * L;
    int lane_ = C.lane; asm volatile("" : "+v"(lane_));
    const int lane = lane_, wave = C.wave, tid = wave * 64 + lane, c32 = lane & 31, hi = lane >> 5;
    const int lb = wave % NLB, eg = wave / NLB;
    const bf16_t* Z = (const bf16_t*)(C.ws + WS_Z);
    const bf16_t* qsrc = Z + (RET ? 4096 : 0) + h * 256;
    const bf16_t* ksrc = Z + (RET ? 5120 : 1024) + h * 256;
    const bf16_t* vsrc = Z + (RET ? 6144 : 2048) + h * 256;
    const bf16_t* gsrc = Z + (RET ? 7168 : 3072) + h * 256;
    const bf16_t* ST = (const bf16_t*)(C.ws + (RET ? WS_STR : WS_STM)) + ((size_t)bh * NC + k) * 65536;
    const float* gain = (RET ? C.g_ro : C.g_mo) + h * 256;
    bf16_t* MIX = (bf16_t*)(C.ws + WS_MIX) + (RET ? 1024 : 0) + h * 256;
    LAS bf16_t* Kl = (LAS bf16_t*)C.lds;
    constexpr int KBYTES = L * KP * 2, TAB = KBYTES + 256 * PITCH * 2;
    LAS bf16_t* vT = (LAS bf16_t*)(C.lds + KBYTES);
    LAS float* a_s = (LAS float*)(C.lds + TAB);
    LAS float* nprev = a_s + 128;
    LAS float* rowtab = nprev + 256;
    const int lrow = 32 * lb + c32;
    bf16x8 qr[16], sf[16];
    if (RET) {
#pragma unroll
        for (int ks = 0; ks < 16; ++ks) qr[ks] = *(const bf16x8*)(qsrc + (size_t)(t0 + lrow) * 8192 + 16 * ks + 8 * hi);
    } else conv_taps_to_lds(C, h, tid);
#pragma unroll
    for (int ks = 0; ks < 16; ++ks) sf[ks] = *(const bf16x8*)(ST + (size_t)(eg * NEB * 32 + c32) * 256 + 16 * ks + 8 * hi);
    if (RET) {
#pragma unroll
        for (int i = 0; i < L / 16; ++i) { const int c = tid + 512 * i, row = c >> 5, ch = c & 31;
            *(LAS u32x4*)(Kl + row * KP + 8 * ch) = *(const u32x4*)(ksrc + (size_t)(t0 + row) * 8192 + 8 * ch); }
    } else {
        __syncthreads();
        const LAS float* taps = (const LAS float*)(C.lds + CONVTAB_OFF);
#pragma unroll
        for (int i = 0; i < L / 16; ++i) { const int c = tid + 512 * i, row = c >> 5, ch = c & 31, t = t0 + row; float y[8];
            conv8_silu(qsrc + 8 * ch, t, t & (SEQ - 1), taps + 8 * ch, 1.f, y);
            *(LAS u32x4*)(Kl + row * KP + 8 * ch) = (u32x4){cvt_pk_bf16(y[0], y[1]), cvt_pk_bf16(y[2], y[3]), cvt_pk_bf16(y[4], y[5]), cvt_pk_bf16(y[6], y[7])}; }
        __syncthreads();
#pragma unroll
        for (int ks = 0; ks < 16; ++ks) qr[ks] = *(const LAS bf16x8*)(Kl + lrow * KP + 16 * ks + 8 * hi);
        __syncthreads();
#pragma unroll
        for (int i = 0; i < L / 16; ++i) { const int c = tid + 512 * i, row = c >> 5, ch = c & 31, t = t0 + row; float y[8];
            conv8_silu(ksrc + 8 * ch, t, t & (SEQ - 1), taps + 1024 + 8 * ch, 0.0625f, y);
            *(LAS u32x4*)(Kl + row * KP + 8 * ch) = (u32x4){cvt_pk_bf16(y[0], y[1]), cvt_pk_bf16(y[2], y[3]), cvt_pk_bf16(y[4], y[5]), cvt_pk_bf16(y[6], y[7])}; }
    }
#pragma unroll
    for (int i = 0; i < L / 16; ++i) { const int c = tid + 512 * i, l = c & (L - 1), c8 = c / L;
        const u32x4 vz = *(const u32x4*)(vsrc + (size_t)(t0 + l) * 8192 + 8 * c8); LAS bf16_t* vd = vT + (8 * c8) * PITCH + l;
        vd[0 * PITCH] = (bf16_t)(vz.x & 0xffff); vd[1 * PITCH] = (bf16_t)(vz.x >> 16); vd[2 * PITCH] = (bf16_t)(vz.y & 0xffff); vd[3 * PITCH] = (bf16_t)(vz.y >> 16);
        vd[4 * PITCH] = (bf16_t)(vz.z & 0xffff); vd[5 * PITCH] = (bf16_t)(vz.z >> 16); vd[6 * PITCH] = (bf16_t)(vz.w & 0xffff); vd[7 * PITCH] = (bf16_t)(vz.w >> 16); }
    float mprev = 0.f;
    if (!RET) {
        if (tid < L) a_s[tid] = ((const float*)(C.ws + WS_GI))[(t0 + tid) * 4 + h] - ((const float*)(C.ws + WS_BC))[(t0 + tid) * 4 + h];
        if (tid < 256) nprev[tid] = ((const float*)(C.ws + WS_UN))[((size_t)bh * NCM + k) * 256 + tid];
        mprev = ((const float*)(C.ws + WS_MPREV))[bh * 64 + k];
    }
    __syncthreads();
    float rowf, rowd, M = 0.f, bl = 0.f, dsum = 0.f;
    const float lg2 = ret_log2gamma(h);
    if (!RET) {
        float pm = -__builtin_inff();
        for (int s = 0; s < L; ++s) { const float a = a_s[s]; if (s <= lrow) pm = fmaxf(pm, a); }
        M = fmaxf(pm, mprev);
        bl = ((const float*)(C.ws + WS_BC))[(t0 + lrow) * 4 + h];
    }
    bf16x8 pa[2 * NLB];
#pragma unroll
    for (int sb = 0; sb < NLB; ++sb) {
        f32x16 p = f32x16{};
        if (sb <= lb) {
#pragma unroll
            for (int ks = 0; ks < 16; ++ks) { const bf16x8 kf = *(const LAS bf16x8*)(Kl + (32 * sb + c32) * KP + 16 * ks + 8 * hi); p = mfma32(kf, qr[ks], p); }
#pragma unroll
            for (int r = 0; r < 16; ++r) { const int s = 32 * sb + crow(r, hi);
                if (!RET) { const float dm = (s <= lrow) ? __expf(a_s[s] - M) : 0.f; p[r] *= dm; dsum += p[r]; }
                else p[r] = (s <= lrow) ? p[r] * __builtin_amdgcn_exp2f(lg2 * (float)(lrow - s)) : 0.f; }
        }
        PK4(p, 0, pa[2 * sb]); PK4(p, 8, pa[2 * sb + 1]);
        __builtin_amdgcn_sched_barrier(0);
    }
    if (!RET) {
        const float inter = (mprev == -__builtin_inff()) ? 0.f : __expf(mprev - M);
        dsum = half_swap_add(dsum);
        float qn = 0.f;
#pragma unroll
        for (int ks = 0; ks < 16; ++ks) { const u32x4 qz = *reinterpret_cast<const u32x4*>(&qr[ks]); const LAS float* np = nprev + 16 * ks + 8 * hi;
            qn += (bflo(qz.x) * np[0] + bfhi(qz.x) * np[1]) + (bflo(qz.y) * np[2] + bfhi(qz.y) * np[3]) + (bflo(qz.z) * np[4] + bfhi(qz.z) * np[5]) + (bflo(qz.w) * np[6] + bfhi(qz.w) * np[7]); }
        qn = half_swap_add(qn);
        const float den = dsum + inter * qn;
        rowf = inter; rowd = 1.f / fmaxf(fabsf(den), __expf(-bl - M));
    } else { rowf = exp2f(lg2 * (float)(lrow + 1)); rowd = 1.f; }
    LAS float* rt = rowtab + wave * 64;
    if (hi == 0) { rt[c32] = rowf; rt[32 + c32] = rowd; }
    __syncthreads();
#pragma unroll
    for (int eb = 0; eb < NEB; ++eb) {
        const int e0 = (eg * NEB + eb) * 32;
        f32x16 n1 = f32x16{}, n2 = f32x16{};
#pragma unroll
        for (int ks = 0; ks < 16; ++ks) { n2 = mfma32(qr[ks], sf[ks], n2);
            if (eb + 1 < NEB) sf[ks] = *(const bf16x8*)(ST + (size_t)(e0 + 32 + c32) * 256 + 16 * ks + 8 * hi); }
#pragma unroll
        for (int sb = 0; sb < NLB; ++sb) if (sb <= lb) {
#pragma unroll
            for (int kk = 0; kk < 2; ++kk) { const bf16x8 vf = *(const LAS bf16x8*)(vT + (e0 + c32) * PITCH + 32 * sb + 16 * kk + 8 * hi); n1 = mfma32(pa[2 * sb + kk], vf, n1); } }
#pragma unroll
        for (int r = 0; r < 16; ++r) { const int rl = crow(r, hi); Kl[(32 * lb + rl) * KP + e0 + c32] = f2bf((n1[r] + rt[rl] * n2[r]) * rt[32 + rl]); }
        __builtin_amdgcn_sched_barrier(0);
    }
    __syncthreads();
#pragma unroll
    for (int l8 = 0; l8 < L / NWAVES; l8 += 8) {
        f32x4 v[8]; u32x2 gz[8];
#pragma unroll
        for (int j = 0; j < 8; ++j) { const int l = wave + NWAVES * (l8 + j), t = t0 + l; const u32x2 hz = *(const LAS u32x2*)(Kl + l * KP + 4 * lane); v[j] = (f32x4){bflo(hz.x), bfhi(hz.x), bflo(hz.y), bfhi(hz.y)};
            gz[j] = *(const u32x2*)(gsrc + (size_t)t * 8192 + 4 * lane); }
        const f32x4 gn = *(const f32x4*)(gain + 4 * lane);
#pragma unroll
        for (int j = 0; j < 8; ++j) { const int t = t0 + wave + NWAVES * (l8 + j);
            const float g0 = bflo(gz[j].x), g1 = bfhi(gz[j].x), g2 = bflo(gz[j].y), g3 = bfhi(gz[j].y); f32x4 x = v[j];
            if (!RET) { x[0] *= sigmoid_f(g0); x[1] *= sigmoid_f(g1); x[2] *= sigmoid_f(g2); x[3] *= sigmoid_f(g3); }
            const float rstd = rsqrtf(wave_sum((x[0] * x[0] + x[1] * x[1]) + (x[2] * x[2] + x[3] * x[3])) * (1.f / 256.f) + EPS);
            x = x * rstd * gn;
            if (RET) { x[0] *= silu_f(g0); x[1] *= silu_f(g1); x[2] *= silu_f(g2); x[3] *= silu_f(g3); }
            *(u32x2*)(MIX + (size_t)t * 2048 + 4 * lane) = (u32x2){cvt_pk_bf16(x[0], x[1]), cvt_pk_bf16(x[2], x[3])}; }
    }
    __syncthreads();
}
__device__ __forceinline__ void phase_mixout(const Ctx& C) {
    constexpr int NU = 8 * NCM + 8 * NCR;
    for (int u = C.wg; u < NU; u += C.nwg) {
#if !defined(MIX_ONLY) || MIX_ONLY == 0
        if (u < 8 * NCM) mixer_out_unit<false>(C, u / NCM, u % NCM);
#endif
#if !defined(MIX_ONLY) || MIX_ONLY == 1
        if (u >= 8 * NCM) mixer_out_unit<true>(C, (u - 8 * NCM) / NCR, (u - 8 * NCM) % NCR);
#endif
    }
}
__device__ __forceinline__ void phase_latent_norm(const Ctx& C) {
    const float* cq = (const float*)(C.ws + WS_CQKV); bf16_t* out = (bf16_t*)(C.ws + WS_CQKVN); bf16_t* kr = (bf16_t*)(C.ws + WS_KR);
    const f32x2* ropeM = (const f32x2*)(C.ws + WS_ROPEM);
    const int gw = C.wg * NWAVES + C.wave, NGW = C.nwg * NWAVES, lane = C.lane;
    for (int t = gw; t < T; t += NGW) {
        const float* row = cq + (size_t)t * NDQKV;
        const f32x4 a0 = *(const f32x4*)(row + 8 * lane), a1 = *(const f32x4*)(row + 8 * lane + 4);
        const f32x4 b0 = *(const f32x4*)(row + 512 + 8 * lane), b1 = *(const f32x4*)(row + 512 + 8 * lane + 4);
        const float kv = row[1024 + lane];
        const float sa = wave_sum((a0[0] * a0[0] + a0[1] * a0[1]) + (a0[2] * a0[2] + a0[3] * a0[3]) + (a1[0] * a1[0] + a1[1] * a1[1]) + (a1[2] * a1[2] + a1[3] * a1[3]));
        const float sb = wave_sum((b0[0] * b0[0] + b0[1] * b0[1]) + (b0[2] * b0[2] + b0[3] * b0[3]) + (b1[0] * b1[0] + b1[1] * b1[1]) + (b1[2] * b1[2] + b1[3] * b1[3]));
        const float sk = wave_sum(kv * kv);
        const float ra = rsqrtf(sa * (1.f / 512.f) + EPS), rb = rsqrtf(sb * (1.f / 512.f) + EPS), rk = rsqrtf(sk * (1.f / 64.f) + EPS);
        const f32x4 ga0 = *(const f32x4*)(C.g_cq + 8 * lane), ga1 = *(const f32x4*)(C.g_cq + 8 * lane + 4), gb0 = *(const f32x4*)(C.g_ckv + 8 * lane), gb1 = *(const f32x4*)(C.g_ckv + 8 * lane + 4);
        const f32x4 ya0 = a0 * ra * ga0, ya1 = a1 * ra * ga1, yb0 = b0 * rb * gb0, yb1 = b1 * rb * gb1;
        *(u32x4*)(out + (size_t)t * 1024 + 8 * lane) = (u32x4){cvt_pk_bf16(ya0[0], ya0[1]), cvt_pk_bf16(ya0[2], ya0[3]), cvt_pk_bf16(ya1[0], ya1[1]), cvt_pk_bf16(ya1[2], ya1[3])};
        *(u32x4*)(out + (size_t)t * 1024 + 512 + 8 * lane) = (u32x4){cvt_pk_bf16(yb0[0], yb0[1]), cvt_pk_bf16(yb0[2], yb0[3]), cvt_pk_bf16(yb1[0], yb1[1]), cvt_pk_bf16(yb1[2], yb1[3])};
        const float y = kv * rk * C.g_kr[lane]; const float partner = __shfl_xor(y, 32); const f32x2 cs = ropeM[(size_t)t * 32 + (lane & 31)];
        const float o = (lane < 32) ? (y * cs[0] - partner * cs[1]) : (y * cs[0] + partner * cs[1]);
        kr[(size_t)t * 64 + lane] = f2bf(o);
    }
}

__device__ __forceinline__ void unpack8(const u32x4 z, float (&f)[8]) { f[0] = bflo(z.x); f[1] = bfhi(z.x); f[2] = bflo(z.y); f[3] = bfhi(z.y); f[4] = bflo(z.z); f[5] = bfhi(z.z); f[6] = bflo(z.w); f[7] = bfhi(z.w); }
__device__ __forceinline__ u32x4 pack8f(const float (&f)[8]) { return (u32x4){cvt_pk_bf16(f[0], f[1]), cvt_pk_bf16(f[2], f[3]), cvt_pk_bf16(f[4], f[5]), cvt_pk_bf16(f[6], f[7])}; }
__device__ __forceinline__ float sum8sq(const float (&f)[8]) { return (f[0] * f[0] + f[1] * f[1]) + (f[2] * f[2] + f[3] * f[3]) + (f[4] * f[4] + f[5] * f[5]) + (f[6] * f[6] + f[7] * f[7]); }
__device__ __forceinline__ float xor4_dpp(float v, bool upper) { const float a = dpp_mov<0x104>(v), b = dpp_mov<0x114>(v); return upper ? b : a; }
__device__ __forceinline__ float red8(float v) { v += dpp_mov<0xB1>(v); v += dpp_mov<0x4E>(v); v += dpp_mov<0x141>(v); return v; }
constexpr size_t WS_KRB = WS_KA;
__device__ __forceinline__ void phase_kr_prep(const Ctx& C) {
    const int w_ = (C.nwg == 256) ? C.wg - 128 : C.wg;
    if (w_ < 0 || w_ * NTHR >= T * 8) return;
    const float* kr = (const float*)(C.ws + WS_KR); bf16_t* KRB = (bf16_t*)(C.ws + WS_KRB); const f32x2* ropeM = (const f32x2*)(C.ws + WS_ROPEM);
    for (int g = w_ * NTHR + C.tid; g < T * 8; g += C.nwg * NTHR) { const int t = g >> 3, sub = g & 7;
        const f32x4 kra = *(const f32x4*)(kr + (size_t)t * 64 + 8 * sub), krb = *(const f32x4*)(kr + (size_t)t * 64 + 8 * sub + 4);
        float kk[8] = {kra[0], kra[1], kra[2], kra[3], krb[0], krb[1], krb[2], krb[3]}; const float rkr = rsqrtf(red8(sum8sq(kk)) * (1.f / 64.f) + EPS); float ko[8];
#pragma unroll
        for (int i = 0; i < 8; ++i) kk[i] *= rkr * C.g_kr[8 * sub + i];
#pragma unroll
        for (int i = 0; i < 8; ++i) { const float partner = xor4_dpp(kk[i], sub >= 4); const f32x2 cs = ropeM[(size_t)t * 32 + 8 * (sub & 3) + i];
            ko[i] = (sub < 4) ? (kk[i] * cs[0] - partner * cs[1]) : (kk[i] * cs[0] + partner * cs[1]); }
        *(u32x4*)(KRB + (size_t)t * 64 + 8 * sub) = pack8f(ko); }
}
__device__ __forceinline__ void phase_qkv_heads(const Ctx& C) {
    const bf16_t* R = (const bf16_t*)(C.ws + WS_QKVR); const float* kr = (const float*)(C.ws + WS_KR);
    bf16_t* KRB = (bf16_t*)(C.ws + WS_KRB); bf16_t* VT = (bf16_t*)(C.ws + WS_VT);
    const f32x2* ropeM = (const f32x2*)(C.ws + WS_ROPEM);
    LAS bf16_t* vt = (LAS bf16_t*)C.lds;
    const int tid = C.tid, sl = tid >> 3, sub = tid & 7;
    for (int u = C.wg; u < NBATCH * MLA_H * (SEQ / 64); u += C.nwg) {
        const int sblk = u & 63, h = (u >> 6) & 15, b = u >> 10;
        const int s = sblk * 64 + sl, t = b * SEQ + s;
        const bf16_t* kvrow = R + (size_t)t * 7168 + 3072 + h * 256;
        const u32x4 zv0 = *(const u32x4*)(kvrow + 128 + 16 * sub), zv1 = *(const u32x4*)(kvrow + 128 + 16 * sub + 8);
        if (h == 0) {
            const f32x4 kra = *(const f32x4*)(kr + (size_t)t * 64 + 8 * sub), krb = *(const f32x4*)(kr + (size_t)t * 64 + 8 * sub + 4);
            float kk[8] = {kra[0], kra[1], kra[2], kra[3], krb[0], krb[1], krb[2], krb[3]}; const float rkr = rsqrtf(red8(sum8sq(kk)) * (1.f / 64.f) + EPS); float ko[8];
#pragma unroll
            for (int i = 0; i < 8; ++i) kk[i] *= rkr * C.g_kr[8 * sub + i];
#pragma unroll
            for (int i = 0; i < 8; ++i) { const float partner = xor4_dpp(kk[i], sub >= 4); const f32x2 cs = ropeM[(size_t)t * 32 + 8 * (sub & 3) + i];
                ko[i] = (sub < 4) ? (kk[i] * cs[0] - partner * cs[1]) : (kk[i] * cs[0] + partner * cs[1]); }
            *(u32x4*)(KRB + (size_t)t * 64 + 8 * sub) = pack8f(ko);
        }
        { const unsigned w[8] = {zv0.x, zv0.y, zv0.z, zv0.w, zv1.x, zv1.y, zv1.z, zv1.w};
#pragma unroll
          for (int i = 0; i < 8; ++i) { vt[(16 * sub + 2 * i) * 72 + sl] = (bf16_t)(w[i] & 0xffff); vt[(16 * sub + 2 * i + 1) * 72 + sl] = (bf16_t)(w[i] >> 16); } }
        __syncthreads();
        { const int d = tid >> 2, q4 = tid & 3; const LAS bf16_t* src = vt + d * 72 + 16 * q4;
          bf16_t* dst = VT + (((size_t)b * MLA_H + h) * VH + d) * SEQ + sblk * 64 + 16 * q4;
          *(u32x4*)dst = *(const LAS u32x4*)src; *(u32x4*)(dst + 8) = *(const LAS u32x4*)(src + 8); }
        __syncthreads();
    }
}

constexpr int ATT_KB = 25600, ATT_VB = 18432, ATT_VOFF = 2 * ATT_KB, ATT_ALOFF = ATT_VOFF + 3 * ATT_VB;
__device__ __forceinline__ void attn_block(const Ctx& C, int b, int h, int qb) {
    int lane_ = C.lane; asm volatile("" : "+v"(lane_));
    const int lane = lane_, wave = C.wave, tid = wave * 64 + lane, c32 = lane & 31, hi = lane >> 5;
    const bf16_t* Qg = (const bf16_t*)(C.ws + WS_QKVR) + (size_t)b * SEQ * 7168 + h * 192;
    const bf16_t* Kg = (const bf16_t*)(C.ws + WS_QKVR) + (size_t)b * SEQ * 7168 + 3072 + h * 256;
    const bf16_t* KRg = (const bf16_t*)(C.ws + WS_KRB) + (size_t)b * SEQ * 64;
    const bf16_t* Vg = (const bf16_t*)(C.ws + WS_VT) + (((size_t)b * MLA_H + h) * VH) * SEQ;
    bf16_t* Og = (bf16_t*)(C.ws + WS_AO) + (size_t)b * SEQ * 2048 + h * 128;
    LAS float* al = (LAS float*)(C.lds + ATT_ALOFF) + wave * 32;
    const int q0 = qb * 256, qw = q0 + 32 * wave, qpos = qw + c32;
        const int srow = tid >> 3, ssub = tid & 7;
    u32x4 sk[3], sv[2];
#define ATT_LOAD(k0_) do { const bf16_t* kp_ = Kg + (size_t)((k0_) + srow) * 7168 + 8 * ssub; const bf16_t* vp_ = Vg + (size_t)srow * SEQ + (k0_) + 8 * ssub; \
        sk[0] = *(const u32x4*)kp_; sk[1] = *(const u32x4*)(kp_ + 64); sk[2] = *(const u32x4*)(KRg + (size_t)((k0_) + srow) * 64 + 8 * ssub); sv[0] = *(const u32x4*)vp_; sv[1] = *(const u32x4*)(vp_ + (size_t)64 * SEQ); } while (0)
#define ATT_WRITE(kb_, vb_) do { LAS bf16_t* Kw = (LAS bf16_t*)(C.lds + (kb_) * ATT_KB) + srow * 200 + 8 * ssub; LAS bf16_t* Vw = (LAS bf16_t*)(C.lds + ATT_VOFF + (vb_) * ATT_VB) + srow * 72 + 8 * ssub; \
        float ka_[8], kb_f[8]; unpack8(sk[0], ka_); unpack8(sk[1], kb_f); const float rk_ = rsqrtf(red8(sum8sq(ka_) + sum8sq(kb_f)) * (1.f / 128.f) + EPS); \
        _Pragma("unroll") for (int i_ = 0; i_ < 8; ++i_) { ka_[i_] *= rk_; kb_f[i_] *= rk_; } \
        *(LAS u32x4*)Kw = pack8f(ka_); *(LAS u32x4*)(Kw + 64) = pack8f(kb_f); *(LAS u32x4*)(Kw + 128) = sk[2]; *(LAS u32x4*)Vw = sv[0]; *(LAS u32x4*)(Vw + 64 * 72) = sv[1]; } while (0)
    bf16x8 qr[12];
    { constexpr float QSCALE = 0.07216878364870322f * 1.4426950408889634f;
      const bf16_t* qrow = Qg + (size_t)qpos * 7168; float ssn = 0.f, ssr = 0.f; u32x4 zq[12];
#pragma unroll
      for (int ks = 0; ks < 12; ++ks) zq[ks] = *(const u32x4*)(qrow + 16 * ks + 8 * hi);
#pragma unroll
      for (int ks = 0; ks < 12; ++ks) { float f[8]; unpack8(zq[ks], f); if (ks < 8) ssn += sum8sq(f); else ssr += sum8sq(f); }
      const float rq = rsqrtf(half_swap_add(ssn) * (1.f / 128.f) + EPS) * QSCALE, rr = rsqrtf(half_swap_add(ssr) * (1.f / 64.f) + EPS);
#pragma unroll
      for (int ks = 0; ks < 8; ++ks) { float f[8]; unpack8(zq[ks], f); const f32x4 ga = *(const f32x4*)(C.g_qn + 16 * ks + 8 * hi), gb = *(const f32x4*)(C.g_qn + 16 * ks + 8 * hi + 4), ka = *(const f32x4*)(C.g_kn + 16 * ks + 8 * hi), kb = *(const f32x4*)(C.g_kn + 16 * ks + 8 * hi + 4);
#pragma unroll
          for (int j = 0; j < 4; ++j) { f[j] *= rq * ga[j] * ka[j]; f[4 + j] *= rq * gb[j] * kb[j]; }
          const u32x4 w = pack8f(f); qr[ks] = *reinterpret_cast<const bf16x8*>(&w); }
      const int tq = b * SEQ + qpos;
#pragma unroll
      for (int pr = 0; pr < 2; ++pr) {
          float x1[8], x2[8], o1[8], o2[8]; unpack8(zq[8 + pr], x1); unpack8(zq[10 + pr], x2);
          const f32x4 g1a = *(const f32x4*)(C.g_qr + 16 * pr + 8 * hi), g1b = *(const f32x4*)(C.g_qr + 16 * pr + 8 * hi + 4), g2a = *(const f32x4*)(C.g_qr + 32 + 16 * pr + 8 * hi), g2b = *(const f32x4*)(C.g_qr + 32 + 16 * pr + 8 * hi + 4);
          const f32x4* csp = (const f32x4*)((const float*)(C.ws + WS_ROPEM) + ((size_t)tq * 32 + 16 * pr + 8 * hi) * 2);
#pragma unroll
          for (int j = 0; j < 8; ++j) { x1[j] *= rr * (j < 4 ? g1a[j] : g1b[j - 4]); x2[j] *= rr * (j < 4 ? g2a[j] : g2b[j - 4]); }
#pragma unroll
          for (int j2 = 0; j2 < 4; ++j2) { const f32x4 cs = csp[j2];
              o1[2 * j2] = (x1[2 * j2] * cs[0] - x2[2 * j2] * cs[1]) * QSCALE; o2[2 * j2] = (x2[2 * j2] * cs[0] + x1[2 * j2] * cs[1]) * QSCALE;
              o1[2 * j2 + 1] = (x1[2 * j2 + 1] * cs[2] - x2[2 * j2 + 1] * cs[3]) * QSCALE; o2[2 * j2 + 1] = (x2[2 * j2 + 1] * cs[2] + x1[2 * j2 + 1] * cs[3]) * QSCALE; }
          const u32x4 w1 = pack8f(o1), w2 = pack8f(o2); qr[8 + pr] = *reinterpret_cast<const bf16x8*>(&w1); qr[10 + pr] = *reinterpret_cast<const bf16x8*>(&w2); } }
    constexpr float THR2 = 10.f;
    float m_reg = -1e30f, l_reg = 0.f; f32x16 o[4]; bf16x8 pa0 = bf16x8{}, pa1 = bf16x8{}, pa2 = bf16x8{}, pa3 = bf16x8{};
#pragma unroll
    for (int d = 0; d < 4; ++d) o[d] = f32x16{};
#define ATT_RESC_PA(PA_, al_) do { u32x4 w_ = *reinterpret_cast<const u32x4*>(&(PA_)); \
        _Pragma("unroll") for (int i_ = 0; i_ < 4; ++i_) w_[i_] = cvt_pk_bf16(bflo(w_[i_]) * (al_), bfhi(w_[i_]) * (al_)); PA_ = *reinterpret_cast<const bf16x8*>(&w_); } while (0)
#define ATT_MAXCHK(P_, HASPA) do { float pm_ = fmaxf(P_[0], P_[1]); \
        _Pragma("unroll") for (int r = 2; r < 16; ++r) pm_ = fmaxf(pm_, P_[r]); \
        pm_ = half_swap_max(pm_); \
        if (!__all(pm_ - m_reg <= THR2)) { const float mn_ = fmaxf(m_reg, pm_); const float alpha_ = __builtin_amdgcn_exp2f(m_reg - mn_); m_reg = mn_; l_reg *= alpha_; \
            if (HASPA) { ATT_RESC_PA(pa0, alpha_); ATT_RESC_PA(pa1, alpha_); } \
            if (hi == 0) al[c32] = alpha_; LDS_WAIT(); \
            _Pragma("unroll") for (int d = 0; d < 4; ++d) _Pragma("unroll") for (int r = 0; r < 16; ++r) o[d][r] *= al[crow(r, hi)]; } } while (0)
    const int ntile = (q0 + 256) / 64;
    ATT_LOAD(0); ATT_WRITE(0, 0);
    __syncthreads();
    for (int kt = 0; kt < ntile; ++kt) {
        const int k0 = kt * 64;
        if (kt + 1 < ntile) ATT_LOAD(k0 + 64);
        if (k0 <= qw + 31) {
            const LAS bf16_t* Kl = (const LAS bf16_t*)(C.lds + (kt & 1) * ATT_KB) + c32 * 200 + 8 * hi;
            const LAS bf16_t* Vl = (const LAS bf16_t*)(C.lds + ATT_VOFF + (kt & 1) * ATT_VB) + c32 * 72 + 8 * hi;
            const bool diag = (k0 + 63 > qw);
            const float NEG = -__builtin_inff();
            f32x16 p0 = f32x16{}, p1 = f32x16{};
#pragma unroll
            for (int ks = 0; ks < 12; ++ks) p0 = mfma32(*(const LAS bf16x8*)(Kl + 16 * ks), qr[ks], p0);
            if (diag) {
#pragma unroll
                for (int r = 0; r < 16; ++r) if (k0 + crow(r, hi) > qpos) p0[r] = NEG; }
            ATT_MAXCHK(p0, false);
#pragma unroll
            for (int ks = 0; ks < 12; ++ks) p1 = mfma32(*(const LAS bf16x8*)(Kl + 32 * 200 + 16 * ks), qr[ks], p1);
            { float ps = 0.f;
#pragma unroll
              for (int r = 0; r < 16; ++r) { p0[r] = __builtin_amdgcn_exp2f(p0[r] - m_reg); ps += p0[r]; }
              l_reg += ps; }
            PK4(p0, 0, pa0); PK4(p0, 8, pa1);
            if (diag) {
#pragma unroll
                for (int r = 0; r < 16; ++r) if (k0 + 32 + crow(r, hi) > qpos) p1[r] = NEG; }
            ATT_MAXCHK(p1, true);
#pragma unroll
            for (int d = 0; d < 4; ++d) { o[d] = mfma32(pa0, *(const LAS bf16x8*)(Vl + (32 * d) * 72), o[d]); o[d] = mfma32(pa1, *(const LAS bf16x8*)(Vl + (32 * d) * 72 + 16), o[d]); }
            { float ps = 0.f;
#pragma unroll
              for (int r = 0; r < 16; ++r) { p1[r] = __builtin_amdgcn_exp2f(p1[r] - m_reg); ps += p1[r]; }
              l_reg += ps; }
            PK4(p1, 0, pa2); PK4(p1, 8, pa3);
#pragma unroll
            for (int d = 0; d < 4; ++d) { o[d] = mfma32(pa2, *(const LAS bf16x8*)(Vl + (32 * d) * 72 + 32), o[d]); o[d] = mfma32(pa3, *(const LAS bf16x8*)(Vl + (32 * d) * 72 + 48), o[d]); }
        }
        if (kt + 1 < ntile) ATT_WRITE((kt + 1) & 1, (kt + 1) & 1);
        __syncthreads();
    }
    l_reg = half_swap_add(l_reg);
    if (hi == 0) al[c32] = 1.f / l_reg;
    LDS_WAIT();
    { LAS bf16_t* ot = (LAS bf16_t*)(C.lds + wave * 8704);
#pragma unroll
      for (int r = 0; r < 16; ++r) { const float il = al[crow(r, hi)];
#pragma unroll
          for (int d = 0; d < 4; ++d) ot[crow(r, hi) * 136 + 32 * d + c32] = f2bf(o[d][r] * il); }
      LDS_WAIT();
#pragma unroll
      for (int i = 0; i < 8; ++i) { const int ch = i * 64 + lane, row = ch >> 4, c16 = ch & 15;
          *(u32x4*)(Og + (size_t)(qw + row) * 2048 + 8 * c16) = *(const LAS u32x4*)(ot + row * 136 + 8 * c16); } }
    LDS_WAIT();
    __syncthreads();
#undef ATT_MAXCHK
#undef ATT_RESC_PA
#undef ATT_LOAD
#undef ATT_WRITE
}
__device__ __forceinline__ void phase_attention(const Ctx& C) {
    const int grp = (C.wg >> 3) % 3;
    for (int p = C.wg; p < NBATCH * MLA_H * 8; p += C.nwg) {
        const int bh = p >> 3, j = p & 7;
#pragma unroll 1
        for (int slot = 0; slot < 3; ++slot) {
            if (slot == grp && p == C.wg) expert_weights_range(C, EXP_P1_END, EXP_N_ALL, C.wg, C.nwg);
            if (slot < 2) attn_block(C, bh >> 4, bh & 15, slot == 0 ? 15 - j : j);
        }
    }
}
__device__ __forceinline__ void phase_moe_scatter(const Ctx& C) {
    const int* cnt = (const int*)(C.ws + WS_CNT); const int* rte = (const int*)(C.ws + WS_RTE);
    int* rtrow = (int*)(C.ws + WS_RTROW); int* tab = (int*)(C.ws + WS_MOETAB);
    LAS int* sh = (LAS int*)C.lds;
    const int tid = C.tid, lane = C.lane, wave = C.wave, rows_per_wg = T / C.nwg;
    if (wave == 0) {
        int tot = 0, pre = 0;
        if (C.nwg == 256) { int cv[32];
#pragma unroll
            for (int j = 0; j < 32; ++j) cv[j] = cnt[((lane >> 3) + 8 * j) * 8 + (lane & 7)];
#pragma unroll
            for (int j = 0; j < 32; ++j) { const int w = (lane >> 3) + 8 * j; if (w < C.wg) pre += cv[j]; tot += cv[j]; }
        } else for (int w = lane >> 3; w < C.nwg; w += 8) { const int c = cnt[w * 8 + (lane & 7)]; if (w < C.wg) pre += c; tot += c; }
        tot += __shfl_xor(tot, 8); tot += __shfl_xor(tot, 16); tot += __shfl_xor(tot, 32);
        pre += __shfl_xor(pre, 8); pre += __shfl_xor(pre, 16); pre += __shfl_xor(pre, 32);
        int start = 0, nrt = 0;
        for (int e = 0; e < 8; ++e) { const int te = __shfl(tot, e); if (e < lane) start += (te + 255) & ~255; nrt += (te + 255) >> 8; }
        if (lane < 8) { sh[lane] = start + pre; sh[8 + lane] = tot; sh[16 + lane] = start; }
        if (C.wg == 0 && lane < 8) { tab[lane] = start >> 8; tab[8 + lane] = (tot + 255) >> 8; }
        if (C.wg == 0 && lane == 0) tab[16] = nrt;
    }
    __syncthreads();
    if (wave == 0) {
        const int tl = lane >> 1, t = C.wg * rows_per_wg + tl; const int e = (tl < rows_per_wg) ? rte[2 * t + (lane & 1)] : -1;
        int rank = 0;
#pragma unroll
        for (int q = 0; q < 8; ++q) { const unsigned long long mk = __ballot(e == q); if (e == q) rank = __popcll(mk & ((1ull << lane) - 1ull)); }
        const int row = (e >= 0) ? sh[e] + rank : 0;
        if (e >= 0) rtrow[2 * t + (lane & 1)] = row;
        sh[32 + lane] = row;
    }
    __syncthreads();
    int* rowtok = (int*)(C.ws + WS_ROWTOK);
    if (tid < 2 * rows_per_wg) rowtok[sh[32 + tid]] = C.wg * rows_per_wg + (tid >> 1);
    if (C.wg < 8) { const int tot = sh[8 + C.wg], start = sh[16 + C.wg], r0 = start + tot, r1 = start + ((tot + 255) & ~255);
        for (int r = r0 + tid; r < r1; r += NTHR) rowtok[r] = T; }
    if (C.wg == 8 && tid < 128) ((u32x4*)(C.ws + WS_H + (size_t)T * D))[tid] = (u32x4){0u, 0u, 0u, 0u};
    __syncthreads();
}
constexpr int MOE_TOKS_OFF = 131072;
__device__ __forceinline__ const LAS int* moe_build_list(const Ctx& C, int npn, bool with_toks, bool split = false) {
    LAS int* t = (LAS int*)(C.lds + LDSCTL_OFF + 64); LAS int* list = (LAS int*)(C.lds + LDSCTL_OFF + 160);
    if (C.tid < 17) t[C.tid] = __hip_atomic_load((const int*)(C.ws + WS_MOETAB) + C.tid, __ATOMIC_RELAXED, __HIP_MEMORY_SCOPE_AGENT);
    __syncthreads();
    if (C.tid < 32) { int w = pg8::moe_unit_word(t, npn, C.nwg, C.wg, C.tid);
        if (split) { const int nfull = (t[16] * npn) / C.nwg; if (C.tid >= nfull) w = -1;
            if (C.tid == 31) { const int left = t[16] * npn - nfull * C.nwg, x = C.wg & 7, m = (C.wg >> 3) & 7, l = x + 8 * m; w = (l < left) ? pg8::moe_unit_word(t, npn, C.nwg, l, nfull) : -1; } }
        list[C.tid] = w; }
    __syncthreads();
    if (with_toks) { LAS int* toks = (LAS int*)(C.lds + MOE_TOKS_OFF); const int* rowtok = (const int*)(C.ws + WS_ROWTOK);
        if (C.tid < 256) { int tv[16];
#pragma unroll
            for (int i = 0; i < 16; ++i) { const int w = list[i]; tv[i] = rowtok[((w < 0 ? 0 : w) & 255) * 256 + C.tid]; }
#pragma unroll
            for (int i = 0; i < 16; ++i) toks[i * 256 + C.tid] = tv[i] * D; }
        __syncthreads(); }
    return list;
}
__device__ __forceinline__ void phase_moe_combine(const Ctx& C) {
    const bf16_t* x3 = (const bf16_t*)(C.ws + WS_X1); const bf16_t* OE = (const bf16_t*)(C.ws + WS_OE);
    const int* rtrow = (const int*)(C.ws + WS_RTROW); const float* rtw = (const float*)(C.ws + WS_RTW);
    const int gw = C.wg * NWAVES + C.wave, NGW = C.nwg * NWAVES, lane = C.lane;
    for (int t = gw; t < T; t += NGW) {
        const int r1 = rtrow[2 * t], r2 = rtrow[2 * t + 1]; const float w1 = rtw[2 * t], w2 = rtw[2 * t + 1];
        const u32x4* a = (const u32x4*)(OE + (size_t)r1 * D); const u32x4* b = (const u32x4*)(OE + (size_t)r2 * D);
        const u32x4* xr = (const u32x4*)(x3 + (size_t)t * D); f32x4* orow = (f32x4*)(C.out + (size_t)t * D);
#pragma unroll
        for (int j = 0; j < 4; ++j) { const int c = lane + 64 * j; const u32x4 av = a[c], bv = b[c]; const u32x4 xz = xr[c]; const f32x4 x0 = {bflo(xz.x), bfhi(xz.x), bflo(xz.y), bfhi(xz.y)}, x1 = {bflo(xz.z), bfhi(xz.z), bflo(xz.w), bfhi(xz.w)};
            f32x4 o0, o1;
            o0[0] = x0[0] + w1 * bflo(av.x) + w2 * bflo(bv.x); o0[1] = x0[1] + w1 * bfhi(av.x) + w2 * bfhi(bv.x); o0[2] = x0[2] + w1 * bflo(av.y) + w2 * bflo(bv.y); o0[3] = x0[3] + w1 * bfhi(av.y) + w2 * bfhi(bv.y);
            o1[0] = x1[0] + w1 * bflo(av.z) + w2 * bflo(bv.z); o1[1] = x1[1] + w1 * bfhi(av.z) + w2 * bfhi(bv.z); o1[2] = x1[2] + w1 * bflo(av.w) + w2 * bflo(bv.w); o1[3] = x1[3] + w1 * bfhi(av.w) + w2 * bfhi(bv.w);
            orow[2 * c] = o0; orow[2 * c + 1] = o1; }
    }
}

constexpr int NPHASE = 18;
struct Args { const void* in[27]; float* out; unsigned char* ws; int ph_lo, ph_hi; };
static_assert(sizeof(Args) == 27 * 8 + 8 + 8 + 8, "Args has no padding");

__global__ void __launch_bounds__(NTHR, 2) fwd_kernel(Args args) {
    extern __shared__ __attribute__((aligned(16))) unsigned char lds_raw[];
    Ctx C;
    C.lds = (LAS unsigned char*)lds_raw;
    C.tid = threadIdx.x; C.lane = C.tid & 63; C.wave = __builtin_amdgcn_readfirstlane(C.tid >> 6);
    C.nwg = gridDim.x; C.wg = blockIdx.x;
    C.x = (const float*)args.in[0]; C.pos = (const int*)args.in[1]; C.g_mix = (const float*)args.in[2]; C.g_ffn = (const float*)args.in[3]; C.w_in = (const float*)args.in[4];
    C.conv_w = (const float*)args.in[5]; C.b_gates = (const float*)args.in[6]; C.g_mo = (const float*)args.in[7]; C.g_ro = (const float*)args.in[8]; C.w_mix_out = (const float*)args.in[9];
    C.ffn_gate = (const float*)args.in[10]; C.ffn_up = (const float*)args.in[11]; C.ffn_down = (const float*)args.in[12]; C.w_dqkv = (const float*)args.in[13]; C.g_cq = (const float*)args.in[14];
    C.g_ckv = (const float*)args.in[15]; C.w_uq = (const float*)args.in[16]; C.w_ukv = (const float*)args.in[17]; C.g_qn = (const float*)args.in[18]; C.g_qr = (const float*)args.in[19];
    C.g_kn = (const float*)args.in[20]; C.g_kr = (const float*)args.in[21]; C.w_o = (const float*)args.in[22]; C.w_router = (const float*)args.in[23]; C.we_gate = (const float*)args.in[24];
    C.we_up = (const float*)args.in[25]; C.we_down = (const float*)args.in[26];
    C.out = args.out; C.ws = args.ws;
    unsigned char* ws = args.ws;
    volatile LAS unsigned* MISC = (volatile LAS unsigned*)(C.lds + MISC_OFF);
    for (int u = C.tid; u < (LDS_BYTES - LDSCTL_OFF) / 4; u += NTHR) ((LAS unsigned*)(C.lds + LDSCTL_OFF))[u] = 0u;
    __syncthreads();
    const int lo = args.ph_lo, hi = args.ph_hi;
    unsigned* barw = (unsigned*)(ws + WS_CTL) + CW_BAR;
    XcdBarrier bar; bar.bar = barw; bar.x = 0; bar.st = nullptr;
    if (hi - lo > 1) bar = xcd_barrier_post(barw, MISC + 8);
#ifdef ONLY_PHASE
#define IN(k) ((k) == ONLY_PHASE && lo <= (k) && (k) < hi)
#else
#define IN(k) (lo <= (k) && (k) < hi)
#endif
#define SEAM(k) do { if (IN(k) && IN((k) + 1)) xcd_barrier(bar); } while (0)
#ifdef PROBE_DUP
#define REPS(k) (((k) == PROBE_DUP) ? 2 : 1)
#else
#define REPS(k) 1
#endif
    bf16_t* Hn = (bf16_t*)(ws + WS_H);
    float* X1 = (float*)(ws + WS_X1); float* X2 = (float*)(ws + WS_X2);

    float* RSQ_X1 = (float*)(ws + WS_RSQ_X1); float* RSQ_X2 = (float*)(ws + WS_RSQ_X2); float* RSQ_CQ = (float*)(ws + WS_RSQ_CQ); float* RSQ_CKV = (float*)(ws + WS_RSQ_CKV);
    if (IN(0)) for (int rep_ = 0; rep_ < REPS(0); ++rep_) { phase_prologue(C); __syncthreads(); phase_norm<1>(C, C.x, C.g_mix, Hn, C.w_in + 4096, IN_COLS); } SEAM(0);
    if (IN(1)) for (int rep_ = 0; rep_ < REPS(1); ++rep_) { if (C.wg < 8) mlstm_scalar_scan(C, C.wg);
        pg8::Gemm g{Hn, (const bf16_t*)(ws + WS_WIN), D, D, D}; pg8::StaticOrder S; S.init(T, 8192, C.nwg, C.wg);
        pg8::EpiZ E{(bf16_t*)(ws + WS_Z), 8192, (const float*)(ws + WS_ROPER)};
        const int grp = (C.wg >> 3) & 3;
        { pg8::RangeOrder R{S, 0, grp}; pg8::gemm_phase<pg8::EpiZ, pg8::RangeOrder>(C.lds, g, R, E); }
        dense_weights_to_bf16(C, DI_WIN, DI_TOTAL); expert_weights_range(C, EXP_N_ALL, EXP_N_TOTAL2, C.wg, C.nwg); expert_weights_range(C, EXP_TAIL_END, EXP_P1_END, C.wg, C.nwg);
        { pg8::RangeOrder R{S, grp, 1 << 30}; pg8::gemm_phase<pg8::EpiZ, pg8::RangeOrder>(C.lds, g, R, E); } } SEAM(1);
    if (IN(2)) for (int rep_ = 0; rep_ < REPS(2); ++rep_) { phase_contrib(C); } SEAM(2);
    if (IN(3)) for (int rep_ = 0; rep_ < REPS(3); ++rep_) { phase_scan(C); } SEAM(3);
    if (IN(4)) for (int rep_ = 0; rep_ < REPS(4); ++rep_) { phase_mixout(C); } SEAM(4);
    if (IN(5)) for (int rep_ = 0; rep_ < REPS(5); ++rep_) { pg8::Gemm g{(const bf16_t*)(ws + WS_MIX), (const bf16_t*)(ws + WS_WOUT), D, D, D}; pg8::StaticOrder S; S.init(T, D, C.nwg, C.wg);
        pg8::EpiResNorm<true, true> E{(bf16_t*)X1, D, C.x, Hn, C.g_ffn, RSQ_X1}; pg8::gemm_phase<pg8::EpiResNorm<true, true>, pg8::StaticOrder>(C.lds, g, S, E); } SEAM(5);
    if (IN(6)) for (int rep_ = 0; rep_ < REPS(6); ++rep_) { pg8::Gemm g{Hn, (const bf16_t*)(ws + WS_WGU), D / 2, D / 2, D / 2}; pg8::StaticOrder S; S.init(T, 2 * DFF, C.nwg, C.wg);
        pg8::EpiSwiGLUScaled8 E{ws + WS_ACT, DFF, RSQ_X1, 1.f / D, EPS}; pg8::gemm_phase<pg8::EpiSwiGLUScaled8, pg8::StaticOrder, true, true, true>(C.lds, g, S, E);
        if (C.nwg == 256 && C.wg >= 128) expert_weights_range(C, 0, EXP_TAIL7, C.wg - 128, 128); else if (C.nwg != 256) expert_weights_range(C, 0, EXP_TAIL7, C.wg, C.nwg); } SEAM(6);
    if (IN(7)) for (int rep_ = 0; rep_ < REPS(7); ++rep_) { pg8::Gemm g{(const bf16_t*)(ws + WS_ACT), (const bf16_t*)(ws + WS_WD), DFF / 2, DFF / 2, DFF / 2}; pg8::StaticOrder S; S.init(T, D, C.nwg, C.wg);
        pg8::EpiResNorm<false> E{(bf16_t*)X2, D, X1, Hn, C.g_mix + D, RSQ_X2}; pg8::gemm_phase<pg8::EpiResNorm<false>, pg8::StaticOrder, true, true, true>(C.lds, g, S, E); } SEAM(7);
    if (IN(8)) for (int rep_ = 0; rep_ < REPS(8); ++rep_) { pg8::Gemm g{Hn, (const bf16_t*)(ws + WS_WDQKV), D, D, D}; pg8::StaticOrder S; S.init(T, NDQKV, C.nwg, C.wg);
        pg8::EpiLatent E{(bf16_t*)(ws + WS_CQKVN), (float*)(ws + WS_KR), RSQ_X2, RSQ_CQ, RSQ_CKV, C.g_cq, C.g_ckv, 1.f / D, EPS}; pg8::gemm_phase<pg8::EpiLatent, pg8::StaticOrder>(C.lds, g, S, E);
        if (C.nwg == 256 && C.wg >= 160) expert_weights_range(C, EXP_TAIL7, EXP_TAIL7 + EXP_TAIL9, C.wg - 160, 96); else if (C.nwg != 256) expert_weights_range(C, EXP_TAIL7, EXP_TAIL7 + EXP_TAIL9, C.wg, C.nwg); } SEAM(8);
    if (IN(9)) for (int rep_ = 0; rep_ < REPS(9); ++rep_) { phase_kr_prep(C); pg8::Gemm g{(const bf16_t*)(ws + WS_CQKVN), (const bf16_t*)(ws + WS_WUQKV), 512, 1024, 512}; pg8::DualOrder S; S.init(T, 7168, C.nwg, C.wg);
        pg8::EpiBf16Dual E{(bf16_t*)(ws + WS_QKVR), 7168, RSQ_CQ, RSQ_CKV, 1.f / 512.f, EPS, (bf16_t*)(ws + WS_VT), SEQ}; pg8::gemm_phase<pg8::EpiBf16Dual, pg8::DualOrder>(C.lds, g, S, E);
        if (C.nwg == 256 && C.wg >= 128) expert_weights_range(C, EXP_TAIL7 + EXP_TAIL9, EXP_TAIL_END, C.wg - 128, 128); else if (C.nwg != 256) expert_weights_range(C, EXP_TAIL7 + EXP_TAIL9, EXP_TAIL_END, C.wg, C.nwg); } SEAM(9);
    if (IN(11)) for (int rep_ = 0; rep_ < REPS(11); ++rep_) { phase_attention(C); } SEAM(11);
    if (IN(12)) for (int rep_ = 0; rep_ < REPS(12); ++rep_) { pg8::Gemm g{(const bf16_t*)(ws + WS_AO), (const bf16_t*)(ws + WS_WO), D, D, D}; pg8::StaticOrder S; S.init(T, D, C.nwg, C.wg);
        pg8::EpiF32 E{(bf16_t*)X1, D, (const bf16_t*)X2}; pg8::gemm_phase<pg8::EpiF32, pg8::StaticOrder>(C.lds, g, S, E); } SEAM(12);
    if (IN(13)) for (int rep_ = 0; rep_ < REPS(13); ++rep_) { phase_norm<2>(C, X1, C.g_ffn + D, Hn, C.w_router, 8); } SEAM(13);
    if (IN(14)) for (int rep_ = 0; rep_ < REPS(14); ++rep_) { phase_moe_scatter(C); } SEAM(14);
    if (IN(15)) for (int rep_ = 0; rep_ < REPS(15); ++rep_) { const LAS int* list = moe_build_list(C, 2 * DFF / 256, true);
        pg8::Gemm g{(const bf16_t*)(ws + WS_H), (const bf16_t*)(ws + WS_WEGU), D / 2, D / 2, D / 2}; pg8::MoeOrder S{list, 2 * DFF / 256, (const LAS int*)(C.lds + MOE_TOKS_OFF)};
        pg8::EpiSwiGLU8 E{ws + WS_ACTE, DFF}; pg8::gemm_phase<pg8::EpiSwiGLU8, pg8::MoeOrder, true, true, true, true>(C.lds, g, S, E); } SEAM(15);
    if (IN(16)) for (int rep_ = 0; rep_ < REPS(16); ++rep_) { const bool split = (C.nwg == 256); const LAS int* list = moe_build_list(C, D / 256, false, split);
        pg8::Gemm g{(const bf16_t*)(ws + WS_ACTE), (const bf16_t*)(ws + WS_WED), DFF / 2, DFF / 2, DFF / 2}; pg8::MoeOrder S{list, D / 256, (const LAS int*)(C.lds + MOE_TOKS_OFF)};
        pg8::EpiBf16 E{(bf16_t*)(ws + WS_OE), D}; pg8::gemm_phase<pg8::EpiBf16, pg8::MoeOrder, true, true, true>(C.lds, g, S, E);
        if (split) {
            const int w = __builtin_amdgcn_readfirstlane(list[31]);
            if (w >= 0) { const int rt = w & 255, pnl = (w >> 8) & 255, e = w >> 16, sl = C.wg >> 6, l = (C.wg & 7) + 8 * ((C.wg >> 3) & 7);
                const int koff = sl < 2 ? sl * 1536 : 3072 + (sl - 2) * 1280, kt = sl < 2 ? 12 : 10;
                pg8::Gemm g2{(const bf16_t*)(ws + WS_ACTE + koff), (const bf16_t*)(ws + WS_WED + koff), kt * 64, DFF / 2, DFF / 2};
                pg8::OneUnit S2{pg8::Unit{rt, e * (D / 256) + pnl, pnl, 0}, true};
                pg8::EpiSplitK E2{(bf16_t*)(ws + WS_OE), D, (float*)(ws + WS_SPLITK) + (size_t)l * (3 * 32 * 512 * 4), (unsigned*)(ws + WS_CTL) + CW_SPLITK + 16 * l, sl};
                pg8::gemm_phase<pg8::EpiSplitK, pg8::OneUnit, true, true, true>(C.lds, g2, S2, E2); } } } SEAM(16);
    if (IN(17)) for (int rep_ = 0; rep_ < REPS(17); ++rep_) { phase_moe_combine(C); }
#undef IN
#undef SEAM
}

extern "C" void kernel_launch(void* const* d_in, const int* in_sizes, int n_in, void* d_out, int out_size, void* d_ws, size_t ws_size, hipStream_t stream) {
    static int grid = 0;
    if (grid == 0) {
        if (n_in != 27 || out_size != T * D || ws_size < WS_END) { fprintf(stderr, "kernel_launch: unexpected problem (n_in %d, out %d, ws %zu < %zu)\n", n_in, out_size, ws_size, (size_t)WS_END); grid = -1; return; }
        int dev = 0, cus = 0;
        if (hipGetDevice(&dev) != hipSuccess || hipDeviceGetAttribute(&cus, hipDeviceAttributeMultiprocessorCount, dev) != hipSuccess) { grid = -1; return; }
        if (hipFuncSetAttribute((const void*)fwd_kernel, hipFuncAttributeMaxDynamicSharedMemorySize, LDS_BYTES) != hipSuccess) { fprintf(stderr, "kernel_launch: hipFuncSetAttribute failed\n"); grid = -1; return; }
        int per_cu = 0;
        if (hipOccupancyMaxActiveBlocksPerMultiprocessor(&per_cu, (const void*)fwd_kernel, NTHR, LDS_BYTES) != hipSuccess || per_cu < 1) fprintf(stderr, "kernel_launch: occupancy query reports %d\n", per_cu);
        (void)hipGetLastError();
        grid = 256;
        if (cus < 256) { fprintf(stderr, "kernel_launch: device has %d CUs, need 256\n", cus); grid = -1; return; }
    }
    if (grid < 0) return;
    if (hipMemsetAsync((char*)d_ws + WS_CTL, 0, CTL_ZERO_BYTES, stream) != hipSuccess) return;
    Args a{};
    for (int i = 0; i < 27; ++i) a.in[i] = d_in[i];
    a.out = (float*)d_out; a.ws = (unsigned char*)d_ws;
#if MK_ONE_LAUNCH
    a.ph_lo = 0; a.ph_hi = NPHASE;
    hipLaunchKernelGGL(fwd_kernel, dim3(grid), dim3(NTHR), LDS_BYTES, stream, a);
#else
    for (int ph = 0; ph < NPHASE; ++ph) { a.ph_lo = ph; a.ph_hi = ph + 1; hipLaunchKernelGGL(fwd_kernel, dim3(grid), dim3(NTHR), LDS_BYTES, stream, a); }
#endif
}
```
